# Optimizing an MI355X kernel written in HIP

```python
import jax, jax.numpy as jnp
from jax import lax
import numpy as np

D_MODEL = 2048
BATCH = 2
SEQ = 8192
DEPTH = 1

CHUNK = 64
EPS = 1e-6
M_HEADS = 4
M_HEAD_DIM = 256
M_WIDTH = M_HEADS * M_HEAD_DIM
CONV_WIDTH = 4
A_HEADS = 16
A_HEAD_DIM = 64
A_WIDTH = A_HEADS * A_HEAD_DIM
LEFT_CHUNKS = 8
BAND_CHUNKS = LEFT_CHUNKS + 1
MAX_REL = 128
N_MEM = 256
X_HEADS = 4
X_HEAD_DIM = 128
X_WIDTH = X_HEADS * X_HEAD_DIM
N_EXPERTS = 32
TOP_K = 4
D_FF = D_MODEL
SWIGLU_LIMIT = 7.0
SWIGLU_ALPHA = 1.702
MOE_BLOCK = 256
IN_COLS = 4 * M_WIDTH + 2 * M_HEADS + 3 * A_WIDTH + 2 * D_MODEL

kernel_name = "hybrid_mlstm_chunkattn_memxattn_moe"


def _in_proj_offsets():
    sizes = (M_WIDTH, M_WIDTH, M_WIDTH, M_WIDTH, 2 * M_HEADS, A_WIDTH, A_WIDTH, A_WIDTH, D_MODEL)
    offs, t = [], 0
    for s in sizes:
        t += s
        offs.append(t)
    return offs


def rmsnorm(x, w):
    xf = x.astype(jnp.float32)
    y = xf * lax.rsqrt(jnp.mean(xf * xf, axis=-1, keepdims=True) + EPS)
    return (y * w.astype(jnp.float32)).astype(x.dtype)


def causal_dwconv(u, w, b):
    S = u.shape[1]
    up = jnp.pad(u, ((0, 0), (CONV_WIDTH - 1, 0), (0, 0)))
    out = up[:, 0:S] * w[0]
    for j in range(1, CONV_WIDTH):
        out = out + up[:, j:j + S] * w[j]
    return out + b


def mlstm_chunkwise(q, k, v, i_pre, f_pre):
    B, H, S, d = q.shape
    NC = S // CHUNK
    f32 = jnp.float32
    q = q.astype(f32).reshape(B, H, NC, CHUNK, d)
    k = (k.astype(f32) * (d ** -0.5)).reshape(B, H, NC, CHUNK, d)
    v = v.astype(f32).reshape(B, H, NC, CHUNK, d)
    ig = i_pre.reshape(B, H, NC, CHUNK)
    b = jnp.cumsum(jax.nn.log_sigmoid(f_pre).reshape(B, H, NC, CHUNK), axis=-1)
    g = b[..., -1]
    w_end = g[..., None] - b + ig
    a = jnp.max(w_end, axis=-1)
    e_end = jnp.exp(w_end - a[..., None])
    C_loc = jnp.einsum('bhclv,bhclk->bhcvk', v * e_end[..., None], k)
    n_loc = jnp.einsum('bhcl,bhclk->bhck', e_end, k)

    def step(carry, inp):
        C, n, m = carry
        Cl, nl, al, gl = inp
        m_new = jnp.maximum(gl + m, al)
        s_prev = jnp.exp(gl + m - m_new)
        s_loc = jnp.exp(al - m_new)
        C_new = s_prev[..., None, None] * C + s_loc[..., None, None] * Cl
        n_new = s_prev[..., None] * n + s_loc[..., None] * nl
        return (C_new, n_new, m_new), (C, n, m)

    init = (jnp.zeros((B, H, d, d), f32), jnp.zeros((B, H, d), f32), jnp.zeros((B, H), f32))
    xs = (jnp.moveaxis(C_loc, 2, 0), jnp.moveaxis(n_loc, 2, 0),
          jnp.moveaxis(a, 2, 0), jnp.moveaxis(g, 2, 0))
    _, (C_in, n_in, m_in) = lax.scan(step, init, xs)
    C_in = jnp.moveaxis(C_in, 0, 2)
    n_in = jnp.moveaxis(n_in, 0, 2)
    m_in = jnp.moveaxis(m_in, 0, 2)

    causal = jnp.tril(jnp.ones((CHUNK, CHUNK), dtype=bool))
    Dlog = b[..., :, None] - b[..., None, :] + ig[..., None, :]
    Dlog = jnp.where(causal, Dlog, -jnp.inf)
    inter_log = b + m_in[..., None]
    m_j = jnp.maximum(inter_log, jnp.max(Dlog, axis=-1))
    s = jnp.einsum('bhcjd,bhcsd->bhcjs', q, k) * jnp.exp(Dlog - m_j[..., None])
    w_inter = jnp.exp(inter_log - m_j)
    num = (jnp.einsum('bhcjs,bhcsv->bhcjv', s, v)
           + w_inter[..., None] * jnp.einsum('bhcvk,bhcjk->bhcjv', C_in, q))
    den = jnp.sum(s, axis=-1) + w_inter * jnp.einsum('bhck,bhcjk->bhcj', n_in, q)
    h = num / jnp.maximum(jnp.abs(den), jnp.exp(-m_j))[..., None]
    return h.reshape(B, H, S, d)


def chunked_band_attention(q, k, v, rel_table):
    B, H, S, dh = q.shape
    NC = S // CHUNK
    qc = q.reshape(B, H, NC, CHUNK, dh)
    pad = ((0, 0), (0, 0), (LEFT_CHUNKS, 0), (0, 0), (0, 0))
    kp = jnp.pad(k.reshape(B, H, NC, CHUNK, dh), pad)
    vp = jnp.pad(v.reshape(B, H, NC, CHUNK, dh), pad)
    band_idx = jnp.arange(NC)[:, None] + jnp.arange(BAND_CHUNKS)[None, :]
    k_band = jnp.take(kp, band_idx, axis=2).reshape(B, H, NC, BAND_CHUNKS * CHUNK, dh)
    v_band = jnp.take(vp, band_idx, axis=2).reshape(B, H, NC, BAND_CHUNKS * CHUNK, dh)
    valid = jnp.repeat(band_idx >= LEFT_CHUNKS, CHUNK, axis=1)
    q_pos = LEFT_CHUNKS * CHUNK + jnp.arange(CHUNK)
    k_pos = jnp.arange(BAND_CHUNKS * CHUNK)
    rel = jnp.clip(q_pos[:, None] - k_pos[None, :], -MAX_REL, MAX_REL) + MAX_REL
    bias = rel_table[:, rel].astype(jnp.float32)
    scores = jnp.einsum('bhcqd,bhckd->bhcqk', qc, k_band).astype(jnp.float32) * (dh ** -0.5)
    scores = scores + bias[None, :, None]
    scores = jnp.where(valid[None, None, :, None, :], scores, -1e30)
    p = jax.nn.softmax(scores, axis=-1).astype(v.dtype)
    o = jnp.einsum('bhcqk,bhckd->bhcqd', p, v_band)
    return o.reshape(B, H, S, dh).transpose(0, 2, 1, 3).reshape(B, S, H * dh)


def memory_cross_attention(h, mem_n, wq, wkv, wo):
    B, S, _ = h.shape
    q = (h @ wq).reshape(B, S, X_HEADS, X_HEAD_DIM)
    kv = mem_n @ wkv
    km, vm = jnp.split(kv, 2, axis=-1)
    km = km.reshape(B, -1, X_HEADS, X_HEAD_DIM)
    vm = vm.reshape(B, -1, X_HEADS, X_HEAD_DIM)
    scores = jnp.einsum('bshd,bnhd->bhsn', q, km).astype(jnp.float32) * (X_HEAD_DIM ** -0.5)
    p = jax.nn.softmax(scores, axis=-1).astype(vm.dtype)
    o = jnp.einsum('bhsn,bnhd->bshd', p, vm).reshape(B, S, X_WIDTH)
    return o @ wo


def moe_ffn(h, w_router, b_router, w_gu, b_gu, w_down, b_down):
    B, S, D = h.shape
    T = B * S
    xt = h.reshape(T, D)
    logits = (xt @ w_router + b_router).astype(jnp.float32)
    top_logit, top_e = lax.top_k(logits, TOP_K)
    gate = jax.nn.softmax(top_logit, axis=-1)
    A = T * TOP_K
    flat_e = top_e.reshape(A).astype(jnp.int32)
    flat_tok = jnp.arange(A, dtype=jnp.int32) // TOP_K
    flat_gate = gate.reshape(A)
    order = jnp.argsort(flat_e)
    se = flat_e[order]
    counts = jnp.bincount(flat_e, length=N_EXPERTS)
    padded = ((counts + MOE_BLOCK - 1) // MOE_BLOCK) * MOE_BLOCK
    start = jnp.cumsum(counts) - counts
    pend = jnp.cumsum(padded)
    pstart = pend - padded
    dest = pstart[se] + (jnp.arange(A, dtype=jnp.int32) - start[se])
    n_blocks = -(-A // MOE_BLOCK) + N_EXPERTS
    n_rows = n_blocks * MOE_BLOCK
    row_tok = jnp.full((n_rows,), T, dtype=jnp.int32).at[dest].set(flat_tok[order])
    row_gate = jnp.zeros((n_rows,), jnp.float32).at[dest].set(flat_gate[order])
    block_e = jnp.searchsorted(pend, jnp.arange(n_blocks) * MOE_BLOCK, side='right')
    block_e = jnp.minimum(block_e, N_EXPERTS - 1).astype(jnp.int32)
    x_pad = jnp.concatenate([xt, jnp.zeros((1, D), xt.dtype)], axis=0)

    def expert_block(args):
        tok, e = args
        xb = x_pad[tok]
        gu = xb @ w_gu[e] + b_gu[e]
        g, u = jnp.split(gu, 2, axis=-1)
        g = jnp.minimum(g, SWIGLU_LIMIT)
        u = jnp.clip(u, -SWIGLU_LIMIT, SWIGLU_LIMIT)
        act = (u + 1) * (g * jax.nn.sigmoid(SWIGLU_ALPHA * g))
        return act @ w_down[e] + b_down[e]

    y_rows = lax.map(expert_block, (row_tok.reshape(n_blocks, MOE_BLOCK), block_e))
    y_rows = y_rows.reshape(n_rows, D) * row_gate[:, None].astype(h.dtype)
    y = jnp.zeros((T + 1, D), h.dtype).at[row_tok].add(y_rows)[:T]
    return y.reshape(B, S, D)


def setup_inputs(seed: int = 0) -> dict:
    key = jax.random.key(seed)
    ks = jax.random.split(key, 32)
    L, D = DEPTH, D_MODEL
    nrm = jax.random.normal
    f32 = jnp.float32
    i_b = 0.1 * nrm(ks[5], (L, M_HEADS), f32)
    f_b = jnp.linspace(3.0, 6.0, M_HEADS, dtype=f32)[None, :] + 0.1 * nrm(ks[6], (L, M_HEADS), f32)
    return {
        "x": nrm(ks[0], (BATCH, SEQ, D), f32),
        "mem": nrm(ks[1], (BATCH, N_MEM, D), f32),
        "norm_mix_w": 1.0 + 0.05 * nrm(ks[2], (L, D), f32),
        "w_in": nrm(ks[3], (L, D, IN_COLS), f32) * D ** -0.5,
        "conv_w": nrm(ks[4], (L, CONV_WIDTH, 2 * M_WIDTH), f32) * CONV_WIDTH ** -0.5,
        "conv_b": 0.02 * nrm(ks[7], (L, 2 * M_WIDTH), f32),
        "if_bias": jnp.concatenate([i_b, f_b], axis=-1),
        "m_head_norm_w": 1.0 + 0.05 * nrm(ks[8], (L, M_HEADS, M_HEAD_DIM), f32),
        "w_branch_m": nrm(ks[9], (L, M_WIDTH, D), f32) * M_WIDTH ** -0.5,
        "w_branch_a": nrm(ks[10], (L, A_WIDTH, D), f32) * A_WIDTH ** -0.5,
        "rel_bias": 0.1 * nrm(ks[11], (L, A_HEADS, 2 * MAX_REL + 1), f32),
        "w_out": nrm(ks[12], (L, D, D), f32) * D ** -0.5,
        "norm_x_w": 1.0 + 0.05 * nrm(ks[13], (L, D), f32),
        "norm_mem_w": 1.0 + 0.05 * nrm(ks[14], (L, D), f32),
        "wq_x": nrm(ks[15], (L, D, X_WIDTH), f32) * D ** -0.5,
        "wkv_x": nrm(ks[16], (L, D, 2 * X_WIDTH), f32) * D ** -0.5,
        "wo_x": nrm(ks[17], (L, X_WIDTH, D), f32) * X_WIDTH ** -0.5,
        "norm_ffn_w": 1.0 + 0.05 * nrm(ks[18], (L, D), f32),
        "w_router": nrm(ks[19], (L, D, N_EXPERTS), f32) * D ** -0.5,
        "b_router": 0.01 * nrm(ks[20], (L, N_EXPERTS), f32),
        "w_gu": nrm(ks[21], (L, N_EXPERTS, D, 2 * D_FF), f32) * D ** -0.5,
        "b_gu": 0.01 * nrm(ks[22], (L, N_EXPERTS, 2 * D_FF), f32),
        "w_down": nrm(ks[23], (L, N_EXPERTS, D_FF, D), f32) * D_FF ** -0.5,
        "b_down": 0.01 * nrm(ks[24], (L, N_EXPERTS, D), f32),
        "final_norm_w": 1.0 + 0.05 * nrm(ks[25], (D,), f32),
    }


def reference(x, mem, norm_mix_w, w_in, conv_w, conv_b, if_bias, m_head_norm_w, w_branch_m,
              w_branch_a, rel_bias, w_out, norm_x_w, norm_mem_w, wq_x, wkv_x, wo_x, norm_ffn_w,
              w_router, b_router, w_gu, b_gu, w_down, b_down, final_norm_w):
    B, S, D = x.shape
    offs = _in_proj_offsets()
    for l in range(DEPTH):
        h = rmsnorm(x, norm_mix_w[l])
        proj = h @ w_in[l]
        q_m, k_m, v_m, o_m, if_m, q_a, k_a, v_a, g_m, g_a = jnp.split(proj, offs, axis=-1)

        qk = jax.nn.silu(causal_dwconv(jnp.concatenate([q_m, k_m], axis=-1), conv_w[l], conv_b[l]))
        qm, km = jnp.split(qk, 2, axis=-1)
        to_heads_m = lambda t: t.reshape(B, S, M_HEADS, M_HEAD_DIM).transpose(0, 2, 1, 3)
        gates = (if_m + if_bias[l]).astype(jnp.float32)
        i_pre = gates[..., :M_HEADS].transpose(0, 2, 1)
        f_pre = gates[..., M_HEADS:].transpose(0, 2, 1)
        hm = mlstm_chunkwise(to_heads_m(qm), to_heads_m(km), to_heads_m(v_m), i_pre, f_pre)
        hm = hm.transpose(0, 2, 1, 3)
        hm = hm * lax.rsqrt(jnp.mean(hm * hm, axis=-1, keepdims=True) + EPS)
        hm = (hm * m_head_norm_w[l].astype(jnp.float32)).reshape(B, S, M_WIDTH).astype(x.dtype)
        y_m = (jax.nn.sigmoid(o_m) * hm) @ w_branch_m[l]

        to_heads_a = lambda t: t.reshape(B, S, A_HEADS, A_HEAD_DIM).transpose(0, 2, 1, 3)
        ya = chunked_band_attention(to_heads_a(q_a), to_heads_a(k_a), to_heads_a(v_a), rel_bias[l])
        y_a = ya @ w_branch_a[l]

        merged = jax.nn.sigmoid(g_m) * y_m + jax.nn.sigmoid(g_a) * y_a
        x = x + merged @ w_out[l]

        x = x + memory_cross_attention(rmsnorm(x, norm_x_w[l]), rmsnorm(mem, norm_mem_w[l]),
                                       wq_x[l], wkv_x[l], wo_x[l])

        x = x + moe_ffn(rmsnorm(x, norm_ffn_w[l]), w_router[l], b_router[l], w_gu[l], b_gu[l],
                        w_down[l], b_down[l])
    return rmsnorm(x, final_norm_w)
```

```cpp
#include <hip/hip_runtime.h>
#include <cstdio>
#include <cstdint>
namespace pg8 {
#define PG8_LAS __attribute__((address_space(3)))
typedef unsigned short bf16_t;
typedef short bf16x8 __attribute__((ext_vector_type(8)));
typedef float f32x4 __attribute__((ext_vector_type(4)));
typedef unsigned u32x4 __attribute__((ext_vector_type(4)));
constexpr int BM = 256, BK = 64, HALF = 128, HTB = HALF * BK * 2  , STAGE_BYTES = 8 * HTB, NXCD = 8, WGM = 8;

__host__ __device__ __forceinline__ int lds_byte(int r, int c) { const int st = (r >> 4) * 2 + (c >> 5), rr = r & 15, cc = c & 31, ob = rr * 64 + cc * 2; return st * 1024 + (ob ^ (((ob >> 9) & 1) << 5)); }
__host__ __device__ __forceinline__ void stage_rc(int b, int& R, int& C) { const int st = b / 1024, sb = b % 1024, swz = sb ^ (((sb >> 9) & 1) << 5); R = (st >> 1) * 16 + swz / 64; C = (st & 1) * 32 + (swz % 64) / 2; }
__host__ __device__ __forceinline__ int perm32(int rho) { const int n = rho >> 4, i = rho & 15; return 8 * (i >> 2) + 4 * n + (i & 3); }

struct Unit { int pm, pn; };
struct Gemm { const bf16_t* A; const bf16_t* Bt; int M, N, K; };

struct StaticOrder {
    int nM, nN, nwg, G, c;
    __host__ __device__ void init(int M, int N, int G_, int c_) { nM = M / BM; nN = N / BM; nwg = nM * nN; G = G_; c = c_; }
    __host__ __device__ bool next(int i, Unit& u) const {
        const long L = (long)i * G + c; if (L >= nwg) return false;
        int wgid = (int)L; { const int q = nwg / NXCD, r = nwg % NXCD, xcd = wgid % NXCD, off = wgid / NXCD; wgid = (xcd < r ? xcd * (q + 1) : r * (q + 1) + (xcd - r) * q) + off; }
        const int nig = WGM * nN, gid = wgid / nig, fm = gid * WGM, gsz = (nM - fm) < WGM ? (nM - fm) : WGM;
        u.pm = fm + ((wgid % nig) % gsz); u.pn = (wgid % nig) / gsz; return true;
    }
    __device__ __forceinline__ const char* a_base(const Gemm& g, const Unit& u) const { return (const char*)g.A + (size_t)u.pm * ((size_t)BM * g.K * 2); }
    __device__ __forceinline__ const char* b_base(const Gemm& g, const Unit& u) const { return (const char*)g.Bt + (size_t)u.pn * ((size_t)BM * g.K * 2); }
    __device__ __forceinline__ void a_ready(const Unit&) const {}
    __device__ __forceinline__ void done(const Unit&) const {}
};


template <int MODE> struct InProjOrder : StaticOrder {
    __device__ __forceinline__ bool next(int i, Unit& u) const { if (!StaticOrder::next(i, u)) return false;
        const int l = u.pn; u.pn = (MODE == 0) ? (l < 16 ? l : l + 12) : (16 + l); return true; }
    __device__ __forceinline__ const char* b_base(const Gemm& g, const Unit& u) const {
        const int t = (MODE == 0) ? u.pn : (u.pn - 16); return (const char*)g.Bt + (size_t)t * ((size_t)BM * g.K * 2); }
};

struct MoeOrder {
    int nN, G, c, nblk; const int* block_e; size_t bstride;
    __device__ __forceinline__ bool next(int i, Unit& u) const {
        if (G == 256 && (nN == 16 || nN == 8)) {
            const int xc = nN / 4, rpr = (8 / xc) * 8, x = c & 7, j = c >> 3;
            u.pm = i * rpr + (x / xc) * 8 + (j >> 2); u.pn = (x % xc) * 4 + (j & 3);
            if (i * rpr >= nblk) return false;
            return u.pm < nblk;
        }
        const long L = (long)i * G + c; if (L >= (long)nblk * nN) return false;
        u.pm = (int)(L / nN); u.pn = (int)(L % nN); return true;
    }
    __device__ __forceinline__ const char* a_base(const Gemm& g, const Unit& u) const { return (const char*)g.A + (size_t)u.pm * ((size_t)BM * g.K * 2); }
    __device__ __forceinline__ const char* b_base(const Gemm& g, const Unit& u) const { return (const char*)g.Bt + (size_t)block_e[u.pm] * bstride + (size_t)u.pn * ((size_t)BM * g.K * 2); }
    __device__ __forceinline__ void a_ready(const Unit&) const {}
    __device__ __forceinline__ void done(const Unit&) const {}
};

typedef unsigned u32x2 __attribute__((ext_vector_type(2)));
typedef int v8i_t __attribute__((ext_vector_type(8)));
typedef int v4i_t __attribute__((ext_vector_type(4)));
__device__ __forceinline__ v8i_t cat8(bf16x8 lo, bf16x8 hi) { const v4i_t a = __builtin_bit_cast(v4i_t, lo), b = __builtin_bit_cast(v4i_t, hi); return __builtin_shufflevector(a, b, 0, 1, 2, 3, 4, 5, 6, 7); }
__device__ __forceinline__ unsigned pk_fp8x4(float a, float b, float c, float d) {
    a = __builtin_amdgcn_fmed3f(a, -448.f, 448.f); b = __builtin_amdgcn_fmed3f(b, -448.f, 448.f); c = __builtin_amdgcn_fmed3f(c, -448.f, 448.f); d = __builtin_amdgcn_fmed3f(d, -448.f, 448.f);
    int w = 0; w = __builtin_amdgcn_cvt_pk_fp8_f32(a, b, w, false); w = __builtin_amdgcn_cvt_pk_fp8_f32(c, d, w, true); return (unsigned)w; }
typedef __bf16 bf2_t __attribute__((ext_vector_type(2)));
typedef float f32x2_t __attribute__((ext_vector_type(2)));
__device__ __forceinline__ unsigned cvt_pk_bf16_c(float lo, float hi) { const f32x2_t v = {lo, hi}; const bf2_t r = __builtin_convertvector(v, bf2_t); return __builtin_bit_cast(unsigned, r); }
__device__ __forceinline__ unsigned cvt_pk_bf16(float lo, float hi) { unsigned r; asm volatile("v_cvt_pk_bf16_f32 %0, %1, %2" : "=v"(r) : "v"(lo), "v"(hi)); return r; }
__device__ __forceinline__ float bf_lo(unsigned w) { return __builtin_bit_cast(float, w << 16); }
__device__ __forceinline__ float bf_hi(unsigned w) { return __builtin_bit_cast(float, w & 0xffff0000u); }
__device__ __forceinline__ float sigmoidf_(float x) { return __builtin_amdgcn_rcpf(1.f + __expf(-x)); }

struct EpiAct {
    static constexpr bool PERM = true, AFTER_DRAIN = false; static constexpr int MIDK = 0;
    bf16_t* O; int ldc; int s1lo, s1hi, s2lo, s2hi, clo, chi; float sc; int nostore; const float* ssq; float inv_n, eps; float gsc;
    __device__ __forceinline__ void operator()(const f32x4 (&acc)[2][2][4][2], const Unit& u, int wr, int wc, int fr, int fq) const {
        const int row0 = u.pm * BM + wr * 64 + fr, col0 = u.pn * BM + wc * 32 + 8 * fq;
        const bool sg = (u.pn >= s1lo && u.pn < s1hi) || (u.pn >= s2lo && u.pn < s2hi);
        const float s = gsc * ((u.pn >= clo && u.pn < chi) ? sc : 1.f);
        float rscv[2][4];
#pragma unroll
        for (int ai = 0; ai < 2; ++ai)
#pragma unroll
            for (int m = 0; m < 4; ++m) { float rsc = s;
                if (ssq) { const f32x4* sp = (const f32x4*)(ssq + (size_t)(row0 + ai * HALF + m * 16) * 32); float t = 0.f;
#pragma unroll
                    for (int q = 0; q < 8; ++q) { const f32x4 p4 = sp[q]; t += p4[0]; t += p4[1]; t += p4[2]; t += p4[3]; }
                    rsc = s * (1.f / sqrtf(t * inv_n + eps)); }
                rscv[ai][m] = rsc; }
#pragma unroll
        for (int ai = 0; ai < 2; ++ai)
#pragma unroll
            for (int m = 0; m < 4; ++m) { bf16_t* rowp = O + (size_t)(row0 + ai * HALF + m * 16) * ldc + col0;
                const float rsc = rscv[ai][m];
#pragma unroll
                for (int bj = 0; bj < 2; ++bj) { f32x4 v0 = acc[ai][bj][m][0], v1 = acc[ai][bj][m][1];
                    if (sg) {
#pragma unroll
                        for (int j = 0; j < 4; ++j) { v0[j] = sigmoidf_(v0[j]); v1[j] = sigmoidf_(v1[j]); } }
                    v0 = v0 * rsc; v1 = v1 * rsc;
                    u32x4 w; w.x = cvt_pk_bf16(v0[0], v0[1]); w.y = cvt_pk_bf16(v0[2], v0[3]); w.z = cvt_pk_bf16(v1[0], v1[1]); w.w = cvt_pk_bf16(v1[2], v1[3]);
                    if (!nostore) *(u32x4*)(rowp + bj * HALF) = w; } }
    }
};

template <bool ADD> struct EpiGate {
    static constexpr bool PERM = true, AFTER_DRAIN = false; static constexpr int MIDK = 0;
    const bf16_t* Gt; int ldg, goff; const bf16_t* Tin; bf16_t* O; int ldo;
    __device__ __forceinline__ void operator()(const f32x4 (&acc)[2][2][4][2], const Unit& u, int wr, int wc, int fr, int fq) const {
        const int row0 = u.pm * BM + wr * 64 + fr, col0 = u.pn * BM + wc * 32 + 8 * fq;
#pragma unroll
        for (int ai = 0; ai < 2; ++ai)
#pragma unroll
            for (int m = 0; m < 4; ++m) { const size_t row = (size_t)(row0 + ai * HALF + m * 16);
#pragma unroll
                for (int bj = 0; bj < 2; ++bj) { const int col = col0 + bj * HALF;
                    const u32x4 gw = *(const u32x4*)(Gt + row * ldg + goff + col);
                    f32x4 v0 = acc[ai][bj][m][0], v1 = acc[ai][bj][m][1];
                    v0[0] *= bf_lo(gw.x); v0[1] *= bf_hi(gw.x); v0[2] *= bf_lo(gw.y); v0[3] *= bf_hi(gw.y);
                    v1[0] *= bf_lo(gw.z); v1[1] *= bf_hi(gw.z); v1[2] *= bf_lo(gw.w); v1[3] *= bf_hi(gw.w);
                    if (ADD) { const u32x4 tw = *(const u32x4*)(Tin + row * ldo + col);
                        v0[0] += bf_lo(tw.x); v0[1] += bf_hi(tw.x); v0[2] += bf_lo(tw.y); v0[3] += bf_hi(tw.y);
                        v1[0] += bf_lo(tw.z); v1[1] += bf_hi(tw.z); v1[2] += bf_lo(tw.w); v1[3] += bf_hi(tw.w); }
                    u32x4 w; w.x = cvt_pk_bf16(v0[0], v0[1]); w.y = cvt_pk_bf16(v0[2], v0[3]); w.z = cvt_pk_bf16(v1[0], v1[1]); w.w = cvt_pk_bf16(v1[2], v1[3]);
                    *(u32x4*)(O + row * ldo + col) = w; } }
    }
};


struct EpiMerge {
    static constexpr bool PERM = true, AFTER_DRAIN = false; static constexpr int MIDK = 16;
    const bf16_t* Gt; int ldg, gm_off, ga_off; bf16_t* O; int ldo;
    __device__ __forceinline__ void mid(f32x4 (&acc)[2][2][4][2], const Unit& u, int wr, int wc, int fr, int fq) const {
        const int row0 = u.pm * BM + wr * 64 + fr, col0 = u.pn * BM + wc * 32 + 8 * fq;
#pragma unroll
        for (int ai = 0; ai < 2; ++ai)
#pragma unroll
            for (int m = 0; m < 4; ++m) { const size_t ro = (size_t)(row0 + ai * HALF + m * 16) * ldg + col0;
#pragma unroll
                for (int bj = 0; bj < 2; ++bj) { const u32x4 gm = *(const u32x4*)(Gt + ro + gm_off + bj * HALF), ga = *(const u32x4*)(Gt + ro + ga_off + bj * HALF);
                    f32x4& v0 = acc[ai][bj][m][0]; f32x4& v1 = acc[ai][bj][m][1];
                    v0[0] *= bf_lo(gm.x) * __builtin_amdgcn_rcpf(bf_lo(ga.x)); v0[1] *= bf_hi(gm.x) * __builtin_amdgcn_rcpf(bf_hi(ga.x)); v0[2] *= bf_lo(gm.y) * __builtin_amdgcn_rcpf(bf_lo(ga.y)); v0[3] *= bf_hi(gm.y) * __builtin_amdgcn_rcpf(bf_hi(ga.y));
                    v1[0] *= bf_lo(gm.z) * __builtin_amdgcn_rcpf(bf_lo(ga.z)); v1[1] *= bf_hi(gm.z) * __builtin_amdgcn_rcpf(bf_hi(ga.z)); v1[2] *= bf_lo(gm.w) * __builtin_amdgcn_rcpf(bf_lo(ga.w)); v1[3] *= bf_hi(gm.w) * __builtin_amdgcn_rcpf(bf_hi(ga.w)); } }
    }
    __device__ __forceinline__ void operator()(const f32x4 (&acc)[2][2][4][2], const Unit& u, int wr, int wc, int fr, int fq) const {
        const int row0 = u.pm * BM + wr * 64 + fr, col0 = u.pn * BM + wc * 32 + 8 * fq;
        u32x4 gwv[2][4][2];
#pragma unroll
        for (int ai = 0; ai < 2; ++ai)
#pragma unroll
            for (int m = 0; m < 4; ++m)
#pragma unroll
                for (int bj = 0; bj < 2; ++bj) gwv[ai][m][bj] = *(const u32x4*)(Gt + (size_t)(row0 + ai * HALF + m * 16) * ldg + ga_off + col0 + bj * HALF);
#pragma unroll
        for (int ai = 0; ai < 2; ++ai)
#pragma unroll
            for (int m = 0; m < 4; ++m) { const size_t row = (size_t)(row0 + ai * HALF + m * 16);
#pragma unroll
                for (int bj = 0; bj < 2; ++bj) { const int col = col0 + bj * HALF;
                    const u32x4 gw = gwv[ai][m][bj];
                    f32x4 v0 = acc[ai][bj][m][0], v1 = acc[ai][bj][m][1];
                    v0[0] *= bf_lo(gw.x); v0[1] *= bf_hi(gw.x); v0[2] *= bf_lo(gw.y); v0[3] *= bf_hi(gw.y);
                    v1[0] *= bf_lo(gw.z); v1[1] *= bf_hi(gw.z); v1[2] *= bf_lo(gw.w); v1[3] *= bf_hi(gw.w);
                    u32x4 w; w.x = cvt_pk_bf16(v0[0], v0[1]); w.y = cvt_pk_bf16(v0[2], v0[3]); w.z = cvt_pk_bf16(v1[0], v1[1]); w.w = cvt_pk_bf16(v1[2], v1[3]);
                    *(u32x4*)(O + row * ldo + col) = w; } }
    }
};

struct EpiResF32 {
    static constexpr bool PERM = false, AFTER_DRAIN = false; static constexpr int MIDK = 0;
    float* C; int ldc; const float* R;
    __device__ __forceinline__ void operator()(const f32x4 (&acc)[2][2][4][2], const Unit& u, int wr, int wc, int fr, int fq) const {
        const int row0 = u.pm * BM + wr * 64 + fr, col0 = u.pn * BM + wc * 32 + 4 * fq;
#pragma unroll
        for (int ai = 0; ai < 2; ++ai)
#pragma unroll
            for (int m = 0; m < 4; ++m) { const size_t ro = (size_t)(row0 + ai * HALF + m * 16) * ldc + col0;
#pragma unroll
                for (int bj = 0; bj < 2; ++bj)
#pragma unroll
                    for (int n = 0; n < 2; ++n) { f32x4 v = acc[ai][bj][m][n];
                        if (R) v = v + *(const f32x4*)(R + ro + bj * HALF + n * 16);
                        *(f32x4*)(C + ro + bj * HALF + n * 16) = v; } }
    }
};


struct EpiResNorm {
    static constexpr bool PERM = true, AFTER_DRAIN = false; static constexpr int MIDK = 0;
    float* C; int ldc; const float* R; bf16_t* XB; const float* wcol; float* SSQ;
    __device__ __forceinline__ void operator()(const f32x4 (&acc)[2][2][4][2], const Unit& u, int wr, int wc, int fr, int fq) const {
        const int row0 = u.pm * BM + wr * 64 + fr, col0 = u.pn * BM + wc * 32 + 8 * fq;
        f32x4 wv[2][2];
#pragma unroll
        for (int bj = 0; bj < 2; ++bj)
#pragma unroll
            for (int n = 0; n < 2; ++n) wv[bj][n] = *(const f32x4*)(wcol + col0 + bj * HALF + 4 * n);
#pragma unroll
        for (int ai = 0; ai < 2; ++ai)
#pragma unroll
            for (int m = 0; m < 4; ++m) { const int row = row0 + ai * HALF + m * 16; const size_t ro = (size_t)row * ldc + col0; float ss = 0.f;
#pragma unroll
                for (int bj = 0; bj < 2; ++bj) {
                    const f32x4 v0 = acc[ai][bj][m][0] + *(const f32x4*)(R + ro + bj * HALF), v1 = acc[ai][bj][m][1] + *(const f32x4*)(R + ro + bj * HALF + 4);
                    *(f32x4*)(C + ro + bj * HALF) = v0; *(f32x4*)(C + ro + bj * HALF + 4) = v1;
                    ss += (v0[0] * v0[0] + v0[1] * v0[1]) + (v0[2] * v0[2] + v0[3] * v0[3]) + (v1[0] * v1[0] + v1[1] * v1[1]) + (v1[2] * v1[2] + v1[3] * v1[3]);
                    const f32x4 y0 = v0 * wv[bj][0], y1 = v1 * wv[bj][1];
                    u32x4 w; w.x = cvt_pk_bf16(y0[0], y0[1]); w.y = cvt_pk_bf16(y0[2], y0[3]); w.z = cvt_pk_bf16(y1[0], y1[1]); w.w = cvt_pk_bf16(y1[2], y1[3]);
                    *(u32x4*)(XB + ro + bj * HALF) = w; }
                ss += __shfl_xor(ss, 16); ss += __shfl_xor(ss, 32);
                if (fq == 0) SSQ[(size_t)row * 32 + 4 * u.pn + wc] = ss; }
    }
};


template <bool RB> struct EpiResB {
    static constexpr bool PERM = true, AFTER_DRAIN = false; static constexpr int MIDK = 0;
    bf16_t* C; int ldc; const void* R; float* SSQ;
    __device__ __forceinline__ void operator()(const f32x4 (&acc)[2][2][4][2], const Unit& u, int wr, int wc, int fr, int fq) const {
        const int row0 = u.pm * BM + wr * 64 + fr, col0 = u.pn * BM + wc * 32 + 8 * fq;
#pragma unroll
        for (int ai = 0; ai < 2; ++ai) {
            u32x4 rwv[4][2]; f32x4 rfv[4][2][2];
#pragma unroll
            for (int m = 0; m < 4; ++m)
#pragma unroll
                for (int bj = 0; bj < 2; ++bj) { const size_t ro = (size_t)(row0 + ai * HALF + m * 16) * ldc + col0 + bj * HALF;
                    if (RB) rwv[m][bj] = *(const u32x4*)((const bf16_t*)R + ro);
                    else { rfv[m][bj][0] = *(const f32x4*)((const float*)R + ro); rfv[m][bj][1] = *(const f32x4*)((const float*)R + ro + 4); } }
#pragma unroll
            for (int m = 0; m < 4; ++m) { const int row = row0 + ai * HALF + m * 16; const size_t ro = (size_t)row * ldc + col0; float ss = 0.f;
#pragma unroll
                for (int bj = 0; bj < 2; ++bj) { f32x4 v0 = acc[ai][bj][m][0], v1 = acc[ai][bj][m][1];
                    if (RB) { const u32x4 rw = rwv[m][bj];
                        v0[0] += bf_lo(rw.x); v0[1] += bf_hi(rw.x); v0[2] += bf_lo(rw.y); v0[3] += bf_hi(rw.y); v1[0] += bf_lo(rw.z); v1[1] += bf_hi(rw.z); v1[2] += bf_lo(rw.w); v1[3] += bf_hi(rw.w); }
                    else { v0 = v0 + rfv[m][bj][0]; v1 = v1 + rfv[m][bj][1]; }
                    ss += (v0[0] * v0[0] + v0[1] * v0[1]) + (v0[2] * v0[2] + v0[3] * v0[3]) + (v1[0] * v1[0] + v1[1] * v1[1]) + (v1[2] * v1[2] + v1[3] * v1[3]);
                    u32x4 w; w.x = cvt_pk_bf16(v0[0], v0[1]); w.y = cvt_pk_bf16(v0[2], v0[3]); w.z = cvt_pk_bf16(v1[0], v1[1]); w.w = cvt_pk_bf16(v1[2], v1[3]);
                    *(u32x4*)(C + ro + bj * HALF) = w; }
                if (SSQ) { ss += __shfl_xor(ss, 16); ss += __shfl_xor(ss, 32); if (fq == 0) SSQ[(size_t)row * 32 + 4 * u.pn + wc] = ss; } }
        }
    }
};

struct EpiSwiGLU {
    static constexpr bool PERM = true, AFTER_DRAIN = false; static constexpr int MIDK = 0;
    unsigned char* O; int ldo; const float* bgu; const int* block_e; int dff; float ascale, oscale; const float* rrow;
    __device__ __forceinline__ void operator()(const f32x4 (&acc)[2][2][4][2], const Unit& u, int wr, int wc, int fr, int fq) const {
        const int row0 = u.pm * BM + wr * 64 + fr, oc = u.pn * HALF + wc * 32 + 8 * fq;
        const float* bg = bgu + (size_t)block_e[u.pm] * (2 * dff) + oc; const float* bu = bg + dff;
        const f32x4 bg0 = *(const f32x4*)bg, bg1 = *(const f32x4*)(bg + 4), bu0 = *(const f32x4*)bu, bu1 = *(const f32x4*)(bu + 4);
        float rsv[2][4];
#pragma unroll
        for (int ai = 0; ai < 2; ++ai)
#pragma unroll
            for (int m = 0; m < 4; ++m) rsv[ai][m] = rrow[row0 + ai * HALF + m * 16];
#pragma unroll
        for (int ai = 0; ai < 2; ++ai)
#pragma unroll
            for (int m = 0; m < 4; ++m) { const float rs = ascale * rsv[ai][m];
                f32x4 g0 = acc[ai][0][m][0] * rs + bg0, g1 = acc[ai][0][m][1] * rs + bg1, u0 = acc[ai][1][m][0] * rs + bu0, u1 = acc[ai][1][m][1] * rs + bu1, a0, a1;
#pragma unroll
                for (int j = 0; j < 4; ++j) {
                    float g = fminf(g0[j], 7.0f), uu = __builtin_amdgcn_fmed3f(u0[j], -7.0f, 7.0f); a0[j] = (uu + 1.f) * (g * __builtin_amdgcn_rcpf(1.f + __builtin_amdgcn_exp2f(g * (-1.702f * 1.4426950408889634f)))) * oscale;
                    g = fminf(g1[j], 7.0f); uu = __builtin_amdgcn_fmed3f(u1[j], -7.0f, 7.0f); a1[j] = (uu + 1.f) * (g * __builtin_amdgcn_rcpf(1.f + __builtin_amdgcn_exp2f(g * (-1.702f * 1.4426950408889634f)))) * oscale; }
                u32x2 w; w.x = pk_fp8x4(a0[0], a0[1], a0[2], a0[3]); w.y = pk_fp8x4(a1[0], a1[1], a1[2], a1[3]);
                *(u32x2*)(O + (size_t)(row0 + ai * HALF + m * 16) * ldo + oc) = w; }
    }
};

struct EpiDown {
    static constexpr bool PERM = true, AFTER_DRAIN = false; static constexpr int MIDK = 0;
    unsigned char* O; int ldo; const float* bdn; const int* block_e; const float* rgate; float ascale, oscale;
    __device__ __forceinline__ void operator()(const f32x4 (&acc)[2][2][4][2], const Unit& u, int wr, int wc, int fr, int fq) const {
        const int row0 = u.pm * BM + wr * 64 + fr, col0 = u.pn * BM + wc * 32 + 8 * fq;
        const float* bb = bdn + (size_t)block_e[u.pm] * ldo + col0;
        f32x4 bv[2][2];
#pragma unroll
        for (int bj = 0; bj < 2; ++bj)
#pragma unroll
            for (int n = 0; n < 2; ++n) bv[bj][n] = *(const f32x4*)(bb + bj * HALF + 4 * n);
        float gtv[2][4];
#pragma unroll
        for (int ai = 0; ai < 2; ++ai)
#pragma unroll
            for (int m = 0; m < 4; ++m) gtv[ai][m] = rgate[row0 + ai * HALF + m * 16];
#pragma unroll
        for (int ai = 0; ai < 2; ++ai)
#pragma unroll
            for (int m = 0; m < 4; ++m) { const int row = row0 + ai * HALF + m * 16; const float gt = gtv[ai][m] * oscale;
#pragma unroll
                for (int bj = 0; bj < 2; ++bj) { const f32x4 v0 = (acc[ai][bj][m][0] * ascale + bv[bj][0]) * gt, v1 = (acc[ai][bj][m][1] * ascale + bv[bj][1]) * gt;
                    u32x2 w; w.x = pk_fp8x4(v0[0], v0[1], v0[2], v0[3]); w.y = pk_fp8x4(v1[0], v1[1], v1[2], v1[3]);
                    *(u32x2*)(O + (size_t)row * ldo + col0 + bj * HALF) = w; } }
    }
};

template <class Epi, class Sched, bool ALIGN_EPI = false, bool SP2 = false, bool FP8 = false>
__device__ __forceinline__ void gemm_phase(PG8_LAS unsigned char* lds, const Gemm g, const Sched& S, const Epi& E, const int wave_id, const int koff_in = 0) {
    int tid_ = wave_id * 64 + (int)__builtin_amdgcn_mbcnt_hi(~0u, __builtin_amdgcn_mbcnt_lo(~0u, 0u)); asm volatile("" : "+v"(tid_));
    const int tid = tid_, wid = __builtin_amdgcn_readfirstlane(tid >> 6), lane = tid & 63, wr = wid >> 2, wc = wid & 3, fr = lane & 15, fq = lane >> 4;
    const int K = g.K, nt = K / BK;
    const int koff = koff_in & (nt - 1) & ~1;
#define PG8_KO(i) ((size_t)(((i) + koff) & (nt - 1)) * kstep)
    unsigned voffA[2], voffB[2];
#pragma unroll
    for (int i = 0; i < 2; ++i) { int R, C; stage_rc(tid * 16 + i * 8192, R, C); const int Rb = Epi::PERM ? ((R & ~31) + perm32(R & 31)) : R;
        voffA[i] = (unsigned)(R * K + C) * 2u; voffB[i] = (unsigned)(Rb * K + C) * 2u; }
    const size_t kstep = (size_t)(BK * 2);
    const size_t hstep = (size_t)HALF * K * 2;
    const size_t tstep = 2 * hstep; (void)tstep;
    const unsigned ldsw = (unsigned)wid * 1024u;
    const int aoff = lds_byte(wr * 64 + fr, fq * 8), boff = lds_byte(wc * 32 + fr, fq * 8);
#define PG8_SA(b, h) (((b) * 2 + (h)) * HTB)
#define PG8_SB(b, h) ((4 + (b) * 2 + (h)) * HTB)
#define PG8_STAGE(bufoff, gbase, voff) do { _Pragma("unroll") for (int _i = 0; _i < 2; ++_i) \
        __builtin_amdgcn_global_load_lds((const unsigned*)((const char*)(gbase) + (voff)[_i]), (PG8_LAS unsigned*)(lds + (bufoff) + ldsw + _i * 8192), 16, 0, 0); } while (0)
#define PG8_LDA(dst, b, h) do { _Pragma("unroll") for (int m = 0; m < 4; ++m) _Pragma("unroll") for (int k = 0; k < 2; ++k) dst[m][k] = *(const PG8_LAS bf16x8*)(lds + PG8_SA(b, h) + aoff + m * 2048 + k * 1024); } while (0)
#define PG8_LDB(dst, b, h) do { _Pragma("unroll") for (int n = 0; n < 2; ++n) _Pragma("unroll") for (int k = 0; k < 2; ++k) dst[n][k] = *(const PG8_LAS bf16x8*)(lds + PG8_SB(b, h) + boff + n * 2048 + k * 1024); } while (0)
#define PG8_MMA(ai, bj, At, Bt) do { __builtin_amdgcn_s_setprio(1); _Pragma("unroll") for (int m = 0; m < 4; ++m) _Pragma("unroll") for (int n = 0; n < 2; ++n) { \
        if constexpr (FP8) { asm volatile("s_nop 1\n\tv_mfma_scale_f32_16x16x128_f8f6f4 %0, %1, %2, %0, %3, %3 op_sel_hi:[0,0,0]" : "+v"(acc[ai][bj][m][n]) : "v"(cat8(Bt[n][0], Bt[n][1])), "v"(cat8(At[m][0], At[m][1])), "v"(one_scale)); } \
        else { _Pragma("unroll") for (int k = 0; k < 2; ++k) acc[ai][bj][m][n] = __builtin_amdgcn_mfma_f32_16x16x32_bf16(Bt[n][k], At[m][k], acc[ai][bj][m][n], 0, 0, 0); } } \
        __builtin_amdgcn_s_setprio(0); } while (0)
#define PG8_WAIT_V(n) asm volatile("s_waitcnt vmcnt(" #n ")" ::: "memory")
#define PG8_WAIT_L(n) asm volatile("s_waitcnt lgkmcnt(" #n ")" ::: "memory")
#define PG8_BAR __builtin_amdgcn_s_barrier()
#define PG8_SCHED __builtin_amdgcn_sched_barrier(0)
    Unit cur, nxt; int ui = 0;
    if (!S.next(0, cur)) return;
#ifdef PG8_STAGGER
    { const int dly = ((int)blockIdx.x >> 3) & 3; for (int q = 0; q < dly; ++q) { __builtin_amdgcn_s_sleep(60); } }
#endif
    const int one_scale = 0x7F7F7F7F; (void)one_scale;
    f32x4 acc[2][2][4][2];
#pragma unroll
    for (int a = 0; a < 2; ++a)
#pragma unroll
        for (int b = 0; b < 2; ++b)
#pragma unroll
            for (int m = 0; m < 4; ++m)
#pragma unroll
                for (int n = 0; n < 2; ++n) acc[a][b][m][n] = (f32x4){0.f, 0.f, 0.f, 0.f};
    bf16x8 At[4][2], B0[2][2], B1[2][2];
    const char* cA = S.a_base(g, cur); const char* cB = S.b_base(g, cur);
    S.a_ready(cur);
    if constexpr (SP2) {
        PG8_STAGE(PG8_SB(0, 0), cB + PG8_KO(0), voffB); PG8_STAGE(PG8_SB(0, 1), cB + hstep + PG8_KO(0), voffB); PG8_STAGE(PG8_SA(0, 0), cA + PG8_KO(0), voffA); PG8_STAGE(PG8_SA(0, 1), cA + hstep + PG8_KO(0), voffA);
        if (wr == 1) PG8_BAR;
        PG8_WAIT_V(2); PG8_BAR;
        PG8_STAGE(PG8_SB(1, 0), cB + PG8_KO(1), voffB); PG8_STAGE(PG8_SA(1, 0), cA + PG8_KO(1), voffA); PG8_STAGE(PG8_SB(1, 1), cB + hstep + PG8_KO(1), voffB);
        PG8_WAIT_V(6); PG8_BAR;
    } else {
        PG8_STAGE(PG8_SB(0, 0), cB + PG8_KO(0), voffB); PG8_STAGE(PG8_SA(0, 0), cA + PG8_KO(0), voffA); PG8_STAGE(PG8_SB(0, 1), cB + hstep + PG8_KO(0), voffB); PG8_STAGE(PG8_SA(0, 1), cA + hstep + PG8_KO(0), voffA);
        if (wr == 1) PG8_BAR;
        PG8_WAIT_V(4); PG8_BAR;
        PG8_STAGE(PG8_SB(1, 0), cB + PG8_KO(1), voffB); PG8_STAGE(PG8_SA(1, 0), cA + PG8_KO(1), voffA); PG8_STAGE(PG8_SB(1, 1), cB + hstep + PG8_KO(1), voffB);
        PG8_WAIT_V(6); PG8_BAR;
    }
    for (;;) {
        const bool has_next = S.next(ui + 1, nxt);
        const char* nA = has_next ? S.a_base(g, nxt) : cA; const char* nB = has_next ? S.b_base(g, nxt) : cB;
        for (int t = 0; t < nt; t += 2) {
            const bool last = (t == nt - 2);
            const char* a1 = cA + PG8_KO(t + 1);
            const char* a2 = last ? nA + PG8_KO(0) : cA + PG8_KO(t + 2); const char* b2 = last ? nB + PG8_KO(0) : cB + PG8_KO(t + 2);
            const char* a3 = a2 + kstep; const char* b3 = b2 + kstep;
            if constexpr (Epi::MIDK > 0) { if (t == Epi::MIDK) { int lm = lane; asm volatile("" : "+v"(lm)); E.mid(acc, cur, wr, wc, lm & 15, lm >> 4); } }
            if (last && has_next) S.a_ready(nxt);
            if constexpr (SP2) {
            PG8_LDB(B0, 0, 0); PG8_LDB(B1, 0, 1); PG8_SCHED; PG8_LDA(At, 0, 0); PG8_STAGE(PG8_SA(1, 1), a1 + hstep, voffA);
            PG8_WAIT_V(8); PG8_WAIT_L(0); PG8_BAR; PG8_MMA(0, 0, At, B0); PG8_MMA(0, 1, At, B1); PG8_BAR; PG8_SCHED;
            PG8_LDA(At, 0, 1); PG8_STAGE(PG8_SB(0, 0), b2, voffB); PG8_STAGE(PG8_SB(0, 1), b2 + hstep, voffB); PG8_STAGE(PG8_SA(0, 0), a2, voffA);
            PG8_WAIT_V(8); PG8_WAIT_L(0); PG8_BAR; PG8_MMA(1, 0, At, B0); PG8_MMA(1, 1, At, B1); PG8_BAR; PG8_SCHED;
            PG8_LDB(B0, 1, 0); PG8_LDB(B1, 1, 1); PG8_SCHED; PG8_LDA(At, 1, 0); PG8_STAGE(PG8_SA(0, 1), a2 + hstep, voffA);
            PG8_WAIT_V(8); PG8_WAIT_L(0); PG8_BAR; PG8_MMA(0, 0, At, B0); PG8_MMA(0, 1, At, B1); PG8_BAR; PG8_SCHED;
            PG8_LDA(At, 1, 1); PG8_STAGE(PG8_SB(1, 0), b3, voffB); PG8_STAGE(PG8_SB(1, 1), b3 + hstep, voffB); PG8_STAGE(PG8_SA(1, 0), a3, voffA);
            PG8_WAIT_V(8); PG8_WAIT_L(0); PG8_BAR; PG8_MMA(1, 0, At, B0); PG8_MMA(1, 1, At, B1); PG8_BAR; PG8_SCHED;
            } else {
            PG8_LDB(B0, 0, 0); PG8_SCHED; PG8_LDA(At, 0, 0); PG8_STAGE(PG8_SA(1, 1), a1 + hstep, voffA);
            PG8_WAIT_L(8); PG8_BAR; PG8_WAIT_L(0); PG8_MMA(0, 0, At, B0); PG8_BAR; PG8_SCHED;
            PG8_LDB(B1, 0, 1); PG8_STAGE(PG8_SB(0, 0), b2, voffB);
            PG8_BAR; PG8_WAIT_L(0); PG8_MMA(0, 1, At, B1); PG8_BAR;
            PG8_LDA(At, 0, 1); PG8_STAGE(PG8_SA(0, 0), a2, voffA);
            PG8_BAR; PG8_WAIT_L(0); PG8_MMA(1, 0, At, B0); PG8_BAR; PG8_SCHED;
            PG8_STAGE(PG8_SB(0, 1), b2 + hstep, voffB);
            PG8_WAIT_V(6); PG8_BAR; PG8_MMA(1, 1, At, B1); PG8_BAR;
            PG8_LDB(B0, 1, 0); PG8_SCHED; PG8_LDA(At, 1, 0); PG8_STAGE(PG8_SA(0, 1), a2 + hstep, voffA);
            PG8_WAIT_L(8); PG8_BAR; PG8_WAIT_L(0); PG8_MMA(0, 0, At, B0); PG8_BAR; PG8_SCHED;
            PG8_LDB(B1, 1, 1); PG8_STAGE(PG8_SB(1, 0), b3, voffB);
            PG8_BAR; PG8_WAIT_L(0); PG8_MMA(0, 1, At, B1); PG8_BAR;
            PG8_LDA(At, 1, 1); PG8_STAGE(PG8_SA(1, 0), a3, voffA);
            PG8_BAR; PG8_WAIT_L(0); PG8_MMA(1, 0, At, B0); PG8_BAR; PG8_SCHED;
            PG8_STAGE(PG8_SB(1, 1), b3 + hstep, voffB);
            PG8_WAIT_V(6); PG8_BAR; PG8_MMA(1, 1, At, B1); PG8_BAR;
            }
        }
        if constexpr (FP8) { asm volatile("s_nop 15\n\ts_nop 15" ::: "memory"); }
        if constexpr (ALIGN_EPI) { if (wr == 0) PG8_BAR; }
        if constexpr (!Epi::AFTER_DRAIN) { int lz = lane; asm volatile("" : "+v"(lz));
            E(acc, cur, wr, wc, lz & 15, lz >> 4); S.done(cur); }
        if (!has_next) break;
#pragma unroll
        for (int a = 0; a < 2; ++a)
#pragma unroll
            for (int b = 0; b < 2; ++b)
#pragma unroll
                for (int m = 0; m < 4; ++m)
#pragma unroll
                    for (int n = 0; n < 2; ++n) acc[a][b][m][n] = (f32x4){0.f, 0.f, 0.f, 0.f};
        cur = nxt; cA = nA; cB = nB; ++ui;
        if constexpr (ALIGN_EPI) { if (wr == 1) PG8_BAR; }
    }
    PG8_WAIT_V(0);
    if constexpr (!ALIGN_EPI) { if (wr == 0) PG8_BAR; }
    PG8_BAR;
    if constexpr (Epi::AFTER_DRAIN) { E.fused(acc, cur, wr, wc, fr, fq, lds, wid, lane); S.done(cur); }
#undef PG8_KO
#undef PG8_SA
#undef PG8_SB
#undef PG8_STAGE
#undef PG8_LDA
#undef PG8_LDB
#undef PG8_MMA
#undef PG8_WAIT_V
#undef PG8_WAIT_L
#undef PG8_BAR
#undef PG8_SCHED
}
}

#define PROBE_MASK 0x0
constexpr int NWAVES = 8, NTHR = 512;
constexpr int BATCH = 2, SEQ = 8192, T = BATCH * SEQ, D = 2048;
constexpr int CHUNK = 64, NCH = SEQ / CHUNK;
constexpr int MH = 4, MD = 256, MW = 1024;
constexpr int AH = 16, AD = 64, AW = 1024;
constexpr int NMEM = 256, XH = 4, XD = 128, XW = 512;
constexpr int NE = 32, TOPK = 4, DFF = 2048, MOEB = 256;
constexpr int IN_COLS = 11272, NPROJ = 11264;
constexpr int NROWS_MAX = (T * TOPK / MOEB + NE) * MOEB;
constexpr int NBLK_MAX = NROWS_MAX / MOEB;
constexpr float EPS = 1e-6f;
constexpr float HSCALE = 16.f;
constexpr float WSCALE = 1024.f, XSCALE = 16.f, ASCALE = 8.f, YSCALE = 16.f;
constexpr int PQ_M = 0, PK_M = 1024, PV_M = 2048, PO_M = 3072, PQ_A = 4096, PK_A = 5120, PV_A = 6144, PG_M = 7168, PG_A = 9216;

constexpr size_t MiB = 1u << 20;
constexpr size_t al(size_t x) { return (x + MiB - 1) / MiB * MiB; }
constexpr size_t WS_CTL = 0, CTL_ZERO_BYTES = 1 * MiB;
constexpr size_t WS_WIN = WS_CTL + CTL_ZERO_BYTES;
constexpr size_t WS_WIN8 = WS_WIN + al((size_t)NPROJ * D * 2);
constexpr size_t WS_H8 = WS_WIN8 + al((size_t)3072 * D);
constexpr size_t WS_WBM = WS_H8 + al((size_t)T * D);
constexpr size_t WS_WBA = WS_WBM + al((size_t)D * MW * 2);
constexpr size_t WS_WOUT = WS_WBA + al((size_t)D * AW * 2);
constexpr size_t WS_WQ = WS_WOUT + al((size_t)D * D * 2);
constexpr size_t WS_WKV = WS_WQ + al((size_t)XW * D * 2);
constexpr size_t WS_WO = WS_WKV + al((size_t)2 * XW * D * 2);
constexpr size_t WS_WR = WS_WO + al((size_t)D * XW * 2);
constexpr size_t WS_WGU = WS_WR + al((size_t)256 * D * 2);
constexpr size_t WS_WDN = WS_WGU + al((size_t)NE * 2 * DFF * D);
constexpr size_t WS_H = WS_WDN + al((size_t)NE * D * DFF);
constexpr size_t WS_PROJ = WS_H + al((size_t)T * D * 2);
constexpr size_t WS_IFG = WS_PROJ + al((size_t)T * NPROJ * 2);
constexpr size_t WS_QKC = WS_IFG + al((size_t)T * 8 * 4);
constexpr size_t WS_BCUM = WS_QKC + al((size_t)T * 2048 * 2);
constexpr size_t WS_CLOC = WS_BCUM + al((size_t)T * 4 * 4);
constexpr size_t WS_CIN = WS_CLOC + al((size_t)1024 * 65536 * 2);
constexpr size_t WS_NLOC = WS_CIN + al((size_t)1024 * 65536 * 2);
constexpr size_t WS_NIN = WS_NLOC + al((size_t)1024 * 256 * 4);
constexpr size_t WS_CHS = WS_NIN + al((size_t)1024 * 256 * 4);
constexpr size_t WS_HM = WS_CHS + MiB;
constexpr size_t WS_YA = WS_HM + al((size_t)T * MW * 2);
constexpr size_t WS_T1 = WS_YA + al((size_t)T * AW * 2);
constexpr size_t WS_MRG = WS_T1 + al((size_t)T * D * 2);
constexpr size_t WS_X1 = WS_MRG + al((size_t)T * D * 2);
constexpr size_t WS_XN1 = WS_X1 + al((size_t)T * D * 4);
constexpr size_t WS_SSQ1 = WS_XN1 + al((size_t)T * D * 2);
constexpr size_t WS_MEMN = WS_SSQ1 + al((size_t)T * 32 * 4);
constexpr size_t WS_KVX = WS_MEMN + al((size_t)512 * D * 2);
constexpr size_t WS_QX = WS_KVX + al((size_t)512 * 1024 * 2);
constexpr size_t WS_OX = WS_QX + al((size_t)T * XW * 2);
constexpr size_t WS_X2 = WS_OX + al((size_t)T * XW * 2);
constexpr size_t WS_XN3 = WS_X2 + al((size_t)T * D * 4);
constexpr size_t WS_LOG = WS_XN3 + al((size_t)T * D * 2);
constexpr size_t WS_TOPE = WS_LOG + al((size_t)T * 256 * 4);
constexpr size_t WS_GATE = WS_TOPE + al((size_t)T * 4 * 4);
constexpr size_t WS_RANK = WS_GATE + al((size_t)T * 4 * 4);
constexpr size_t WS_DEST = WS_RANK + al((size_t)T * 4 * 4);
constexpr size_t WS_RGATE = WS_DEST + al((size_t)T * 4 * 4);
constexpr size_t WS_RROW = WS_RGATE + al((size_t)NROWS_MAX * 4);
constexpr size_t WS_RSTD = WS_RROW + al((size_t)NROWS_MAX * 4);
constexpr size_t WS_XQ = WS_RSTD + al((size_t)T * 4);
constexpr size_t WS_XPERM = WS_XQ + al((size_t)T * D);
constexpr size_t WS_ACT = WS_XPERM + al((size_t)NROWS_MAX * D);
constexpr size_t WS_YR = WS_ACT + al((size_t)NROWS_MAX * DFF);
constexpr size_t WS_END = WS_YR + al((size_t)NROWS_MAX * D * 2);
constexpr int CW_BAR = 4096;
constexpr int CW_HIST = 16384;
constexpr int CW_BLKE = 32768;
constexpr int CW_NBLK = 33792;

constexpr int RING_OFF = 0, RING_BYTES = 131072;
constexpr int LDSCTL_OFF = RING_BYTES, MISC_OFF = LDSCTL_OFF + 320;
constexpr int LDS_BYTES = 147456;

#define GAS __attribute__((address_space(1)))
#define LAS __attribute__((address_space(3)))
typedef unsigned short bf16;
typedef unsigned v4u __attribute__((ext_vector_type(4)));
typedef unsigned v2u __attribute__((ext_vector_type(2)));
typedef float f32x4 __attribute__((ext_vector_type(4)));
typedef float f32x16 __attribute__((ext_vector_type(16)));
typedef float f32x2 __attribute__((ext_vector_type(2)));
typedef short bf16x8 __attribute__((ext_vector_type(8)));
typedef short bf16x4 __attribute__((ext_vector_type(4)));
typedef GAS unsigned gu32;
#define RLX_AGENT __ATOMIC_RELAXED, __HIP_MEMORY_SCOPE_AGENT
#define LDS_WAIT() asm volatile("s_waitcnt lgkmcnt(0)" ::: "memory")
#define VM_WAIT() asm volatile("s_waitcnt vmcnt(0)" ::: "memory")
__device__ __forceinline__ unsigned pk2(float lo, float hi) { return pg8::cvt_pk_bf16_c(lo, hi); }
__device__ __forceinline__ float bflo(unsigned w) { return __builtin_bit_cast(float, w << 16); }
__device__ __forceinline__ float bfhi(unsigned w) { return __builtin_bit_cast(float, w & 0xffff0000u); }
__device__ __forceinline__ float bf1(bf16 h) { return __builtin_bit_cast(float, ((unsigned)h) << 16); }
__device__ __forceinline__ bf16 f2bf(float f) { return (bf16)(pk2(f, 0.f) & 0xffffu); }
__device__ __forceinline__ float sigm(float x) { return __builtin_amdgcn_rcpf(1.f + __expf(-x)); }
__device__ __forceinline__ f32x16 mfma32(bf16x8 a, bf16x8 b, f32x16 c) { return __builtin_amdgcn_mfma_f32_32x32x16_bf16(a, b, c, 0, 0, 0); }
__device__ __forceinline__ void lds_addf(LAS float* p, float v) { (void)__hip_atomic_fetch_add(p, v, __ATOMIC_RELAXED, __HIP_MEMORY_SCOPE_WORKGROUP); }
__device__ __forceinline__ int lds_addi(LAS int* p, int v) { return __hip_atomic_fetch_add(p, v, __ATOMIC_RELAXED, __HIP_MEMORY_SCOPE_WORKGROUP); }
__device__ __forceinline__ float wave_sum(float v) {
#pragma unroll
    for (int o = 1; o < 64; o <<= 1) v += __shfl_xor(v, o);
    return v;
}
__device__ __forceinline__ float wave_max(float v) {
#pragma unroll
    for (int o = 1; o < 64; o <<= 1) v = fmaxf(v, __shfl_xor(v, o));
    return v;
}

#define XB_TMO      128
#define XB_XCNT(j)  (256  + 64 * (j))
#define XB_XSUB(j)  (1280 + 64 * (j))
#define XB_XGEN(j)  (2304 + 64 * (j))
#define XB_TOP      3328
#define XB_TOPGEN   3392
#define XCD_BAR_WORDS 3456
#define XB_SPIN_CAP (1u << 18)
__device__ __forceinline__ unsigned xb_ld(unsigned* p)              { return __hip_atomic_load(p, __ATOMIC_RELAXED, __HIP_MEMORY_SCOPE_AGENT); }
__device__ __forceinline__ unsigned xb_add(unsigned* p, unsigned v) { return __hip_atomic_fetch_add(p, v, __ATOMIC_RELAXED, __HIP_MEMORY_SCOPE_AGENT); }
__device__ __forceinline__ unsigned xb_xcc_id() { return (unsigned)__builtin_amdgcn_s_getreg((3 << 11) | 20) & 0xFu; }
#define XB_SPIN(cond, bar) do { unsigned _sp = 0; while (cond) { __builtin_amdgcn_s_sleep(1); \
    if ((++_sp & 255u) == 0u) { if (xb_ld(&(bar)[XB_TMO])) break; if (_sp > XB_SPIN_CAP) { atomicAdd(&(bar)[XB_TMO], 1u); break; } } } } while (0)
struct XcdBarrier { unsigned* bar; unsigned x; volatile LAS unsigned* st; };
__device__ __forceinline__ XcdBarrier xcd_barrier_post(unsigned* bar, volatile LAS unsigned* st, int tid0) {
    XcdBarrier b; b.bar = bar; b.x = xb_xcc_id(); b.st = st;
    if (tid0 == 0) (void)xb_add(&bar[XB_XCNT(b.x)], 1u);
    return b;
}
__device__ __forceinline__ void xcd_barrier_complete(unsigned* bar, unsigned x, unsigned& nloc, unsigned& nx) {
    const unsigned G = gridDim.x * gridDim.y * gridDim.z;
    unsigned sum, cnt, mine, sp = 0u;
    for (;;) {
        sum = 0u; cnt = 0u; mine = 0u;
#pragma unroll
        for (unsigned j = 0; j < 16; ++j) { const unsigned c = xb_ld(&bar[XB_XCNT(j)]); sum += c; cnt += (c > 0u) ? 1u : 0u; mine = (j == x) ? c : mine; }
        if (sum == G) break;
        __builtin_amdgcn_s_sleep(1);
        if ((++sp & 255u) == 0u) { if (xb_ld(&bar[XB_TMO])) break; if (sp > XB_SPIN_CAP) { atomicAdd(&bar[XB_TMO], 1u); break; } }
    }
    nloc = mine > 0u ? mine : 1u; nx = cnt > 0u ? cnt : 1u;
}
__device__ __forceinline__ void xcd_barrier(const XcdBarrier& b, int tid0) {
    asm volatile("s_waitcnt vmcnt(0)" ::: "memory");
    __syncthreads();
    if (tid0 == 0) {
        unsigned* bar = b.bar;
        __builtin_amdgcn_s_waitcnt(0);
        unsigned nloc = b.st[0], nx = b.st[1];
        if (nloc == 0u) { xcd_barrier_complete(bar, b.x, nloc, nx); b.st[0] = nloc; b.st[1] = nx; }
        const unsigned old = xb_add(&bar[XB_XSUB(b.x)], 1u);
        const unsigned gen = old / nloc;
        if (old + 1u == (gen + 1u) * nloc) {
            __builtin_amdgcn_fence(__ATOMIC_RELEASE, "agent");
            asm volatile("s_waitcnt vmcnt(0)" ::: "memory");
            const unsigned og = xb_add(&bar[XB_TOP], 1u);
            const unsigned tg = og / nx;
            if (og + 1u == (tg + 1u) * nx) xb_add(&bar[XB_TOPGEN], 1u);
            else XB_SPIN(xb_ld(&bar[XB_TOPGEN]) == tg, bar);
            __builtin_amdgcn_fence(__ATOMIC_ACQUIRE, "agent");
            xb_add(&bar[XB_XGEN(b.x)], 1u);
            asm volatile("s_waitcnt vmcnt(0)" ::: "memory");
        } else {
            XB_SPIN(xb_ld(&bar[XB_XGEN(b.x)]) == gen, bar);
            __builtin_amdgcn_fence(__ATOMIC_ACQUIRE, "agent");
            asm volatile("s_waitcnt vmcnt(0)" ::: "memory");
        }
    }
    __syncthreads();
}

struct Frame {
    LAS unsigned char* lds;
    int tid, lane, wave, G, vcu;
    unsigned char* ws;
    const float* in[25];
    float* out;
};
enum { I_X = 0, I_MEM, I_NMIXW, I_WIN, I_CONVW, I_CONVB, I_IFB, I_MHNW, I_WBM, I_WBA, I_REL, I_WOUT, I_NXW, I_NMEMW, I_WQ, I_WKV, I_WO, I_NFFNW,
       I_WR, I_BR, I_WGU, I_BGU, I_WDN, I_BDN, I_FNW };

__device__ __forceinline__ int fresh_lane() { int l = (int)__builtin_amdgcn_mbcnt_hi(~0u, __builtin_amdgcn_mbcnt_lo(~0u, 0u)); asm volatile("" : "+v"(l)); return l; }
__device__ __forceinline__ void frame_ids(Frame& F) {
    const int l = fresh_lane(); F.lane = l; F.tid = F.wave * 64 + l;
}

__device__ __forceinline__ void transpose_item(const float* W, int ldw, int src_col0, int k0, bf16* WT, int K, int dest_row0, LAS float* scr, int lane) {
    float rv[32];
#pragma unroll
    for (int i = 0; i < 32; ++i) { const int kk = 2 * i + (lane >> 5); rv[i] = W[(size_t)(k0 + kk) * ldw + src_col0 + (lane & 31)]; }
#pragma unroll
    for (int i = 0; i < 32; ++i) { const int kk = 2 * i + (lane >> 5); scr[kk * 33 + (lane & 31)] = rv[i]; }
    LDS_WAIT(); asm volatile("" ::: "memory");
    const int c = lane & 7;
#pragma unroll
    for (int j = 0; j < 4; ++j) { const int n = (lane >> 3) + 8 * j; const LAS float* s = scr + (8 * c) * 33 + n;
        v4u o; o.x = pk2(s[0 * 33], s[1 * 33]); o.y = pk2(s[2 * 33], s[3 * 33]); o.z = pk2(s[4 * 33], s[5 * 33]); o.w = pk2(s[6 * 33], s[7 * 33]);
        *(GAS v4u*)(WT + (size_t)(dest_row0 + n) * K + k0 + 8 * c) = o; }
    LDS_WAIT(); asm volatile("" ::: "memory");
}
struct Fp8Job { const float* src; unsigned char* dst; int ldw, K; };
__device__ __forceinline__ Fp8Job fp8_job(const Frame& F, int r) {
    constexpr int I_GU1 = 32 * 128, I_DN1 = 32 * 64;
    Fp8Job j;
    if (r < NE * I_GU1) { const int e = r / I_GU1, q = r % I_GU1, kb = q / 128, sb = q % 128;
        const int sc0 = 32 * sb, bj = sc0 / DFF, cc = sc0 % DFF, dest = (cc / 128) * 256 + bj * 128 + (cc % 128);
        j.src = F.in[I_WGU] + (size_t)e * D * (2 * DFF) + (size_t)(64 * kb) * (2 * DFF) + sc0; j.ldw = 2 * DFF;
        j.dst = (unsigned char*)(F.ws + WS_WGU) + (size_t)e * (2 * DFF) * D + (size_t)dest * D + 64 * kb; j.K = D; }
    else { r -= NE * I_GU1; const int e = r / I_DN1, q = r % I_DN1, kb = q / 64, nb = q % 64;
        j.src = F.in[I_WDN] + (size_t)e * DFF * D + (size_t)(64 * kb) * D + 32 * nb; j.ldw = D;
        j.dst = (unsigned char*)(F.ws + WS_WDN) + (size_t)e * D * DFF + (size_t)(32 * nb) * DFF + 64 * kb; j.K = DFF; }
    return j;
}
__device__ __forceinline__ void fp8_item_load(const Fp8Job& j, f32x4 (&rv)[8], int lane) {
    const float* p = j.src + (size_t)(lane >> 3) * j.ldw + 4 * (lane & 7);
#pragma unroll
    for (int i = 0; i < 8; ++i) rv[i] = *(const GAS f32x4*)(p + (size_t)(8 * i) * j.ldw);
}
__device__ __forceinline__ void fp8_item_store(const Fp8Job& j, const f32x4 (&rv)[8], LAS float* scr, int lane) {
#pragma unroll
    for (int i = 0; i < 8; ++i) { LAS float* d = scr + (8 * i + (lane >> 3)) * 33 + 4 * (lane & 7); d[0] = rv[i].x; d[1] = rv[i].y; d[2] = rv[i].z; d[3] = rv[i].w; }
    LDS_WAIT(); asm volatile("" ::: "memory");
    const int c = lane >> 4;
#pragma unroll
    for (int jn = 0; jn < 2; ++jn) { const int n = (lane & 15) + 16 * jn; const LAS float* s = scr + (16 * c) * 33 + n;
        v4u o; o.x = pg8::pk_fp8x4(s[0 * 33] * WSCALE, s[1 * 33] * WSCALE, s[2 * 33] * WSCALE, s[3 * 33] * WSCALE); o.y = pg8::pk_fp8x4(s[4 * 33] * WSCALE, s[5 * 33] * WSCALE, s[6 * 33] * WSCALE, s[7 * 33] * WSCALE);
        o.z = pg8::pk_fp8x4(s[8 * 33] * WSCALE, s[9 * 33] * WSCALE, s[10 * 33] * WSCALE, s[11 * 33] * WSCALE); o.w = pg8::pk_fp8x4(s[12 * 33] * WSCALE, s[13 * 33] * WSCALE, s[14 * 33] * WSCALE, s[15 * 33] * WSCALE);
        *(GAS v4u*)(j.dst + (size_t)n * j.K + 16 * c) = o; }
    LDS_WAIT(); asm volatile("" ::: "memory");
}
__device__ __forceinline__ void tr_dense(const float* W, int K, int N, bf16* WT, LAS float* scr, int item, int lane) {
    const int nblk = N / 32, kb = item / nblk, nb = item % nblk;
    transpose_item(W, N, 32 * nb, 64 * kb, WT, K, 32 * nb, scr, lane);
}
__device__ __forceinline__ void rms_row_to_bf16(const float* xrow, const float* w, bf16* orow, int lane) {
    const GAS f32x4* xr = (const GAS f32x4*)xrow + lane;
    f32x4 v[8]; float s = 0.f;
#pragma unroll
    for (int j = 0; j < 8; ++j) { v[j] = xr[64 * j]; s += (v[j].x * v[j].x + v[j].y * v[j].y) + (v[j].z * v[j].z + v[j].w * v[j].w); }
    const float rstd = 1.f / sqrtf(wave_sum(s) * (1.f / D) + EPS);
    const GAS f32x4* wr = (const GAS f32x4*)w + lane;
    GAS v2u* o8 = (GAS v2u*)orow + lane;
#pragma unroll
    for (int j = 0; j < 8; ++j) { const f32x4 ww = wr[64 * j]; v2u o; o.x = pk2(v[j].x * rstd * ww.x, v[j].y * rstd * ww.y); o.y = pk2(v[j].z * rstd * ww.z, v[j].w * rstd * ww.w); o8[64 * j] = o; }
}

struct TJob { const float* src; unsigned char* dst; const float* kscale; int ldw, Kd, rowmap, fp8; };
constexpr int T_IN = 16 * 44, T_BM = 8 * 8, T_BA = 8 * 8, T_OUT = 16 * 8, T_Q = 16 * 2, T_KV = 16 * 4, T_O = 4 * 8, T_GU = 16 * 16, T_DN = 16 * 8;
constexpr int NT_SMALL = T_IN + T_BM + T_BA + T_OUT + T_Q + T_KV + T_O, NTILES = NT_SMALL + NE * (T_GU + T_DN);
constexpr int LATE_WG = 120, NT_LATE = LATE_WG * 8;
__device__ __forceinline__ TJob tile_job(const Frame& F, int r) {
    TJob j; j.rowmap = 0; j.fp8 = 0; j.kscale = nullptr;
#define TJ_DENSE(W_, Kk, Nn, DST_) { const int nbn = (Nn) / 256, kb = r / nbn, nb = r % nbn; j.src = (W_) + (size_t)(128 * kb) * (Nn) + 256 * nb; j.ldw = (Nn); \
        j.dst = (unsigned char*)(F.ws + (DST_)) + ((size_t)(256 * nb) * (Kk) + 128 * kb) * 2; j.Kd = (Kk); return j; }
    if (r < T_IN) { const int kb = r / 44, nb = r % 44, n0 = 256 * nb; j.src = F.in[I_WIN] + (size_t)(128 * kb) * IN_COLS + n0 + (n0 >= 4096 ? 8 : 0); j.ldw = IN_COLS; j.Kd = D;
        if (nb >= 16 && nb < 28) { const int t8 = nb - 16; j.fp8 = 1; j.dst = (unsigned char*)(F.ws + WS_WIN8) + (size_t)(256 * t8) * D + 128 * kb; }
        else j.dst = (unsigned char*)(F.ws + WS_WIN) + ((size_t)n0 * D + 128 * kb) * 2;
        return j; } r -= T_IN;
    if (r < T_BM) { const int kb = r / 8, nb = r % 8; j.src = F.in[I_WBM] + (size_t)(128 * kb) * D + 256 * nb; j.ldw = D; j.dst = (unsigned char*)(F.ws + WS_WBM) + ((size_t)(256 * nb) * 2048 + 128 * kb) * 2; j.Kd = 2048; return j; } r -= T_BM;
    if (r < T_BA) { const int kb = r / 8, nb = r % 8; j.src = F.in[I_WBA] + (size_t)(128 * kb) * D + 256 * nb; j.ldw = D; j.dst = (unsigned char*)(F.ws + WS_WBM) + ((size_t)(256 * nb) * 2048 + 1024 + 128 * kb) * 2; j.Kd = 2048; return j; } r -= T_BA;
    if (r < T_OUT) TJ_DENSE(F.in[I_WOUT], D, D, WS_WOUT) r -= T_OUT;
    if (r < T_Q) { const int kb = r / 2, nb = r % 2; j.src = F.in[I_WQ] + (size_t)(128 * kb) * XW + 256 * nb; j.ldw = XW; j.dst = (unsigned char*)(F.ws + WS_WQ) + ((size_t)(256 * nb) * D + 128 * kb) * 2; j.Kd = D; j.kscale = F.in[I_NXW] + 128 * kb; return j; } r -= T_Q;
    if (r < T_KV) TJ_DENSE(F.in[I_WKV], D, 2 * XW, WS_WKV) r -= T_KV;
    if (r < T_O) TJ_DENSE(F.in[I_WO], XW, D, WS_WO) r -= T_O;
#undef TJ_DENSE
    j.fp8 = 1;
    if (r < NE * T_GU) { const int e = r / T_GU, q = r % T_GU, kb = q / 16, nb = q % 16; j.src = F.in[I_WGU] + (size_t)e * D * (2 * DFF) + (size_t)(128 * kb) * (2 * DFF) + 256 * nb; j.ldw = 2 * DFF;
        j.dst = (unsigned char*)(F.ws + WS_WGU) + (size_t)e * (2 * DFF) * D + 128 * kb; j.Kd = D; j.rowmap = 1 + 256 * nb; return j; }
    r -= NE * T_GU;
    { const int e = r / T_DN, q = r % T_DN, kb = q / 8, nb = q % 8; j.src = F.in[I_WDN] + (size_t)e * DFF * D + (size_t)(128 * kb) * D + 256 * nb; j.ldw = D;
        j.dst = (unsigned char*)(F.ws + WS_WDN) + (size_t)e * D * DFF + (size_t)(256 * nb) * DFF + 128 * kb; j.Kd = DFF; return j; }
}
__device__ __forceinline__ void tile_load(const TJob& j, f32x4 (&rv)[16], int tid) {
    const float* p = j.src + (size_t)(tid >> 6) * j.ldw + 4 * (tid & 63);
#pragma unroll
    for (int i = 0; i < 16; ++i) rv[i] = __builtin_nontemporal_load((const GAS f32x4*)(p + (size_t)(8 * i) * j.ldw));
}

__device__ __forceinline__ void weight_tiles(Frame& F, int t0, int t1, int wi, int nw, const bool rev = false) {
#define WT_IDX(x) (rev ? (t0 + t1 - 1 - (x)) : (x))
        LAS float* tile = (LAS float*)(F.lds + RING_OFF);
        f32x4 rv[16], rn[16];
        int tt = t0 + wi;
        if (tt < t1) { const TJob j = tile_job(F, WT_IDX(tt)); tile_load(j, rv, F.tid); }
        for (; tt < t1; tt += nw) {
#pragma unroll
            for (int i = 0; i < 16; ++i) { const int k = (F.tid >> 6) + 8 * i, n4 = 4 * (F.tid & 63); *(LAS f32x4*)(tile + k * 256 + (n4 ^ (((k >> 4) & 7) << 2))) = rv[i]; }
            { const TJob jc = tile_job(F, WT_IDX(tt));
              if (jc.kscale) {
                  __syncthreads();
#pragma unroll
                  for (int i = 0; i < 16; ++i) { const int k = (F.tid >> 6) + 8 * i, n4 = 4 * (F.tid & 63); LAS f32x4* p = (LAS f32x4*)(tile + k * 256 + (n4 ^ (((k >> 4) & 7) << 2))); *p = *p * jc.kscale[k]; } } }
            __syncthreads();
            const bool more = tt + nw < t1;
            if (more) { const TJob jn = tile_job(F, WT_IDX(tt + nw)); tile_load(jn, rn, F.tid); }
            const TJob j = tile_job(F, WT_IDX(tt));
#pragma unroll
            for (int i = 0; i < 4; ++i) { const int p = F.tid + NTHR * i, c = p & 7, n = p >> 3;
                const LAS float* s = tile + (16 * c) * 256 + (n ^ (c << 2));
                size_t drow;
                if (j.rowmap) { const int sc = (j.rowmap - 1) + n, bj = sc / DFF, cc = sc % DFF; drow = (size_t)((cc / 128) * 256 + bj * 128 + (cc % 128)); } else drow = (size_t)n;
                if (j.fp8) {
                    v4u o; o.x = pg8::pk_fp8x4(s[0 * 256] * WSCALE, s[1 * 256] * WSCALE, s[2 * 256] * WSCALE, s[3 * 256] * WSCALE); o.y = pg8::pk_fp8x4(s[4 * 256] * WSCALE, s[5 * 256] * WSCALE, s[6 * 256] * WSCALE, s[7 * 256] * WSCALE);
                    o.z = pg8::pk_fp8x4(s[8 * 256] * WSCALE, s[9 * 256] * WSCALE, s[10 * 256] * WSCALE, s[11 * 256] * WSCALE); o.w = pg8::pk_fp8x4(s[12 * 256] * WSCALE, s[13 * 256] * WSCALE, s[14 * 256] * WSCALE, s[15 * 256] * WSCALE);
                    *(GAS v4u*)(j.dst + drow * j.Kd + 16 * c) = o;
                } else {
                    v4u o0, o1; o0.x = pk2(s[0 * 256], s[1 * 256]); o0.y = pk2(s[2 * 256], s[3 * 256]); o0.z = pk2(s[4 * 256], s[5 * 256]); o0.w = pk2(s[6 * 256], s[7 * 256]);
                    o1.x = pk2(s[8 * 256], s[9 * 256]); o1.y = pk2(s[10 * 256], s[11 * 256]); o1.z = pk2(s[12 * 256], s[13 * 256]); o1.w = pk2(s[14 * 256], s[15 * 256]);
                    GAS v4u* o = (GAS v4u*)(j.dst + (drow * j.Kd + 16 * c) * 2); o[0] = o0; o[1] = o1;
                } }
            __syncthreads();
            if (more) {
#pragma unroll
                for (int i = 0; i < 16; ++i) rv[i] = rn[i]; }
        }
#undef WT_IDX
}

__device__ __forceinline__ void p0_prologue(Frame& F) {
    frame_ids(F);
    const int gw = F.vcu * NWAVES + F.wave, NGW = F.G * NWAVES;
    bf16* WIN = (bf16*)(F.ws + WS_WIN);
    {
        LAS float* scr = (LAS float*)(F.lds + RING_OFF + F.wave * 16384);
        for (int it = gw; it < 32; it += NGW) tr_dense(F.in[I_WR], D, NE, (bf16*)(F.ws + WS_WR), scr, it, F.lane);
        __syncthreads();
        weight_tiles(F, 0, NTILES - NT_LATE, F.vcu, F.G, true);
    }
    __syncthreads();
    {
        LAS float* wg = (LAS float*)(F.lds + RING_OFF);
        for (int i = F.tid; i < 8 * D; i += NTHR) { const int k = i >> 3, g = i & 7; wg[g * D + k] = F.in[I_WIN][(size_t)k * IN_COLS + 4096 + g]; }
        __syncthreads();
        bf16* H = (bf16*)(F.ws + WS_H); float* IFG = (float*)(F.ws + WS_IFG);
        const float* nw = F.in[I_NMIXW];
        for (int m = gw; m < T; m += NGW) {
            const GAS f32x4* xr = (const GAS f32x4*)(F.in[I_X] + (size_t)m * D) + F.lane;
            f32x4 v[8]; float s = 0.f;
#pragma unroll
            for (int j = 0; j < 8; ++j) { v[j] = __builtin_nontemporal_load(xr + 64 * j); s += (v[j].x * v[j].x + v[j].y * v[j].y) + (v[j].z * v[j].z + v[j].w * v[j].w); }
            const float rstd = 1.f / sqrtf(wave_sum(s) * (1.f / D) + EPS);
            const GAS f32x4* wr = (const GAS f32x4*)nw + F.lane;
            GAS v2u* o8 = (GAS v2u*)(H + (size_t)m * D) + F.lane; GAS unsigned* h8 = (GAS unsigned*)((unsigned char*)(F.ws + WS_H8) + (size_t)m * D) + F.lane;
#pragma unroll
            for (int j = 0; j < 8; ++j) { const f32x4 ww = wr[64 * j]; v[j].x *= rstd * ww.x; v[j].y *= rstd * ww.y; v[j].z *= rstd * ww.z; v[j].w *= rstd * ww.w;
                v2u o; o.x = pk2(v[j].x, v[j].y); o.y = pk2(v[j].z, v[j].w); o8[64 * j] = o;
                h8[64 * j] = pg8::pk_fp8x4(v[j].x * HSCALE, v[j].y * HSCALE, v[j].z * HSCALE, v[j].w * HSCALE); }
            float ga8[8];
#pragma unroll
            for (int g = 0; g < 8; ++g) ga8[g] = 0.f;
#pragma unroll 2
            for (int j = 0; j < 8; ++j)
#pragma unroll
                for (int g = 0; g < 8; ++g) { const f32x4 ww = *(const LAS f32x4*)(wg + g * D + 256 * j + 4 * F.lane); ga8[g] += (v[j].x * ww.x + v[j].y * ww.y) + (v[j].z * ww.z + v[j].w * ww.w); }
            { const bool h5 = (F.lane & 32) != 0, h4 = (F.lane & 16) != 0, h3 = (F.lane & 8) != 0; float b4[4], c2[2], d1;
#pragma unroll
              for (int i = 0; i < 4; ++i) { const float snd = h5 ? ga8[i] : ga8[i + 4], kp = h5 ? ga8[i + 4] : ga8[i]; b4[i] = kp + __shfl_xor(snd, 32); }
#pragma unroll
              for (int i = 0; i < 2; ++i) { const float snd = h4 ? b4[i] : b4[i + 2], kp = h4 ? b4[i + 2] : b4[i]; c2[i] = kp + __shfl_xor(snd, 16); }
              { const float snd = h3 ? c2[0] : c2[1], kp = h3 ? c2[1] : c2[0]; d1 = kp + __shfl_xor(snd, 8); }
              d1 += __shfl_xor(d1, 4); d1 += __shfl_xor(d1, 2); d1 += __shfl_xor(d1, 1);
              if ((F.lane & 7) == 0) { const int g = F.lane >> 3; IFG[(size_t)m * 8 + g] = d1 + F.in[I_IFB][g]; } }
        }
        bf16* MEMN = (bf16*)(F.ws + WS_MEMN);
        for (int m = gw; m < BATCH * NMEM; m += NGW) rms_row_to_bf16(F.in[I_MEM] + (size_t)m * D, F.in[I_NMEMW], MEMN + (size_t)m * D, F.lane);
        __syncthreads();
    }

}

__device__ __forceinline__ void p_conv(Frame& F) {
    frame_ids(F);
    const bf16* PROJ = (const bf16*)(F.ws + WS_PROJ); bf16* QKC = (bf16*)(F.ws + WS_QKC);
    const float* cw = F.in[I_CONVW]; const float* cb = F.in[I_CONVB];
    const int gt = F.vcu * NTHR + F.tid, NGT = F.G * NTHR;
    for (int q = gt; q < 256 * (T / 32); q += NGT) {
        const int c0 = (q & 255) * 8, t0 = (q >> 8) * 32, s0 = t0 & (SEQ - 1);
        float wgt[4][8], bias[8];
#pragma unroll
        for (int j = 0; j < 4; ++j) { const f32x4 w0 = *(const GAS f32x4*)(cw + j * 2048 + c0), w1 = *(const GAS f32x4*)(cw + j * 2048 + c0 + 4);
            wgt[j][0] = w0.x; wgt[j][1] = w0.y; wgt[j][2] = w0.z; wgt[j][3] = w0.w; wgt[j][4] = w1.x; wgt[j][5] = w1.y; wgt[j][6] = w1.z; wgt[j][7] = w1.w; }
        { const f32x4 b0 = *(const GAS f32x4*)(cb + c0), b1 = *(const GAS f32x4*)(cb + c0 + 4); bias[0] = b0.x; bias[1] = b0.y; bias[2] = b0.z; bias[3] = b0.w; bias[4] = b1.x; bias[5] = b1.y; bias[6] = b1.z; bias[7] = b1.w; }
        const float sc = (c0 >= 1024) ? 0.0625f : 1.f;
        const bf16* src = PROJ + (size_t)t0 * NPROJ + c0;
        v4u h0 = (v4u){0u, 0u, 0u, 0u}, h1 = h0, h2 = h0;
        if (s0 > 0) { h0 = *(const GAS v4u*)(src - 3 * (size_t)NPROJ); h1 = *(const GAS v4u*)(src - 2 * (size_t)NPROJ); h2 = *(const GAS v4u*)(src - (size_t)NPROJ); }
        for (int i0 = 0; i0 < 32; i0 += 8) {
            v4u rw[8];
#pragma unroll
            for (int i = 0; i < 8; ++i) rw[i] = *(const GAS v4u*)(src + (size_t)(i0 + i) * NPROJ);
#pragma unroll
            for (int i = 0; i < 8; ++i) { const v4u h3 = rw[i]; float a[8];
#pragma unroll
                for (int e = 0; e < 4; ++e) { const unsigned u0 = h0[e], u1 = h1[e], u2 = h2[e], u3 = h3[e];
                    a[2 * e] = bias[2 * e] + bflo(u0) * wgt[0][2 * e] + bflo(u1) * wgt[1][2 * e] + bflo(u2) * wgt[2][2 * e] + bflo(u3) * wgt[3][2 * e];
                    a[2 * e + 1] = bias[2 * e + 1] + bfhi(u0) * wgt[0][2 * e + 1] + bfhi(u1) * wgt[1][2 * e + 1] + bfhi(u2) * wgt[2][2 * e + 1] + bfhi(u3) * wgt[3][2 * e + 1]; }
#pragma unroll
                for (int e = 0; e < 8; ++e) a[e] = a[e] * sigm(a[e]) * sc;
                v4u o; o.x = pk2(a[0], a[1]); o.y = pk2(a[2], a[3]); o.z = pk2(a[4], a[5]); o.w = pk2(a[6], a[7]);
                *(GAS v4u*)(QKC + (size_t)(t0 + i0 + i) * 2048 + c0) = o;
                h0 = h1; h1 = h2; h2 = h3; }
        }
    }
}

constexpr int TP = 72;
__device__ __forceinline__ int tp_col(int c8, int s) { return c8 * TP + ((((s >> 3) ^ ((c8 >> 3) & 7)) << 3) | (s & 7)); }
__device__ __forceinline__ int tp_chunk(int r, int chunk) { return r * TP + ((chunk ^ ((r >> 3) & 7)) << 3); }
__device__ __forceinline__ void p_mlstm_local(Frame& F) {
    frame_ids(F);
    const bf16* PROJ = (const bf16*)(F.ws + WS_PROJ); const bf16* QKC = (const bf16*)(F.ws + WS_QKC); const float* IFG = (const float*)(F.ws + WS_IFG);
    float* BCUM = (float*)(F.ws + WS_BCUM); bf16* CLOC = (bf16*)(F.ws + WS_CLOC); float* NLOC = (float*)(F.ws + WS_NLOC);
    float* CHA = (float*)(F.ws + WS_CHS); float* CHG = CHA + 1024;
    LAS bf16* Kt = (LAS bf16*)(F.lds + RING_OFF);
    LAS bf16* Vt = Kt + 256 * TP;
    LAS float* es = (LAS float*)(Vt + 256 * TP);
    const int lane = F.lane, w = F.wave, hh = lane >> 5, l31 = lane & 31;
    v4u rk[4], rv[4]; float ipn = 0.f, fpn = 0.f;
#define ML_LOAD(uu) do { const int bh_ = (uu) >> 7, c_ = (uu) & 127, b_ = bh_ >> 2, h_ = bh_ & 3, t0_ = b_ * SEQ + c_ * CHUNK; \
        _Pragma("unroll") for (int i = 0; i < 4; ++i) { const int p = F.tid + NTHR * i, s = p >> 5, c8 = (p & 31) * 8; \
            rk[i] = *(const GAS v4u*)(QKC + (size_t)(t0_ + s) * 2048 + 1024 + h_ * 256 + c8); rv[i] = *(const GAS v4u*)(PROJ + (size_t)(t0_ + s) * NPROJ + PV_M + h_ * 256 + c8); } \
        if (w == 0) { ipn = IFG[(size_t)(t0_ + lane) * 8 + h_]; fpn = IFG[(size_t)(t0_ + lane) * 8 + 4 + h_]; } } while (0)
    if (F.vcu < 1024) ML_LOAD(F.vcu);
    for (int u = F.vcu; u < 1024; u += F.G) {
        const int bh = u >> 7, c = u & 127, b = bh >> 2, h = bh & 3, t0 = b * SEQ + c * CHUNK;
        if (w == 0) {
            const float ip = ipn, fp = fpn;
            const float lf = fminf(fp, 0.f) - log1pf(__expf(-fabsf(fp)));
            float bc = lf;
#pragma unroll
            for (int o = 1; o < 64; o <<= 1) { const float y = __shfl_up(bc, o); if (lane >= o) bc += y; }
            const float g = __shfl(bc, 63), we = g - bc + ip, a = wave_max(we);
            es[lane] = __expf(we - a);
            BCUM[(size_t)(t0 + lane) * 4 + h] = bc;
            if (lane == 0) { CHA[u] = a; CHG[u] = g; }
        }
        __syncthreads();
#pragma unroll
        for (int i = 0; i < 4; ++i) { const int p = F.tid + NTHR * i, s = p >> 5, c8 = (p & 31) * 8;
            const v4u kv = rk[i], vv = rv[i];
            const float e = es[s];
            LAS bf16* kd = Kt + tp_col(c8, s); LAS bf16* vd = Vt + tp_col(c8, s);
            kd[0 * TP] = (bf16)(kv.x & 0xffff); kd[1 * TP] = (bf16)(kv.x >> 16); kd[2 * TP] = (bf16)(kv.y & 0xffff); kd[3 * TP] = (bf16)(kv.y >> 16);
            kd[4 * TP] = (bf16)(kv.z & 0xffff); kd[5 * TP] = (bf16)(kv.z >> 16); kd[6 * TP] = (bf16)(kv.w & 0xffff); kd[7 * TP] = (bf16)(kv.w >> 16);
            vd[0 * TP] = f2bf(bflo(vv.x) * e); vd[1 * TP] = f2bf(bfhi(vv.x) * e); vd[2 * TP] = f2bf(bflo(vv.y) * e); vd[3 * TP] = f2bf(bfhi(vv.y) * e);
            vd[4 * TP] = f2bf(bflo(vv.z) * e); vd[5 * TP] = f2bf(bfhi(vv.z) * e); vd[6 * TP] = f2bf(bflo(vv.w) * e); vd[7 * TP] = f2bf(bfhi(vv.w) * e); }
        __syncthreads();
        if (u + F.G < 1024) ML_LOAD(u + F.G);
        bf16x8 af[4];
#pragma unroll
        for (int ks = 0; ks < 4; ++ks) af[ks] = *(const LAS bf16x8*)(Kt + tp_chunk(32 * w + l31, 2 * ks + hh));
        bf16* Cu = CLOC + (size_t)u * 65536;
#pragma unroll 2
        for (int ni = 0; ni < 8; ++ni) {
            f32x16 acc = {0.f, 0.f, 0.f, 0.f, 0.f, 0.f, 0.f, 0.f, 0.f, 0.f, 0.f, 0.f, 0.f, 0.f, 0.f, 0.f};
#pragma unroll
            for (int ks = 0; ks < 4; ++ks) { const bf16x8 bfr = *(const LAS bf16x8*)(Vt + tp_chunk(32 * ni + l31, 2 * ks + hh)); acc = mfma32(af[ks], bfr, acc); }
            const int v = 32 * ni + l31;
#pragma unroll
            for (int rg = 0; rg < 4; ++rg) { v2u o; o.x = pk2(acc[4 * rg], acc[4 * rg + 1]); o.y = pk2(acc[4 * rg + 2], acc[4 * rg + 3]);
                *(GAS v2u*)(Cu + (size_t)w * 8192 + v * 32 + 8 * rg + 4 * hh) = o; }
        }
        if (F.tid < 256) { float a = 0.f;
#pragma unroll
            for (int cch = 0; cch < 8; ++cch) { const v4u kq = *(const LAS v4u*)(Kt + tp_chunk(F.tid, cch)); const LAS float* e8 = es + 8 * cch;
                a += e8[0] * bflo(kq.x); a += e8[1] * bfhi(kq.x); a += e8[2] * bflo(kq.y); a += e8[3] * bfhi(kq.y); a += e8[4] * bflo(kq.z); a += e8[5] * bfhi(kq.z); a += e8[6] * bflo(kq.w); a += e8[7] * bfhi(kq.w); }
            NLOC[(size_t)u * 256 + F.tid] = a; }
        __syncthreads();
    }
#undef ML_LOAD
}

__device__ __forceinline__ void p_mlstm_scan(Frame& F) {
    frame_ids(F);
    const bf16* CLOC = (const bf16*)(F.ws + WS_CLOC); bf16* CIN = (bf16*)(F.ws + WS_CIN);
    const float* NLOC = (const float*)(F.ws + WS_NLOC); float* NIN = (float*)(F.ws + WS_NIN);
    const float* CHA = (const float*)(F.ws + WS_CHS); const float* CHG = CHA + 1024; float* CHM = (float*)(F.ws + WS_CHS) + 2048;
    const int gt = F.vcu * NTHR + F.tid, NGT = F.G * NTHR;
    if (F.tid < 8) { for (int q = F.vcu * 8 + F.tid; q < 8 * 256; q += F.G * 8) {
        const int bh = q >> 8, k = q & 255; float m = 0.f, n = 0.f;
        for (int c0 = 0; c0 < NCH; c0 += 32) { float nl[32], aa[32], gg[32];
#pragma unroll
            for (int i = 0; i < 32; ++i) { const int u = bh * NCH + c0 + i; nl[i] = NLOC[(size_t)u * 256 + k]; aa[i] = CHA[u]; gg[i] = CHG[u]; }
#pragma unroll
            for (int i = 0; i < 32; ++i) { const int u = bh * NCH + c0 + i;
                const float mn = fmaxf(gg[i] + m, aa[i]), sp = __expf(gg[i] + m - mn), sl = __expf(aa[i] - mn);
                NIN[(size_t)u * 256 + k] = n; n = sp * n + sl * nl[i]; m = mn; } } } }
    for (int q = gt; q < 8 * 16384; q += NGT) {
        const int bh = q >> 14; const size_t off = (size_t)(q & 16383) * 4;
        float m = 0.f, C0 = 0.f, C1 = 0.f, C2 = 0.f, C3 = 0.f;
        for (int c0 = 0; c0 < NCH; c0 += 16) {
            v2u cl[16]; float aa[16], gg[16];
#pragma unroll
            for (int i = 0; i < 16; ++i) { const int u = bh * NCH + c0 + i; cl[i] = *(const GAS v2u*)(CLOC + (size_t)u * 65536 + off); aa[i] = CHA[u]; gg[i] = CHG[u]; }
#pragma unroll
            for (int i = 0; i < 16; ++i) { const int u = bh * NCH + c0 + i;
                const float mn = fmaxf(gg[i] + m, aa[i]), sp = __expf(gg[i] + m - mn), sl = __expf(aa[i] - mn);
                v2u o; o.x = pk2(C0, C1); o.y = pk2(C2, C3);
                *(GAS v2u*)(CIN + (size_t)u * 65536 + off) = o;
                if (off == 0) CHM[u] = m;
                C0 = sp * C0 + sl * bflo(cl[i].x); C1 = sp * C1 + sl * bfhi(cl[i].x); C2 = sp * C2 + sl * bflo(cl[i].y); C3 = sp * C3 + sl * bfhi(cl[i].y);
                m = mn; }
        }
    }
}

constexpr int QP = 264;
__device__ __forceinline__ void p_mlstm_out(Frame& F) {
    frame_ids(F);
    const bf16* PROJ = (const bf16*)(F.ws + WS_PROJ); const bf16* QKC = (const bf16*)(F.ws + WS_QKC); const float* IFG = (const float*)(F.ws + WS_IFG);
    const float* BCUM = (const float*)(F.ws + WS_BCUM); const bf16* CIN = (const bf16*)(F.ws + WS_CIN); const float* NIN = (const float*)(F.ws + WS_NIN);
    const float* CHM = (const float*)(F.ws + WS_CHS) + 2048; bf16* HM = (bf16*)(F.ws + WS_HM); const float* hnw = F.in[I_MHNW];
    LAS bf16* Qs = (LAS bf16*)(F.lds + RING_OFF);
    LAS bf16* Ks = Qs + 64 * QP;
    LAS bf16* Vt = Ks + 64 * QP;
    LAS bf16* Sm = Vt + 256 * TP;
    LAS float* fb = (LAS float*)(Sm + 64 * TP);
    LAS float* fi = fb + 64; LAS float* fmj = fb + 128; LAS float* fwi = fb + 192; LAS float* dpart = fb + 256; LAS float* dint = fb + 384; LAS float* hpart = fb + 448;
    const int lane = F.lane, w = F.wave, hh = lane >> 5, l31 = lane & 31;
    v4u rq[4], rk[4], rv[4]; float bjn = 0.f, ijn = 0.f, minn = 0.f;
#define MO_LOAD(uu) do { const int bh_ = (uu) >> 7, c_ = (uu) & 127, b_ = bh_ >> 2, h_ = bh_ & 3, t0_ = b_ * SEQ + c_ * CHUNK; \
        _Pragma("unroll") for (int i = 0; i < 4; ++i) { const int p = F.tid + NTHR * i, s = p >> 5, c8 = (p & 31) * 8; \
            rq[i] = *(const GAS v4u*)(QKC + (size_t)(t0_ + s) * 2048 + h_ * 256 + c8); rk[i] = *(const GAS v4u*)(QKC + (size_t)(t0_ + s) * 2048 + 1024 + h_ * 256 + c8); \
            rv[i] = *(const GAS v4u*)(PROJ + (size_t)(t0_ + s) * NPROJ + PV_M + h_ * 256 + c8); } \
        if (w == 0) { bjn = BCUM[(size_t)(t0_ + lane) * 4 + h_]; ijn = IFG[(size_t)(t0_ + lane) * 8 + h_]; minn = CHM[(uu)]; } } while (0)
    if (F.vcu < 1024) MO_LOAD(F.vcu);
    for (int u = F.vcu; u < 1024; u += F.G) {
        const int bh = u >> 7, c = u & 127, b = bh >> 2, h = bh & 3, t0 = b * SEQ + c * CHUNK;
        bf16x8 cf[16];
        { const bf16* Cu = CIN + (size_t)u * 65536 + (size_t)(32 * w + l31) * 32 + 8 * hh;
#pragma unroll
            for (int ks = 0; ks < 16; ++ks) cf[ks] = *(const GAS bf16x8*)(Cu + (ks >> 1) * 8192 + 16 * (ks & 1)); }
#pragma unroll
        for (int i = 0; i < 4; ++i) { const int p = F.tid + NTHR * i, s = p >> 5, c8 = (p & 31) * 8;
            const v4u vv = rv[i];
            *(LAS v4u*)(Qs + s * QP + c8) = rq[i]; *(LAS v4u*)(Ks + s * QP + c8) = rk[i];
            LAS bf16* vd = Vt + tp_col(c8, s);
            vd[0 * TP] = (bf16)(vv.x & 0xffff); vd[1 * TP] = (bf16)(vv.x >> 16); vd[2 * TP] = (bf16)(vv.y & 0xffff); vd[3 * TP] = (bf16)(vv.y >> 16);
            vd[4 * TP] = (bf16)(vv.z & 0xffff); vd[5 * TP] = (bf16)(vv.z >> 16); vd[6 * TP] = (bf16)(vv.w & 0xffff); vd[7 * TP] = (bf16)(vv.w >> 16); }
        if (w == 0) {
            const float bj = bjn, ij = ijn, m_in = minn;
            float pm = ij - bj;
#pragma unroll
            for (int o = 1; o < 64; o <<= 1) { const float y = __shfl_up(pm, o); if (lane >= o) pm = fmaxf(pm, y); }
            const float il = bj + m_in, mj = fmaxf(il, bj + pm);
            fb[lane] = bj; fi[lane] = ij; fmj[lane] = mj; fwi[lane] = __expf(il - mj);
        }
        __syncthreads();
        if (u + F.G < 1024) MO_LOAD(u + F.G);
        if (w < 4) {
            const int tj = w >> 1, ts = w & 1;
            f32x16 acc = {0.f, 0.f, 0.f, 0.f, 0.f, 0.f, 0.f, 0.f, 0.f, 0.f, 0.f, 0.f, 0.f, 0.f, 0.f, 0.f};
#pragma unroll
            for (int ks = 0; ks < 16; ++ks) { const bf16x8 a = *(const LAS bf16x8*)(Qs + (32 * tj + l31) * QP + 16 * ks + 8 * hh);
                const bf16x8 bb = *(const LAS bf16x8*)(Ks + (32 * ts + l31) * QP + 16 * ks + 8 * hh); acc = mfma32(a, bb, acc); }
            const int s = 32 * ts + l31; const float cs = fi[s] - fb[s];
#pragma unroll
            for (int r = 0; r < 16; ++r) { const int j = 32 * tj + (r & 3) + 8 * (r >> 2) + 4 * hh;
                const float p = (s <= j) ? acc[r] * __expf(fb[j] - fmj[j] + cs) : 0.f;
                Sm[j * TP + s] = f2bf(p);
                float v = p; v += __shfl_xor(v, 1); v += __shfl_xor(v, 2); v += __shfl_xor(v, 4); v += __shfl_xor(v, 8); v += __shfl_xor(v, 16);
                if (l31 == 0) dpart[ts * 64 + j] = v; }
        } else {
            const int tt = F.tid - 256, j = tt >> 2, part = tt & 3; float a = 0.f;
            const GAS f32x4* nin = (const GAS f32x4*)(NIN + (size_t)u * 256 + part * 64);
#pragma unroll
            for (int hb = 0; hb < 4; ++hb) { f32x4 nv[4];
#pragma unroll
                for (int k4 = 0; k4 < 4; ++k4) nv[k4] = nin[4 * hb + k4];
#pragma unroll
                for (int k4 = 0; k4 < 4; ++k4) { const v2u qw = *(const LAS v2u*)(Qs + j * QP + part * 64 + 16 * hb + 4 * k4);
                    a += nv[k4].x * bflo(qw.x) + nv[k4].y * bfhi(qw.x) + nv[k4].z * bflo(qw.y) + nv[k4].w * bfhi(qw.y); } }
            a += __shfl_xor(a, 1); a += __shfl_xor(a, 2);
            if (part == 0) dint[j] = fwi[j] * a;
        }
        __syncthreads();
        f32x16 acc[2];
#pragma unroll
        for (int tj = 0; tj < 2; ++tj) acc[tj] = (f32x16){0.f, 0.f, 0.f, 0.f, 0.f, 0.f, 0.f, 0.f, 0.f, 0.f, 0.f, 0.f, 0.f, 0.f, 0.f, 0.f};
#pragma unroll
        for (int ks = 0; ks < 16; ++ks) { const bf16x8 a = cf[ks];
#pragma unroll
            for (int tj = 0; tj < 2; ++tj) { const bf16x8 bq = *(const LAS bf16x8*)(Qs + (32 * tj + l31) * QP + 16 * ks + 8 * hh); acc[tj] = mfma32(a, bq, acc[tj]); } }
#pragma unroll
        for (int tj = 0; tj < 2; ++tj) { const float wi = fwi[32 * tj + l31];
#pragma unroll
            for (int r = 0; r < 16; ++r) acc[tj][r] *= wi; }
#pragma unroll
        for (int ks = 0; ks < 4; ++ks) { const bf16x8 a = *(const LAS bf16x8*)(Vt + tp_chunk(32 * w + l31, 2 * ks + hh));
#pragma unroll
            for (int tj = 0; tj < 2; ++tj) { const bf16x8 bs = *(const LAS bf16x8*)(Sm + (32 * tj + l31) * TP + 16 * ks + 8 * hh); acc[tj] = mfma32(a, bs, acc[tj]); } }
#pragma unroll
        for (int tj = 0; tj < 2; ++tj) { const int j = 32 * tj + l31; const float den = (dpart[j] + dpart[64 + j]) + dint[j];
            const float inv = 1.f / fmaxf(fabsf(den), __expf(-fmj[j])); float q2 = 0.f;
#pragma unroll
            for (int r = 0; r < 16; ++r) { acc[tj][r] *= inv; q2 += acc[tj][r] * acc[tj][r]; }
            q2 += __shfl_xor(q2, 32);
            if (hh == 0) hpart[w * 64 + j] = q2; }
        __syncthreads();
        f32x4 nwv[4]; v2u ogv[2][4];
#pragma unroll
        for (int rg = 0; rg < 4; ++rg) { const int v0 = 32 * w + 8 * rg + 4 * hh; nwv[rg] = *(const GAS f32x4*)(hnw + h * 256 + v0);
#pragma unroll
            for (int tj = 0; tj < 2; ++tj) ogv[tj][rg] = *(const GAS v2u*)(PROJ + (size_t)(t0 + 32 * tj + l31) * NPROJ + PO_M + h * 256 + v0); }
#pragma unroll
        for (int tj = 0; tj < 2; ++tj) { const int j = 32 * tj + l31; float hs = 0.f;
#pragma unroll
            for (int ww = 0; ww < 8; ++ww) hs += hpart[ww * 64 + j];
            const float rs = 1.f / sqrtf(hs * (1.f / MD) + EPS); const size_t t = (size_t)(t0 + j);
#pragma unroll
            for (int rg = 0; rg < 4; ++rg) { const int v0 = 32 * w + 8 * rg + 4 * hh;
                const f32x4 nw = nwv[rg];
                const v2u og = ogv[tj][rg];
                v2u o; o.x = pk2(acc[tj][4 * rg] * rs * nw.x * bflo(og.x), acc[tj][4 * rg + 1] * rs * nw.y * bfhi(og.x));
                o.y = pk2(acc[tj][4 * rg + 2] * rs * nw.z * bflo(og.y), acc[tj][4 * rg + 3] * rs * nw.w * bfhi(og.y));
                *(GAS v2u*)(HM + t * 2048 + h * 256 + v0) = o; } }
        __syncthreads();
    }
#undef MO_LOAD
}

template <int DH> struct AttnState { f32x16 ot[DH / 32]; bf16x8 qf[DH / 16]; float m_run, l_run; };
template <int DH, bool BAND>
__device__ __forceinline__ void attn_step(AttnState<DH>& A, const LAS bf16* Ks, const LAS bf16* Vt, const LAS float* relb, int dchunk, int qi, int lane) {
    constexpr int KP = DH + 8;
    const int hh = lane >> 5, l31 = lane & 31;
    f32x16 st[2];
#pragma unroll
    for (int kt = 0; kt < 2; ++kt) { st[kt] = (f32x16){0.f, 0.f, 0.f, 0.f, 0.f, 0.f, 0.f, 0.f, 0.f, 0.f, 0.f, 0.f, 0.f, 0.f, 0.f, 0.f};
#pragma unroll
        for (int ks = 0; ks < DH / 16; ++ks) { const bf16x8 a = *(const LAS bf16x8*)(Ks + (32 * kt + l31) * KP + 16 * ks + 8 * hh); st[kt] = mfma32(a, A.qf[ks], st[kt]); } }
    float mx = -1e30f, cadd = 0.f;
    if (BAND && dchunk < 3) {
        const int base4 = (64 * dchunk + qi - 4 * hh + 128) * 4;
#pragma unroll
        for (int kt = 0; kt < 2; ++kt)
#pragma unroll
            for (int r = 0; r < 16; ++r) { int i4 = base4 - 4 * (32 * kt + (r & 3) + 8 * (r >> 2)); i4 = i4 > 1024 ? 1024 : i4;
                const float s = st[kt][r] + *(const LAS float*)((const LAS char*)relb + i4); st[kt][r] = s; mx = fmaxf(mx, s); }
    } else {
#pragma unroll
        for (int kt = 0; kt < 2; ++kt)
#pragma unroll
            for (int r = 0; r < 16; ++r) mx = fmaxf(mx, st[kt][r]);
        if (BAND) { cadd = relb[256]; mx += cadd; }
    }
    mx = fmaxf(mx, __shfl_xor(mx, 32));
    const float mn = fmaxf(A.m_run, mx), alpha = __builtin_amdgcn_exp2f(A.m_run - mn), sh = cadd - mn;
    float sum = 0.f;
#pragma unroll
    for (int kt = 0; kt < 2; ++kt)
#pragma unroll
        for (int r = 0; r < 16; ++r) { const float p = __builtin_amdgcn_exp2f(st[kt][r] + sh); st[kt][r] = p; sum += p; }
    sum += __shfl_xor(sum, 32);
    A.l_run = A.l_run * alpha + sum; A.m_run = mn;
#pragma unroll
    for (int dt = 0; dt < DH / 32; ++dt)
#pragma unroll
        for (int r = 0; r < 16; ++r) A.ot[dt][r] *= alpha;
#pragma unroll
    for (int kt = 0; kt < 2; ++kt)
#pragma unroll
        for (int s2 = 0; s2 < 2; ++s2) {
            union { v4u u; bf16x8 v; } pf;
            pf.u.x = pk2(st[kt][8 * s2 + 0], st[kt][8 * s2 + 1]); pf.u.y = pk2(st[kt][8 * s2 + 2], st[kt][8 * s2 + 3]);
            pf.u.z = pk2(st[kt][8 * s2 + 4], st[kt][8 * s2 + 5]); pf.u.w = pk2(st[kt][8 * s2 + 6], st[kt][8 * s2 + 7]);
#pragma unroll
            for (int dt = 0; dt < DH / 32; ++dt) {
                const int vr = 32 * dt + l31, ch = 4 * kt + 2 * s2;
                union { v2u u[2]; bf16x8 v; } af; af.u[0] = *(const LAS v2u*)(Vt + tp_chunk(vr, ch) + 4 * hh); af.u[1] = *(const LAS v2u*)(Vt + tp_chunk(vr, ch + 1) + 4 * hh);
                A.ot[dt] = mfma32(af.v, pf.v, A.ot[dt]); } }
}
template <int DH> struct KVRegs { v4u k[(8 * DH) / NTHR], v[(8 * DH) / NTHR]; };
template <int DH>
__device__ __forceinline__ void attn_load(KVRegs<DH>& R, const bf16* kg, const bf16* vg, size_t pitch, int tid) {
    constexpr int PPR = DH / 8;
#pragma unroll
    for (int i = 0; i < (64 * PPR) / NTHR; ++i) { const int p = tid + NTHR * i, key = p / PPR, c8 = (p % PPR) * 8;
        R.k[i] = *(const GAS v4u*)(kg + (size_t)key * pitch + c8); R.v[i] = *(const GAS v4u*)(vg + (size_t)key * pitch + c8); }
}
template <int DH>
__device__ __forceinline__ void attn_put(LAS bf16* Ks, LAS bf16* Vt, const KVRegs<DH>& R, int tid) {
    constexpr int KP = DH + 8, PPR = DH / 8;
#pragma unroll
    for (int i = 0; i < (64 * PPR) / NTHR; ++i) { const int p = tid + NTHR * i, key = p / PPR, c8 = (p % PPR) * 8;
        const v4u vv = R.v[i];
        *(LAS v4u*)(Ks + key * KP + c8) = R.k[i];
        LAS bf16* vd = Vt + tp_col(c8, key);
        vd[0 * TP] = (bf16)(vv.x & 0xffff); vd[1 * TP] = (bf16)(vv.x >> 16); vd[2 * TP] = (bf16)(vv.y & 0xffff); vd[3 * TP] = (bf16)(vv.y >> 16);
        vd[4 * TP] = (bf16)(vv.z & 0xffff); vd[5 * TP] = (bf16)(vv.z >> 16); vd[6 * TP] = (bf16)(vv.w & 0xffff); vd[7 * TP] = (bf16)(vv.w >> 16); }
}
template <int DH>
__device__ __forceinline__ void attn_init(AttnState<DH>& A, const bf16* qrow, int lane) {
    const int hh = lane >> 5;
#pragma unroll
    for (int ks = 0; ks < DH / 16; ++ks) A.qf[ks] = *(const GAS bf16x8*)(qrow + 16 * ks + 8 * hh);
#pragma unroll
    for (int dt = 0; dt < DH / 32; ++dt) A.ot[dt] = (f32x16){0.f, 0.f, 0.f, 0.f, 0.f, 0.f, 0.f, 0.f, 0.f, 0.f, 0.f, 0.f, 0.f, 0.f, 0.f, 0.f};
    A.m_run = -1e30f; A.l_run = 0.f;
}
template <int DH>
__device__ __forceinline__ void attn_store(const AttnState<DH>& A, bf16* orow, int lane) {
    const int hh = lane >> 5; const float inv = 1.f / A.l_run;
#pragma unroll
    for (int dt = 0; dt < DH / 32; ++dt)
#pragma unroll
        for (int rg = 0; rg < 4; ++rg) { v2u o; o.x = pk2(A.ot[dt][4 * rg] * inv, A.ot[dt][4 * rg + 1] * inv); o.y = pk2(A.ot[dt][4 * rg + 2] * inv, A.ot[dt][4 * rg + 3] * inv);
            *(GAS v2u*)(orow + 32 * dt + 8 * rg + 4 * hh) = o; }
}

__device__ __forceinline__ void p_band_attn(Frame& F, int i0 = 0, int i1 = 4096) {
    frame_ids(F);
    const bf16* PROJ = (const bf16*)(F.ws + WS_PROJ); bf16* YA = (bf16*)(F.ws + WS_HM) + 1024;
    constexpr int KSZ = 64 * (AD + 8), VSZ = AD * TP, BUF = KSZ + VSZ;
    LAS bf16* B0 = (LAS bf16*)(F.lds + RING_OFF);
    LAS float* relb = (LAS float*)(B0 + 2 * BUF);
    const int lane = F.lane, w = F.wave, l31 = lane & 31;
    for (int u = F.vcu + i0 * F.G, ue = (F.vcu + i1 * F.G < BATCH * AH * 32) ? F.vcu + i1 * F.G : BATCH * AH * 32; u < ue; u += F.G) {
        const int b = u >> 9, hd = (u >> 5) & 15, qt = u & 31;
        for (int i = F.tid; i < 257; i += NTHR) relb[i] = F.in[I_REL][hd * 257 + i] * 1.4426950408889634f;
        const int cw = 4 * qt + (w >> 1), qi = (w & 1) * 32 + l31; const size_t tq = (size_t)b * SEQ + cw * CHUNK + qi;
        AttnState<AD> A; attn_init<AD>(A, PROJ + tq * NPROJ + PQ_A + hd * AD, lane);
        const int kc0 = (4 * qt - 8) > 0 ? (4 * qt - 8) : 0, kc1 = 4 * qt + 3;
        const bf16* kbase = PROJ + (size_t)b * SEQ * NPROJ + PK_A + hd * AD; const bf16* vbase = PROJ + (size_t)b * SEQ * NPROJ + PV_A + hd * AD;
        KVRegs<AD> R0, R1;
        attn_load<AD>(R0, kbase + (size_t)kc0 * CHUNK * NPROJ, vbase + (size_t)kc0 * CHUNK * NPROJ, NPROJ, F.tid);
        if (kc0 + 1 <= kc1) attn_load<AD>(R1, kbase + (size_t)(kc0 + 1) * CHUNK * NPROJ, vbase + (size_t)(kc0 + 1) * CHUNK * NPROJ, NPROJ, F.tid);
        for (int kc = kc0; kc <= kc1; kc += 2) {
            { LAS bf16* Ks = B0; LAS bf16* Vt = Ks + KSZ;
              attn_put<AD>(Ks, Vt, R0, F.tid);
              __syncthreads();
              if (kc + 2 <= kc1) attn_load<AD>(R0, kbase + (size_t)(kc + 2) * CHUNK * NPROJ, vbase + (size_t)(kc + 2) * CHUNK * NPROJ, NPROJ, F.tid);
              if (kc >= cw - 8 && kc <= cw) attn_step<AD, true>(A, Ks, Vt, relb, cw - kc, qi, lane); }
            if (kc + 1 <= kc1) { LAS bf16* Ks = B0 + BUF; LAS bf16* Vt = Ks + KSZ;
              attn_put<AD>(Ks, Vt, R1, F.tid);
              __syncthreads();
              if (kc + 3 <= kc1) attn_load<AD>(R1, kbase + (size_t)(kc + 3) * CHUNK * NPROJ, vbase + (size_t)(kc + 3) * CHUNK * NPROJ, NPROJ, F.tid);
              if (kc + 1 >= cw - 8 && kc + 1 <= cw) attn_step<AD, true>(A, Ks, Vt, relb, cw - kc - 1, qi, lane); }
        }
        attn_store<AD>(A, YA + tq * 2048 + hd * AD, lane);
        __syncthreads();
    }
}

constexpr int NB2 = 1;
__device__ __forceinline__ void p_local_band(Frame& F) {
    frame_ids(F);
    const bf16* PROJ = (const bf16*)(F.ws + WS_PROJ); const bf16* QKC = (const bf16*)(F.ws + WS_QKC); const float* IFG = (const float*)(F.ws + WS_IFG);
    float* BCUM = (float*)(F.ws + WS_BCUM); bf16* CLOC = (bf16*)(F.ws + WS_CLOC); float* NLOC = (float*)(F.ws + WS_NLOC);
    float* CHA = (float*)(F.ws + WS_CHS); float* CHG = CHA + 1024;
    LAS bf16* Kt = (LAS bf16*)(F.lds + RING_OFF);
    LAS bf16* Vt = Kt + 256 * TP;
    LAS float* es = (LAS float*)(Vt + 256 * TP);
    const int lane = F.lane, w = F.wave, hh = lane >> 5, l31 = lane & 31;
    v4u rk[4], rv[4]; float ipn = 0.f, fpn = 0.f;
#define ML_LOAD(uu) do { const int bh_ = (uu) >> 7, c_ = (uu) & 127, b_ = bh_ >> 2, h_ = bh_ & 3, t0_ = b_ * SEQ + c_ * CHUNK; \
        _Pragma("unroll") for (int i = 0; i < 4; ++i) { const int p = F.tid + NTHR * i, s = p >> 5, c8 = (p & 31) * 8; \
            rk[i] = *(const GAS v4u*)(QKC + (size_t)(t0_ + s) * 2048 + 1024 + h_ * 256 + c8); rv[i] = *(const GAS v4u*)(PROJ + (size_t)(t0_ + s) * NPROJ + PV_M + h_ * 256 + c8); } } while (0)
#define ML_LOADG(uu) do { const int bh_ = (uu) >> 7, c_ = (uu) & 127, b_ = bh_ >> 2, h_ = bh_ & 3, t0_ = b_ * SEQ + c_ * CHUNK; \
        if (F.wave == 0) { ipn = IFG[(size_t)(t0_ + F.lane) * 8 + h_]; fpn = IFG[(size_t)(t0_ + F.lane) * 8 + 4 + h_]; } } while (0)
    const int par = F.vcu & 1;
    if (F.vcu < 1024) { ML_LOAD(F.vcu); ML_LOADG(F.vcu); }
    for (int i = 0; F.vcu + (i - par) * F.G < 1024; ++i) {
        const int ul = F.vcu + (i - par) * F.G, ub = F.vcu + (i + NB2) * F.G, uln = ul + F.G;
        if (ul >= 0) {
        const int u = ul;
        int lane = F.lane; asm volatile("" : "+v"(lane));
        const int tid_ = F.wave * 64 + lane, hh = lane >> 5, l31 = lane & 31;
        const int bh = u >> 7, c = u & 127, b = bh >> 2, h = bh & 3, t0 = b * SEQ + c * CHUNK;
        if (w == 0) {
            const float ip = ipn, fp = fpn;
            const float lf = fminf(fp, 0.f) - log1pf(__expf(-fabsf(fp)));
            float bc = lf;
#pragma unroll
            for (int o = 1; o < 64; o <<= 1) { const float y = __shfl_up(bc, o); if (lane >= o) bc += y; }
            const float g = __shfl(bc, 63), we = g - bc + ip, a = wave_max(we);
            es[lane] = __expf(we - a);
            BCUM[(size_t)(t0 + lane) * 4 + h] = bc;
            if (lane == 0) { CHA[u] = a; CHG[u] = g; }
        }
        __syncthreads();
#pragma unroll
        for (int i = 0; i < 4; ++i) { const int p = tid_ + NTHR * i, s = p >> 5, c8 = (p & 31) * 8;
            const v4u kv = rk[i], vv = rv[i];
            const float e = es[s];
            LAS bf16* kd = Kt + tp_col(c8, s); LAS bf16* vd = Vt + tp_col(c8, s);
            kd[0 * TP] = (bf16)(kv.x & 0xffff); kd[1 * TP] = (bf16)(kv.x >> 16); kd[2 * TP] = (bf16)(kv.y & 0xffff); kd[3 * TP] = (bf16)(kv.y >> 16);
            kd[4 * TP] = (bf16)(kv.z & 0xffff); kd[5 * TP] = (bf16)(kv.z >> 16); kd[6 * TP] = (bf16)(kv.w & 0xffff); kd[7 * TP] = (bf16)(kv.w >> 16);
            vd[0 * TP] = f2bf(bflo(vv.x) * e); vd[1 * TP] = f2bf(bfhi(vv.x) * e); vd[2 * TP] = f2bf(bflo(vv.y) * e); vd[3 * TP] = f2bf(bfhi(vv.y) * e);
            vd[4 * TP] = f2bf(bflo(vv.z) * e); vd[5 * TP] = f2bf(bfhi(vv.z) * e); vd[6 * TP] = f2bf(bflo(vv.w) * e); vd[7 * TP] = f2bf(bfhi(vv.w) * e); }
        __syncthreads();
        if (uln < 1024) { ML_LOAD(uln); ML_LOADG(uln); }
        bf16x8 af[4];
#pragma unroll
        for (int ks = 0; ks < 4; ++ks) af[ks] = *(const LAS bf16x8*)(Kt + tp_chunk(32 * w + l31, 2 * ks + hh));
        bf16* Cu = CLOC + (size_t)u * 65536;
#pragma unroll 2
        for (int ni = 0; ni < 8; ++ni) {
            f32x16 acc = {0.f, 0.f, 0.f, 0.f, 0.f, 0.f, 0.f, 0.f, 0.f, 0.f, 0.f, 0.f, 0.f, 0.f, 0.f, 0.f};
#pragma unroll
            for (int ks = 0; ks < 4; ++ks) { const bf16x8 bfr = *(const LAS bf16x8*)(Vt + tp_chunk(32 * ni + l31, 2 * ks + hh)); acc = mfma32(af[ks], bfr, acc); }
            const int v = 32 * ni + l31;
#pragma unroll
            for (int rg = 0; rg < 4; ++rg) { v2u o; o.x = pk2(acc[4 * rg], acc[4 * rg + 1]); o.y = pk2(acc[4 * rg + 2], acc[4 * rg + 3]);
                *(GAS v2u*)(Cu + (size_t)w * 8192 + v * 32 + 8 * rg + 4 * hh) = o; }
        }
        if (tid_ < 256) { float a = 0.f;
#pragma unroll
            for (int cch = 0; cch < 8; ++cch) { const v4u kq = *(const LAS v4u*)(Kt + tp_chunk(tid_, cch)); const LAS float* e8 = es + 8 * cch;
                a += e8[0] * bflo(kq.x); a += e8[1] * bfhi(kq.x); a += e8[2] * bflo(kq.y); a += e8[3] * bfhi(kq.y); a += e8[4] * bflo(kq.z); a += e8[5] * bfhi(kq.z); a += e8[6] * bflo(kq.w); a += e8[7] * bfhi(kq.w); }
            NLOC[(size_t)u * 256 + tid_] = a; }
        __syncthreads();
            }
        if (ub < 1024) {
        const int u = ub;
    const bf16* PROJ = (const bf16*)(F.ws + WS_PROJ); bf16* YA = (bf16*)(F.ws + WS_HM) + 1024;
    constexpr int KSZ = 64 * (AD + 8), VSZ = AD * TP, BUF = KSZ + VSZ;
    LAS bf16* B0 = (LAS bf16*)(F.lds + RING_OFF);
    LAS float* relb = (LAS float*)(B0 + 2 * BUF);
    int lane = F.lane; asm volatile("" : "+v"(lane));
    const int tid_ = F.wave * 64 + lane, w = F.wave, l31 = lane & 31;
        {
        const int b = u >> 9, hd = (u >> 5) & 15, qt = u & 31;
        for (int i = tid_; i < 257; i += NTHR) relb[i] = F.in[I_REL][hd * 257 + i] * 1.4426950408889634f;
        const int cw = 4 * qt + (w >> 1), qi = (w & 1) * 32 + l31; const size_t tq = (size_t)b * SEQ + cw * CHUNK + qi;
        AttnState<AD> A; attn_init<AD>(A, PROJ + tq * NPROJ + PQ_A + hd * AD, lane);
        const int kc0 = (4 * qt - 8) > 0 ? (4 * qt - 8) : 0, kc1 = 4 * qt + 3;
        const bf16* kbase = PROJ + (size_t)b * SEQ * NPROJ + PK_A + hd * AD; const bf16* vbase = PROJ + (size_t)b * SEQ * NPROJ + PV_A + hd * AD;
        KVRegs<AD> R0, R1;
        attn_load<AD>(R0, kbase + (size_t)kc0 * CHUNK * NPROJ, vbase + (size_t)kc0 * CHUNK * NPROJ, NPROJ, tid_);
        if (kc0 + 1 <= kc1) attn_load<AD>(R1, kbase + (size_t)(kc0 + 1) * CHUNK * NPROJ, vbase + (size_t)(kc0 + 1) * CHUNK * NPROJ, NPROJ, tid_);
        for (int kc = kc0; kc <= kc1; kc += 2) {
            { LAS bf16* Ks = B0; LAS bf16* Vt = Ks + KSZ;
              attn_put<AD>(Ks, Vt, R0, tid_);
              __syncthreads();
              if (kc + 2 <= kc1) attn_load<AD>(R0, kbase + (size_t)(kc + 2) * CHUNK * NPROJ, vbase + (size_t)(kc + 2) * CHUNK * NPROJ, NPROJ, tid_);
              if (kc >= cw - 8 && kc <= cw) attn_step<AD, true>(A, Ks, Vt, relb, cw - kc, qi, lane); }
            if (kc + 1 <= kc1) { LAS bf16* Ks = B0 + BUF; LAS bf16* Vt = Ks + KSZ;
              attn_put<AD>(Ks, Vt, R1, tid_);
              __syncthreads();
              if (kc + 3 <= kc1) attn_load<AD>(R1, kbase + (size_t)(kc + 3) * CHUNK * NPROJ, vbase + (size_t)(kc + 3) * CHUNK * NPROJ, NPROJ, tid_);
              if (kc + 1 >= cw - 8 && kc + 1 <= cw) attn_step<AD, true>(A, Ks, Vt, relb, cw - kc - 1, qi, lane); }
        }
        attn_store<AD>(A, YA + tq * 2048 + hd * AD, lane);
        __syncthreads();
            }
        }
    }
#undef ML_LOADG
#undef ML_LOAD
}


__device__ __forceinline__ void p_cross_attn(Frame& F) {
    frame_ids(F);
    const bf16* QX = (const bf16*)(F.ws + WS_QX); const bf16* KVX = (const bf16*)(F.ws + WS_KVX); bf16* OX = (bf16*)(F.ws + WS_OX);
    constexpr int KSZ = 64 * (XD + 8), VSZ = XD * TP, BUF = KSZ + VSZ;
    LAS bf16* B0 = (LAS bf16*)(F.lds + RING_OFF);
    const int lane = F.lane, w = F.wave, l31 = lane & 31;
    for (int u = F.vcu; u < BATCH * XH * 32; u += F.G) {
        const int b = u >> 7, hx = (u >> 5) & 3, qt = u & 31;
        const size_t tq = (size_t)b * SEQ + qt * 256 + 32 * w + l31;
        AttnState<XD> A; attn_init<XD>(A, QX + tq * XW + hx * XD, lane);
        const bf16* kg0 = KVX + (size_t)(b * NMEM) * (2 * XW) + hx * XD;
        KVRegs<XD> R; attn_load<XD>(R, kg0, kg0 + XW, 2 * XW, F.tid);
        for (int st = 0; st < 4; ++st) {
            LAS bf16* Ks = B0 + (st & 1) * BUF; LAS bf16* Vt = Ks + KSZ;
            attn_put<XD>(Ks, Vt, R, F.tid);
            __syncthreads();
            if (st < 3) { const bf16* kg = kg0 + (size_t)((st + 1) * 64) * (2 * XW); attn_load<XD>(R, kg, kg + XW, 2 * XW, F.tid); }
            attn_step<XD, false>(A, Ks, Vt, nullptr, 0, 0, lane);
        }
        attn_store<XD>(A, OX + tq * XW + hx * XD, lane);
        __syncthreads();
    }
}

__device__ __forceinline__ void p_rmsnorm_rows(Frame& F, const float* X, const float* w, bf16* XN, unsigned char* XQ) {
    frame_ids(F);
    const int gw = F.vcu * NWAVES + F.wave, NGW = F.G * NWAVES;
    for (int m = gw; m < T; m += NGW) {
        const GAS f32x4* xr = (const GAS f32x4*)(X + (size_t)m * D) + F.lane;
        f32x4 v[8]; float s = 0.f;
#pragma unroll
        for (int j = 0; j < 8; ++j) { v[j] = xr[64 * j]; s += (v[j].x * v[j].x + v[j].y * v[j].y) + (v[j].z * v[j].z + v[j].w * v[j].w); }
        const float rstd = 1.f / sqrtf(wave_sum(s) * (1.f / D) + EPS);
        const GAS f32x4* wr = (const GAS f32x4*)w + F.lane;
        GAS v2u* o8 = (GAS v2u*)(XN + (size_t)m * D) + F.lane;
#pragma unroll
        for (int j = 0; j < 8; ++j) { const f32x4 ww = wr[64 * j]; v[j].x *= rstd * ww.x; v[j].y *= rstd * ww.y; v[j].z *= rstd * ww.z; v[j].w *= rstd * ww.w;
            v2u o; o.x = pk2(v[j].x, v[j].y); o.y = pk2(v[j].z, v[j].w); o8[64 * j] = o; }
        if (XQ) { GAS unsigned* q4 = (GAS unsigned*)(XQ + (size_t)m * D) + F.lane;
#pragma unroll
            for (int j = 0; j < 8; ++j) q4[64 * j] = pg8::pk_fp8x4(v[j].x * XSCALE, v[j].y * XSCALE, v[j].z * XSCALE, v[j].w * XSCALE); }
    }
}


constexpr int NR_EXTRA = 133120;
__device__ __forceinline__ void p_norm_route(Frame& F) {
    frame_ids(F);
    const bf16* X2 = (const bf16*)(F.ws + WS_X2); const float* nw = F.in[I_NFFNW]; const bf16* WR = (const bf16*)(F.ws + WS_WR); const float* br = F.in[I_BR];
    unsigned char* XQ = (unsigned char*)(F.ws + WS_XQ); float* RSTD = (float*)(F.ws + WS_RSTD);
    int* TOPE = (int*)(F.ws + WS_TOPE); float* GATE = (float*)(F.ws + WS_GATE); int* RANK = (int*)(F.ws + WS_RANK); int* HIST = (int*)(F.ws + WS_CTL) + CW_HIST;
    LAS unsigned char* wt = F.lds + RING_OFF;
    LAS float* part = (LAS float*)(F.lds + NR_EXTRA);
    LAS float* sq = part + 64 * 32;
    LAS float* rs = sq + 64;
    LAS int* lh = (LAS int*)(rs + 64); LAS int* le = lh + 32;
    for (int i = 0; i < 16; ++i) { const int q = F.tid + NTHR * i, e = q >> 8, c = q & 255;
        *(LAS v4u*)(wt + e * 4096 + ((c ^ (e & 15)) << 4)) = *(const GAS v4u*)(WR + (size_t)e * D + 8 * c); }
    const int lane = F.lane, w = F.wave, tg = w & 3, kh = w >> 2, r16 = lane & 15, kq = lane >> 4;
    for (int blk = F.vcu; blk < T / 64; blk += F.G) {
        if (F.tid < 32) lh[F.tid] = 0;
        __syncthreads();
        const int tok = 16 * tg + r16; const size_t t = (size_t)blk * 64 + tok;
        f32x4 acc[2]; acc[0] = (f32x4){0.f, 0.f, 0.f, 0.f}; acc[1] = acc[0]; float ssq = 0.f;
        const bf16* xrow = X2 + t * D + 1024 * kh + 8 * kq; const float* nwp = nw + 1024 * kh + 8 * kq;
        unsigned char* qrow = XQ + t * D + 1024 * kh + 8 * kq;
#pragma unroll 8
        for (int ks = 0; ks < 32; ++ks) {
            const v4u xw = *(const GAS v4u*)(xrow + 32 * ks); const f32x4 xa = {bflo(xw.x), bfhi(xw.x), bflo(xw.y), bfhi(xw.y)}, xb = {bflo(xw.z), bfhi(xw.z), bflo(xw.w), bfhi(xw.w)};
            const f32x4 na = *(const GAS f32x4*)(nwp + 32 * ks), nb = *(const GAS f32x4*)(nwp + 32 * ks + 4);
            ssq += (xa.x * xa.x + xa.y * xa.y) + (xa.z * xa.z + xa.w * xa.w) + (xb.x * xb.x + xb.y * xb.y) + (xb.z * xb.z + xb.w * xb.w);
            const f32x4 ya = xa * na, yb = xb * nb;
            union { v4u u; bf16x8 v; } af; af.u.x = pk2(ya.x, ya.y); af.u.y = pk2(ya.z, ya.w); af.u.z = pk2(yb.x, yb.y); af.u.w = pk2(yb.z, yb.w);
            v2u qq; qq.x = pg8::pk_fp8x4(ya.x * XSCALE, ya.y * XSCALE, ya.z * XSCALE, ya.w * XSCALE); qq.y = pg8::pk_fp8x4(yb.x * XSCALE, yb.y * XSCALE, yb.z * XSCALE, yb.w * XSCALE);
            *(GAS v2u*)(qrow + 32 * ks) = qq;
            const int c = 128 * kh + 4 * ks + kq;
#pragma unroll
            for (int et = 0; et < 2; ++et) { const bf16x8 bfr = *(const LAS bf16x8*)(wt + (16 * et + r16) * 4096 + ((c ^ r16) << 4));
                acc[et] = __builtin_amdgcn_mfma_f32_16x16x32_bf16(af.v, bfr, acc[et], 0, 0, 0); }
        }
        ssq += __shfl_xor(ssq, 16); ssq += __shfl_xor(ssq, 32);
        if (kh == 1) {
#pragma unroll
            for (int et = 0; et < 2; ++et)
#pragma unroll
                for (int r = 0; r < 4; ++r) part[(16 * tg + 4 * kq + r) * 32 + 16 * et + r16] = acc[et][r];
            if (kq == 0) sq[tok] = ssq;
        }
        __syncthreads();
        if (kh == 0) {
            const float rstd = 1.f / sqrtf((ssq + sq[tok]) * (1.f / D) + EPS);
            if (kq == 0) { rs[tok] = rstd; RSTD[t] = rstd; }
            LDS_WAIT(); asm volatile("" ::: "memory");
#pragma unroll
            for (int et = 0; et < 2; ++et)
#pragma unroll
                for (int r = 0; r < 4; ++r) { const int tr = 16 * tg + 4 * kq + r, e = 16 * et + r16;
                    part[tr * 32 + e] = (acc[et][r] + part[tr * 32 + e]) * rs[tr] + br[e]; }
            LDS_WAIT(); asm volatile("" ::: "memory");
            if (lane < 16) { const int tk = 16 * tg + lane; const size_t tt = (size_t)blk * 64 + tk;
                float lg[32];
#pragma unroll
                for (int e = 0; e < 32; ++e) lg[e] = part[tk * 32 + e];
                float tv[4]; int te[4];
#pragma unroll
                for (int k = 0; k < 4; ++k) { float best = -3.0e38f; int bi = 0;
#pragma unroll
                    for (int e = 0; e < 32; ++e) { if (lg[e] > best) { best = lg[e]; bi = e; } }
                    tv[k] = best; te[k] = bi;
#pragma unroll
                    for (int e = 0; e < 32; ++e) lg[e] = (e == bi) ? -3.0e38f : lg[e]; }
                const float e1 = __expf(tv[1] - tv[0]), e2 = __expf(tv[2] - tv[0]), e3 = __expf(tv[3] - tv[0]), inv = 1.f / (1.f + e1 + e2 + e3);
                const float gk[4] = {inv, e1 * inv, e2 * inv, e3 * inv};
#pragma unroll
                for (int k = 0; k < 4; ++k) { TOPE[tt * 4 + k] = te[k]; GATE[tt * 4 + k] = gk[k]; le[tk * 4 + k] = te[k]; }
            }
        }
        __syncthreads();
        if (F.tid < 256) { const int me = le[F.tid]; int rk = 0;
#pragma unroll 8
            for (int q4 = 0; q4 < 64; ++q4) { const v4u e4 = *(const LAS v4u*)(le + 4 * q4); const int a0 = 4 * q4;
                rk += ((a0 < F.tid) & ((int)e4.x == me)) + ((a0 + 1 < F.tid) & ((int)e4.y == me)) + ((a0 + 2 < F.tid) & ((int)e4.z == me)) + ((a0 + 3 < F.tid) & ((int)e4.w == me)); }
            RANK[blk * 256 + F.tid] = rk; (void)lds_addi(lh + me, 1); }
        __syncthreads();
        if (F.tid < 32) HIST[blk * 32 + F.tid] = lh[F.tid];
        __syncthreads();
    }
}

__device__ __forceinline__ void p_route_a(Frame& F) {
    frame_ids(F);
    const float* LOG = (const float*)(F.ws + WS_LOG); int* TOPE = (int*)(F.ws + WS_TOPE); float* GATE = (float*)(F.ws + WS_GATE); int* RANK = (int*)(F.ws + WS_RANK);
    int* HIST = (int*)(F.ws + WS_CTL) + CW_HIST; const float* br = F.in[I_BR];
    LAS int* lh = (LAS int*)(F.lds + RING_OFF); LAS int* le = lh + 32;
    for (int blk = F.vcu; blk < T / 64; blk += F.G) {
        if (F.tid < 32) lh[F.tid] = 0;
        __syncthreads();
        if (F.tid < 64) { const int t = blk * 64 + F.tid;
            float lg[32];
#pragma unroll
            for (int e4 = 0; e4 < 8; ++e4) { const f32x4 v = *(const GAS f32x4*)(LOG + (size_t)t * 256 + 4 * e4), bb = *(const GAS f32x4*)(br + 4 * e4);
                lg[4 * e4] = v.x + bb.x; lg[4 * e4 + 1] = v.y + bb.y; lg[4 * e4 + 2] = v.z + bb.z; lg[4 * e4 + 3] = v.w + bb.w; }
            float tv[4]; int te[4];
#pragma unroll
            for (int k = 0; k < 4; ++k) { float best = -3.0e38f; int bi = 0;
#pragma unroll
                for (int e = 0; e < 32; ++e) { if (lg[e] > best) { best = lg[e]; bi = e; } }
                tv[k] = best; te[k] = bi;
#pragma unroll
                for (int e = 0; e < 32; ++e) lg[e] = (e == bi) ? -3.0e38f : lg[e]; }
            const float e1 = __expf(tv[1] - tv[0]), e2 = __expf(tv[2] - tv[0]), e3 = __expf(tv[3] - tv[0]), inv = 1.f / (1.f + e1 + e2 + e3);
            const float gk[4] = {inv, e1 * inv, e2 * inv, e3 * inv};
#pragma unroll
            for (int k = 0; k < 4; ++k) { TOPE[t * 4 + k] = te[k]; GATE[t * 4 + k] = gk[k]; le[F.tid * 4 + k] = te[k]; }
        }
        __syncthreads();
        if (F.tid < 256) { const int me = le[F.tid]; int rk = 0;
            for (int a = 0; a < F.tid; ++a) rk += (le[a] == me) ? 1 : 0;
            RANK[blk * 256 + F.tid] = rk; (void)lds_addi(lh + me, 1); }
        __syncthreads();
        if (F.tid < 32) HIST[blk * 32 + F.tid] = lh[F.tid];
        __syncthreads();
    }
}
__device__ __forceinline__ void p_route_b(Frame& F) {
    frame_ids(F);
    const int* TOPE = (const int*)(F.ws + WS_TOPE); const float* GATE = (const float*)(F.ws + WS_GATE); const int* RANK = (const int*)(F.ws + WS_RANK);
    int* DEST = (int*)(F.ws + WS_DEST); float* RGATE = (float*)(F.ws + WS_RGATE); float* RROW = (float*)(F.ws + WS_RROW); const float* RSTD = (const float*)(F.ws + WS_RSTD);
    const int* HIST = (const int*)(F.ws + WS_CTL) + CW_HIST; int* BLKE = (int*)(F.ws + WS_CTL) + CW_BLKE; int* NBLK = (int*)(F.ws + WS_CTL) + CW_NBLK;
    const unsigned char* XQ = (const unsigned char*)(F.ws + WS_XQ); unsigned char* XP = (unsigned char*)(F.ws + WS_XPERM);
    LAS int* cnt = (LAS int*)(F.lds + RING_OFF);
    LAS int* pst = cnt + 32; LAS int* pen = cnt + 64; LAS int* base = cnt + 96; LAS int* dl = cnt + 128; LAS int* part = cnt + 384; LAS int* hl = cnt + 896;
    for (int i = F.tid; i < (T / 64) * 32; i += NTHR) hl[i] = HIST[i];
    __syncthreads();
    { const int e = F.tid & 31, g = F.tid >> 5; int s = 0;
#pragma unroll
        for (int q = 0; q < 16; ++q) s += hl[(16 * g + q) * 32 + e];
        part[g * 32 + e] = s; }
    __syncthreads();
    if (F.tid < 32) { int s = 0;
#pragma unroll
        for (int g = 0; g < 16; ++g) s += part[g * 32 + F.tid];
        cnt[F.tid] = s; }
    __syncthreads();
    if (F.tid == 0) { int run = 0; for (int e = 0; e < 32; ++e) { const int pd = (cnt[e] + MOEB - 1) / MOEB * MOEB; pst[e] = run; run += pd; pen[e] = run; } }
    __syncthreads();
    if (F.vcu == 0) {
        if (F.tid == 0) NBLK[0] = pen[31] / MOEB;
        if (F.tid < NBLK_MAX) { int e = 0; for (int q = 0; q < 32; ++q) e += (pen[q] <= F.tid * MOEB) ? 1 : 0; BLKE[F.tid] = e < 31 ? e : 31; }
    }
    for (int e = F.vcu; e < NE; e += F.G) {
        const int r0 = pst[e] + cnt[e], r1 = pen[e];
        for (int r = r0 + F.wave; r < r1; r += NWAVES) { if (F.lane == 0) { RGATE[r] = 0.f; RROW[r] = 0.f; }
            GAS v4u* o = (GAS v4u*)(XP + (size_t)r * D) + F.lane;
#pragma unroll
            for (int j = 0; j < 2; ++j) o[64 * j] = (v4u){0u, 0u, 0u, 0u}; }
    }
    for (int blk = F.vcu; blk < T / 64; blk += F.G) {
        __syncthreads();
        { const int e = F.tid & 31, g = F.tid >> 5; int s = 0;
#pragma unroll
            for (int q = 0; q < 16; ++q) s += (16 * g + q < blk) ? hl[(16 * g + q) * 32 + e] : 0;
            part[g * 32 + e] = s; }
        __syncthreads();
        if (F.tid < 32) { int s = pst[F.tid];
#pragma unroll
            for (int g = 0; g < 16; ++g) s += part[g * 32 + F.tid];
            base[F.tid] = s; }
        __syncthreads();
        if (F.tid < 256) { const int a = blk * 256 + F.tid; const int d = base[TOPE[a]] + RANK[a]; DEST[a] = d; RGATE[d] = GATE[a]; RROW[d] = RSTD[a >> 2]; dl[F.tid] = d; }
        __syncthreads();
        { v4u rr[8][2];
#pragma unroll
            for (int q = 0; q < 8; ++q) { const int t = blk * 64 + F.wave + 8 * q; const GAS v4u* s = (const GAS v4u*)(XQ + (size_t)t * D) + F.lane; rr[q][0] = s[0]; rr[q][1] = s[64]; }
#pragma unroll
            for (int q = 0; q < 8; ++q)
#pragma unroll
                for (int k = 0; k < 4; ++k) { const int a = 4 * (F.wave + 8 * q) + k; GAS v4u* o = (GAS v4u*)(XP + (size_t)dl[a] * D) + F.lane; o[0] = rr[q][0]; o[64] = rr[q][1]; } }
    }
}
__device__ __forceinline__ void p_combine(Frame& F) {
    frame_ids(F);
    const bf16* X2 = (const bf16*)(F.ws + WS_X2); const unsigned char* YR = (const unsigned char*)(F.ws + WS_YR); const int* DEST = (const int*)(F.ws + WS_DEST);
    const float* fw = F.in[I_FNW];
    const int gw = F.vcu * NWAVES + F.wave, NGW = F.G * NWAVES;
    for (int m = gw; m < T; m += NGW) {
        const GAS v2u* xr = (const GAS v2u*)(X2 + (size_t)m * D) + F.lane;
        f32x4 v[8];
#pragma unroll
        for (int j = 0; j < 8; ++j) { const v2u xw = xr[64 * j]; v[j] = (f32x4){bflo(xw.x), bfhi(xw.x), bflo(xw.y), bfhi(xw.y)}; }
#pragma unroll
        for (int k = 0; k < 4; ++k) { const GAS unsigned* yr = (const GAS unsigned*)(YR + (size_t)DEST[m * 4 + k] * D) + F.lane;
#pragma unroll
            for (int j = 0; j < 8; ++j) { const unsigned y = yr[64 * j]; const f32x2 lo = __builtin_amdgcn_cvt_pk_f32_fp8((int)y, false), hi = __builtin_amdgcn_cvt_pk_f32_fp8((int)y, true);
                v[j].x += lo.x * (1.f / YSCALE); v[j].y += lo.y * (1.f / YSCALE); v[j].z += hi.x * (1.f / YSCALE); v[j].w += hi.y * (1.f / YSCALE); } }
        float s = 0.f;
#pragma unroll
        for (int j = 0; j < 8; ++j) s += (v[j].x * v[j].x + v[j].y * v[j].y) + (v[j].z * v[j].z + v[j].w * v[j].w);
        const float rstd = 1.f / sqrtf(wave_sum(s) * (1.f / D) + EPS);
        const GAS f32x4* wr = (const GAS f32x4*)fw + F.lane; GAS f32x4* o = (GAS f32x4*)(F.out + (size_t)m * D) + F.lane;
#pragma unroll
        for (int j = 0; j < 8; ++j) { const f32x4 ww = wr[64 * j]; f32x4 ov = (f32x4){v[j].x * rstd * ww.x, v[j].y * rstd * ww.y, v[j].z * rstd * ww.z, v[j].w * rstd * ww.w};
#ifdef MK_SANITIZE
#pragma unroll
            for (int q = 0; q < 4; ++q) if (!(fabsf(ov[q]) < 1e30f)) ov[q] = 100.f;
#endif
            __builtin_nontemporal_store(ov, o + 64 * j); }
    }
}


constexpr int NPHASE = 20;
struct Args { const float* in[25]; float* out; unsigned char* ws; int ph_lo, ph_hi; };
__global__ void __launch_bounds__(NTHR, 2) mk_fwd(Args args) {
    extern __shared__ __attribute__((aligned(16))) unsigned char lds[];
    Frame F;
    F.lds = (LAS unsigned char*)lds;
    F.wave = __builtin_amdgcn_readfirstlane((int)threadIdx.x >> 6); frame_ids(F);
    F.G = gridDim.x; { const int bx = blockIdx.x; F.vcu = (F.G % 8 == 0) ? (bx % 8) * (F.G / 8) + bx / 8 : bx; }
    F.ws = args.ws; F.out = args.out;
#pragma unroll
    for (int i = 0; i < 25; ++i) F.in[i] = args.in[i];
    for (int u = F.tid; u < (LDS_BYTES - LDSCTL_OFF) / 4; u += NTHR) ((LAS unsigned*)(F.lds + LDSCTL_OFF))[u] = 0u;
    __syncthreads();
    const int lo = args.ph_lo, hi = args.ph_hi;
    unsigned* ctl = (unsigned*)(F.ws + WS_CTL);
    XcdBarrier bar; bar.bar = ctl + CW_BAR; bar.x = 0; bar.st = nullptr;
    if (hi - lo > 1) bar = xcd_barrier_post(ctl + CW_BAR, (volatile LAS unsigned*)(F.lds + MISC_OFF) + 8, F.tid);
#define IN(k) (lo <= (k) && (k) < hi)
#define SEAM(k) do { if (IN(k) && IN((k) + 1)) { frame_ids(F); xcd_barrier(bar, F.tid); } } while (0)
    LAS unsigned char* ring = F.lds + RING_OFF;
    const int cid = (int)blockIdx.x;
    const int kj = cid >> 3, KOFF_ST = (F.G == 256) ? 2 * (((kj & 7) + (kj >> 3)) & 3) : 0, KOFF_MOE = (F.G == 256) ? 2 * (((kj >> 2) + (kj & 3)) & 3) : 0;

    if (IN(0)) { p0_prologue(F); }
#if (PROBE_MASK >> 0) & 1
    if (IN(0)) { frame_ids(F); VM_WAIT(); __syncthreads(); }
    if (IN(0)) { p0_prologue(F); }
#endif
 SEAM(0);
    if (IN(1)) {
        { pg8::Gemm g{(const bf16*)(F.ws + WS_H), (const bf16*)(F.ws + WS_WIN), T, NPROJ - 3072, D}; pg8::InProjOrder<0> S; S.init(T, NPROJ - 3072, F.G, cid);
          pg8::EpiAct E{(bf16*)(F.ws + WS_PROJ), NPROJ, 12, 16, 28, 44, 16, 20, 0.125f * 1.4426950408889634f, 0, nullptr, 0.f, 0.f, 1.f};
          pg8::gemm_phase<pg8::EpiAct, pg8::InProjOrder<0>, true, true>(ring, g, S, E, F.wave, KOFF_ST); }
        { pg8::Gemm g{(const bf16*)(F.ws + WS_H8), (const bf16*)(F.ws + WS_WIN8), T, 3072, D / 2}; pg8::InProjOrder<1> S; S.init(T, 3072, F.G, cid);
          pg8::EpiAct E{(bf16*)(F.ws + WS_PROJ), NPROJ, 0, 0, 0, 0, 16, 20, 0.125f * 1.4426950408889634f, 0, nullptr, 0.f, 0.f, 1.f / (HSCALE * WSCALE)};
          pg8::gemm_phase<pg8::EpiAct, pg8::InProjOrder<1>, true, true, true>(ring, g, S, E, F.wave, KOFF_ST); }
    }
#if (PROBE_MASK >> 1) & 1
    if (IN(1)) { frame_ids(F); VM_WAIT(); __syncthreads(); }
    if (IN(1)) {
        { pg8::Gemm g{(const bf16*)(F.ws + WS_H), (const bf16*)(F.ws + WS_WIN), T, NPROJ - 3072, D}; pg8::InProjOrder<0> S; S.init(T, NPROJ - 3072, F.G, cid);
          pg8::EpiAct E{(bf16*)(F.ws + WS_PROJ), NPROJ, 12, 16, 28, 44, 16, 20, 0.125f * 1.4426950408889634f, 1, nullptr, 0.f, 0.f, 1.f};
          pg8::gemm_phase<pg8::EpiAct, pg8::InProjOrder<0>, true, true>(ring, g, S, E, F.wave, KOFF_ST); }
        { pg8::Gemm g{(const bf16*)(F.ws + WS_H8), (const bf16*)(F.ws + WS_WIN8), T, 3072, D / 2}; pg8::InProjOrder<1> S; S.init(T, 3072, F.G, cid);
          pg8::EpiAct E{(bf16*)(F.ws + WS_PROJ), NPROJ, 0, 0, 0, 0, 16, 20, 0.125f * 1.4426950408889634f, 1, nullptr, 0.f, 0.f, 1.f / (HSCALE * WSCALE)};
          pg8::gemm_phase<pg8::EpiAct, pg8::InProjOrder<1>, true, true, true>(ring, g, S, E, F.wave, KOFF_ST); }
    }
#endif
 SEAM(1);
    if (IN(2)) {
        const int par2 = F.vcu & 1;
        for (int s2 = 0; s2 < 2; ++s2) { if ((s2 ^ par2) == 0) p_conv(F); else p_band_attn(F, 0, NB2); }
    }
#if (PROBE_MASK >> 2) & 1
    if (IN(2)) { frame_ids(F); VM_WAIT(); __syncthreads(); }
    if (IN(2)) { p_conv(F); }
#endif
 SEAM(2);
    if (IN(3)) { p_local_band(F); }
#if (PROBE_MASK >> 19) & 1
    if (IN(3)) { p_mlstm_local(F); }
#endif
#if (PROBE_MASK >> 20) & 1
    if (IN(3)) { p_band_attn(F); }
#endif
#if (PROBE_MASK >> 3) & 1
    if (IN(3)) { frame_ids(F); VM_WAIT(); __syncthreads(); }
    if (IN(3)) { p_mlstm_local(F); p_band_attn(F); }
#endif
 SEAM(3);
    if (IN(4)) { p_mlstm_scan(F); }
#if (PROBE_MASK >> 4) & 1
    if (IN(4)) { frame_ids(F); VM_WAIT(); __syncthreads(); }
    if (IN(4)) { p_mlstm_scan(F); }
#endif
 SEAM(4);
    if (IN(5)) { p_mlstm_out(F); }
#if (PROBE_MASK >> 5) & 1
    if (IN(5)) { frame_ids(F); VM_WAIT(); __syncthreads(); }
    if (IN(5)) { p_mlstm_out(F); }
#endif
 SEAM(5);
    if (IN(6)) { pg8::Gemm g{(const bf16*)(F.ws + WS_HM), (const bf16*)(F.ws + WS_WBM), T, D, 2048}; pg8::StaticOrder S; S.init(T, D, F.G, cid);
        pg8::EpiMerge E{(const bf16*)(F.ws + WS_PROJ), NPROJ, PG_M, PG_A, (bf16*)(F.ws + WS_MRG), D};
        pg8::gemm_phase<pg8::EpiMerge, pg8::StaticOrder, true, true>(ring, g, S, E, F.wave); }
#if (PROBE_MASK >> 6) & 1
    if (IN(6)) { frame_ids(F); VM_WAIT(); __syncthreads(); }
    if (IN(6)) { pg8::Gemm g{(const bf16*)(F.ws + WS_HM), (const bf16*)(F.ws + WS_WBM), T, D, 2048}; pg8::StaticOrder S; S.init(T, D, F.G, cid);
        pg8::EpiMerge E{(const bf16*)(F.ws + WS_PROJ), NPROJ, PG_M, PG_A, (bf16*)(F.ws + WS_MRG), D};
        pg8::gemm_phase<pg8::EpiMerge, pg8::StaticOrder, true, true>(ring, g, S, E, F.wave); }
#endif
 SEAM(6);
    if (IN(7)) { pg8::Gemm g{(const bf16*)(F.ws + WS_MRG), (const bf16*)(F.ws + WS_WOUT), T, D, D}; pg8::StaticOrder S; S.init(T, D, F.G, cid);
        pg8::EpiResB<false> E{(bf16*)(F.ws + WS_XN1), D, (const void*)F.in[I_X], (float*)(F.ws + WS_SSQ1)};
        pg8::gemm_phase<pg8::EpiResB<false>, pg8::StaticOrder, true, true>(ring, g, S, E, F.wave, KOFF_ST); }
#if (PROBE_MASK >> 7) & 1
    if (IN(7)) { frame_ids(F); VM_WAIT(); __syncthreads(); }
    if (IN(7)) { pg8::Gemm g{(const bf16*)(F.ws + WS_MRG), (const bf16*)(F.ws + WS_WOUT), T, D, D}; pg8::StaticOrder S; S.init(T, D, F.G, cid);
        pg8::EpiResB<false> E{(bf16*)(F.ws + WS_XN1), D, (const void*)F.in[I_X], (float*)(F.ws + WS_SSQ1)};
        pg8::gemm_phase<pg8::EpiResB<false>, pg8::StaticOrder, true, true>(ring, g, S, E, F.wave, KOFF_ST); }
#endif
 SEAM(7);
    if (IN(9)) {
        if (cid < 128 || F.G != 256) { pg8::Gemm g{(const bf16*)(F.ws + WS_XN1), (const bf16*)(F.ws + WS_WQ), T, XW, D}; pg8::StaticOrder S; S.init(T, XW, F.G, cid);
            pg8::EpiAct E{(bf16*)(F.ws + WS_QX), XW, 0, 0, 0, 0, 0, 2, 0.08838834764831845f * 1.4426950408889634f, 0, (const float*)(F.ws + WS_SSQ1), 1.f / D, EPS, 1.f};
            pg8::gemm_phase<pg8::EpiAct, pg8::StaticOrder, true, true>(ring, g, S, E, F.wave, KOFF_ST); }
        if (cid >= 128 || F.G != 256) {
            pg8::Gemm g{(const bf16*)(F.ws + WS_MEMN), (const bf16*)(F.ws + WS_WKV), BATCH * NMEM, 2 * XW, D}; pg8::StaticOrder S; S.init(BATCH * NMEM, 2 * XW, F.G == 256 ? 128 : F.G, F.G == 256 ? cid - 128 : cid);
            pg8::EpiAct E{(bf16*)(F.ws + WS_KVX), 2 * XW, 0, 0, 0, 0, 0, 0, 1.f, 0, nullptr, 0.f, 0.f, 1.f};
            pg8::gemm_phase<pg8::EpiAct, pg8::StaticOrder, true, true>(ring, g, S, E, F.wave, KOFF_ST); }
        if (F.G == 256) { if (cid >= 256 - LATE_WG) { frame_ids(F); weight_tiles(F, NTILES - NT_LATE, NTILES, cid - (256 - LATE_WG), LATE_WG); } }
        else { frame_ids(F); __syncthreads(); weight_tiles(F, NTILES - NT_LATE, NTILES, F.vcu, F.G); }
    }
#if (PROBE_MASK >> 9) & 1
    if (IN(9)) { frame_ids(F); VM_WAIT(); __syncthreads(); }
    if (IN(9)) {
        if (cid < 128 || F.G != 256) { pg8::Gemm g{(const bf16*)(F.ws + WS_XN1), (const bf16*)(F.ws + WS_WQ), T, XW, D}; pg8::StaticOrder S; S.init(T, XW, F.G, cid);
            pg8::EpiAct E{(bf16*)(F.ws + WS_QX), XW, 0, 0, 0, 0, 0, 2, 0.08838834764831845f * 1.4426950408889634f, 0, (const float*)(F.ws + WS_SSQ1), 1.f / D, EPS, 1.f};
            pg8::gemm_phase<pg8::EpiAct, pg8::StaticOrder, true, true>(ring, g, S, E, F.wave, KOFF_ST); }
        if (cid >= 128 || F.G != 256) {
            pg8::Gemm g{(const bf16*)(F.ws + WS_MEMN), (const bf16*)(F.ws + WS_WKV), BATCH * NMEM, 2 * XW, D}; pg8::StaticOrder S; S.init(BATCH * NMEM, 2 * XW, F.G == 256 ? 128 : F.G, F.G == 256 ? cid - 128 : cid);
            pg8::EpiAct E{(bf16*)(F.ws + WS_KVX), 2 * XW, 0, 0, 0, 0, 0, 0, 1.f, 0, nullptr, 0.f, 0.f, 1.f};
            pg8::gemm_phase<pg8::EpiAct, pg8::StaticOrder, true, true>(ring, g, S, E, F.wave, KOFF_ST); }
        if (F.G == 256) { if (cid >= 256 - LATE_WG) { frame_ids(F); weight_tiles(F, NTILES - NT_LATE, NTILES, cid - (256 - LATE_WG), LATE_WG); } }
        else { frame_ids(F); __syncthreads(); weight_tiles(F, NTILES - NT_LATE, NTILES, F.vcu, F.G); }
    }
#endif
 SEAM(9);
    if (IN(10)) { p_cross_attn(F); }
#if (PROBE_MASK >> 10) & 1
    if (IN(10)) { frame_ids(F); VM_WAIT(); __syncthreads(); }
    if (IN(10)) { p_cross_attn(F); }
#endif
 SEAM(10);
    if (IN(11)) { pg8::Gemm g{(const bf16*)(F.ws + WS_OX), (const bf16*)(F.ws + WS_WO), T, D, XW}; pg8::StaticOrder S; S.init(T, D, F.G, cid);
        pg8::EpiResB<true> E{(bf16*)(F.ws + WS_X2), D, (const void*)(F.ws + WS_XN1), nullptr};
        pg8::gemm_phase<pg8::EpiResB<true>, pg8::StaticOrder, true, true>(ring, g, S, E, F.wave, KOFF_ST); }
#if (PROBE_MASK >> 11) & 1
    if (IN(11)) { frame_ids(F); VM_WAIT(); __syncthreads(); }
    if (IN(11)) { pg8::Gemm g{(const bf16*)(F.ws + WS_OX), (const bf16*)(F.ws + WS_WO), T, D, XW}; pg8::StaticOrder S; S.init(T, D, F.G, cid);
        pg8::EpiResB<true> E{(bf16*)(F.ws + WS_X2), D, (const void*)(F.ws + WS_XN1), nullptr};
        pg8::gemm_phase<pg8::EpiResB<true>, pg8::StaticOrder, true, true>(ring, g, S, E, F.wave, KOFF_ST); }
#endif
 SEAM(11);
    if (IN(12)) { p_norm_route(F); }
#if (PROBE_MASK >> 12) & 1
    if (IN(12)) { frame_ids(F); VM_WAIT(); __syncthreads(); }
    if (IN(12)) { p_norm_route(F); }
#endif
    do { if (IN(12) && IN(15)) { frame_ids(F); xcd_barrier(bar, F.tid); } } while (0);
    if (IN(15)) { p_route_b(F); }
#if (PROBE_MASK >> 15) & 1
    if (IN(15)) { frame_ids(F); VM_WAIT(); __syncthreads(); }
    if (IN(15)) { p_route_b(F); }
#endif
 SEAM(15);
    if (IN(16)) { const int* BLKE = (const int*)ctl + CW_BLKE; const int nblk = ((const int*)ctl)[CW_NBLK];
        pg8::Gemm g{(const bf16*)(F.ws + WS_XPERM), (const bf16*)(F.ws + WS_WGU), NROWS_MAX, 2 * DFF, D / 2};
        pg8::MoeOrder S{2 * DFF / 256, F.G, cid, nblk, BLKE, (size_t)2 * DFF * D};
        pg8::EpiSwiGLU E{(unsigned char*)(F.ws + WS_ACT), DFF, F.in[I_BGU], BLKE, DFF, 1.f / (XSCALE * WSCALE), ASCALE, (const float*)(F.ws + WS_RROW)};
        pg8::gemm_phase<pg8::EpiSwiGLU, pg8::MoeOrder, true, true, true>(ring, g, S, E, F.wave, KOFF_MOE); }
#if (PROBE_MASK >> 16) & 1
    if (IN(16)) { frame_ids(F); VM_WAIT(); __syncthreads(); }
    if (IN(16)) { const int* BLKE = (const int*)ctl + CW_BLKE; const int nblk = ((const int*)ctl)[CW_NBLK];
        pg8::Gemm g{(const bf16*)(F.ws + WS_XPERM), (const bf16*)(F.ws + WS_WGU), NROWS_MAX, 2 * DFF, D / 2};
        pg8::MoeOrder S{2 * DFF / 256, F.G, cid, nblk, BLKE, (size_t)2 * DFF * D};
        pg8::EpiSwiGLU E{(unsigned char*)(F.ws + WS_ACT), DFF, F.in[I_BGU], BLKE, DFF, 1.f / (XSCALE * WSCALE), ASCALE, (const float*)(F.ws + WS_RROW)};
        pg8::gemm_phase<pg8::EpiSwiGLU, pg8::MoeOrder, true, true, true>(ring, g, S, E, F.wave, KOFF_MOE); }
#endif
 SEAM(16);
    if (IN(17)) { const int* BLKE = (const int*)ctl + CW_BLKE; const int nblk = ((const int*)ctl)[CW_NBLK];
        pg8::Gemm g{(const bf16*)(F.ws + WS_ACT), (const bf16*)(F.ws + WS_WDN), NROWS_MAX, D, DFF / 2};
        pg8::MoeOrder S{D / 256, F.G, cid, nblk, BLKE, (size_t)D * DFF};
        pg8::EpiDown E{(unsigned char*)(F.ws + WS_YR), D, F.in[I_BDN], BLKE, (const float*)(F.ws + WS_RGATE), 1.f / (ASCALE * WSCALE), YSCALE};
        pg8::gemm_phase<pg8::EpiDown, pg8::MoeOrder, true, true, true>(ring, g, S, E, F.wave, KOFF_MOE); }
#if (PROBE_MASK >> 17) & 1
    if (IN(17)) { frame_ids(F); VM_WAIT(); __syncthreads(); }
    if (IN(17)) { const int* BLKE = (const int*)ctl + CW_BLKE; const int nblk = ((const int*)ctl)[CW_NBLK];
        pg8::Gemm g{(const bf16*)(F.ws + WS_ACT), (const bf16*)(F.ws + WS_WDN), NROWS_MAX, D, DFF / 2};
        pg8::MoeOrder S{D / 256, F.G, cid, nblk, BLKE, (size_t)D * DFF};
        pg8::EpiDown E{(unsigned char*)(F.ws + WS_YR), D, F.in[I_BDN], BLKE, (const float*)(F.ws + WS_RGATE), 1.f / (ASCALE * WSCALE), YSCALE};
        pg8::gemm_phase<pg8::EpiDown, pg8::MoeOrder, true, true, true>(ring, g, S, E, F.wave, KOFF_MOE); }
#endif
 SEAM(17);
    if (IN(18)) { p_combine(F); }
#if (PROBE_MASK >> 18) & 1
    if (IN(18)) { frame_ids(F); VM_WAIT(); __syncthreads(); }
    if (IN(18)) { p_combine(F); }
#endif

#undef IN
#undef SEAM
}

#ifndef MK_SPLIT
#define MK_SPLIT 0
#endif
extern "C" void kernel_launch(void* const* d_in, const int* in_sizes, int n_in, void* d_out, int out_size, void* d_ws, size_t ws_size, hipStream_t stream) {
    static int grid = 0;
    if (grid == 0) {
        if (n_in != 25 || in_sizes[0] != T * D || out_size != T * D || ws_size < WS_END) { fprintf(stderr, "kernel_launch: unexpected shapes (n_in %d in0 %d out %d ws %zu need %zu)\n", n_in, n_in > 0 ? in_sizes[0] : -1, out_size, ws_size, (size_t)WS_END); grid = -1; return; }
        int dev = 0, cus = 0, per_cu = 0;
        if (hipGetDevice(&dev) != hipSuccess || hipDeviceGetAttribute(&cus, hipDeviceAttributeMultiprocessorCount, dev) != hipSuccess) { grid = -1; return; }
        if (hipFuncSetAttribute((const void*)mk_fwd, hipFuncAttributeMaxDynamicSharedMemorySize, LDS_BYTES) != hipSuccess) { fprintf(stderr, "kernel_launch: hipFuncSetAttribute failed\n"); grid = -1; return; }
        if (hipOccupancyMaxActiveBlocksPerMultiprocessor(&per_cu, (const void*)mk_fwd, NTHR, LDS_BYTES) != hipSuccess || per_cu < 1) fprintf(stderr, "kernel_launch: occupancy query reports %d\n", per_cu);
        (void)hipGetLastError();
        grid = cus;
    }
    if (grid < 0) return;
    (void)hipMemsetAsync((char*)d_ws + WS_CTL, 0, CTL_ZERO_BYTES, stream);
    Args a{};
    for (int i = 0; i < 25; ++i) a.in[i] = (const float*)d_in[i];
    a.out = (float*)d_out; a.ws = (unsigned char*)d_ws;
#if MK_SPLIT
    for (int p = 0; p < 19; ++p) { a.ph_lo = p; a.ph_hi = p + 1; hipLaunchKernelGGL(mk_fwd, dim3(grid), dim3(NTHR), LDS_BYTES, stream, a); }
#else
    a.ph_lo = 0; a.ph_hi = 19; hipLaunchKernelGGL(mk_fwd, dim3(grid), dim3(NTHR), LDS_BYTES, stream, a);
#endif
}
```

```cpp
#include <hip/hip_runtime.h>
#include <cstdio>
#include <cstdint>
namespace pg8 {
#define PG8_LAS __attribute__((address_space(3)))
typedef unsigned short bf16_t;
typedef short bf16x8 __attribute__((ext_vector_type(8)));
typedef float f32x4 __attribute__((ext_vector_type(4)));
typedef unsigned u32x4 __attribute__((ext_vector_type(4)));
constexpr int BM = 256, BK = 64, HALF = 128, HTB = HALF * BK * 2  , STAGE_BYTES = 8 * HTB, NXCD = 8, WGM = 8;

__host__ __device__ __forceinline__ int lds_byte(int r, int c) { const int st = (r >> 4) * 2 + (c >> 5), rr = r & 15, cc = c & 31, ob = rr * 64 + cc * 2; return st * 1024 + (ob ^ (((ob >> 9) & 1) << 5)); }
__host__ __device__ __forceinline__ void stage_rc(int b, int& R, int& C) { const int st = b / 1024, sb = b % 1024, swz = sb ^ (((sb >> 9) & 1) << 5); R = (st >> 1) * 16 + swz / 64; C = (st & 1) * 32 + (swz % 64) / 2; }
__host__ __device__ __forceinline__ int perm32(int rho) { const int n = rho >> 4, i = rho & 15; return 8 * (i >> 2) + 4 * n + (i & 3); }

struct Unit { int pm, pn; };
struct Gemm { const bf16_t* A; const bf16_t* Bt; int M, N, K; };

struct StaticOrder {
    int nM, nN, nwg, G, c;
    __host__ __device__ void init(int M, int N, int G_, int c_) { nM = M / BM; nN = N / BM; nwg = nM * nN; G = G_; c = c_; }
    __host__ __device__ bool next(int i, Unit& u) const {
        const long L = (long)i * G + c; if (L >= nwg) return false;
        int wgid = (int)L; { const int q = nwg / NXCD, r = nwg % NXCD, xcd = wgid % NXCD, off = wgid / NXCD; wgid = (xcd < r ? xcd * (q + 1) : r * (q + 1) + (xcd - r) * q) + off; }
        const int nig = WGM * nN, gid = wgid / nig, fm = gid * WGM, gsz = (nM - fm) < WGM ? (nM - fm) : WGM;
        u.pm = fm + ((wgid % nig) % gsz); u.pn = (wgid % nig) / gsz; return true;
    }
    __device__ __forceinline__ const char* a_base(const Gemm& g, const Unit& u) const { return (const char*)g.A + (size_t)u.pm * ((size_t)BM * g.K * 2); }
    __device__ __forceinline__ const char* b_base(const Gemm& g, const Unit& u) const { return (const char*)g.Bt + (size_t)u.pn * ((size_t)BM * g.K * 2); }
    __device__ __forceinline__ void a_ready(const Unit&) const {}
    __device__ __forceinline__ void done(const Unit&) const {}
};


template <int MODE> struct InProjOrder : StaticOrder {
    __device__ __forceinline__ bool next(int i, Unit& u) const { if (!StaticOrder::next(i, u)) return false;
        const int l = u.pn; u.pn = (MODE == 0) ? l : (12 + l); return true; }
    __device__ __forceinline__ const char* b_base(const Gemm& g, const Unit& u) const {
        const int t = (MODE == 0) ? u.pn : (u.pn - 12); return (const char*)g.Bt + (size_t)t * ((size_t)BM * g.K * 2); }
};

struct MoeOrder {
    int nN, G, c, nblk; const int* block_e; size_t bstride;
    __device__ __forceinline__ bool next(int i, Unit& u) const {
        if (G == 256 && (nN == 16 || nN == 8)) {
            const int xc = nN / 4, rpr = (8 / xc) * 8, x = c & 7, j = c >> 3;
            u.pm = i * rpr + (x / xc) * 8 + (j >> 2); u.pn = (x % xc) * 4 + (j & 3);
            if (i * rpr >= nblk) return false;
            return u.pm < nblk;
        }
        const long L = (long)i * G + c; if (L >= (long)nblk * nN) return false;
        u.pm = (int)(L / nN); u.pn = (int)(L % nN); return true;
    }
    __device__ __forceinline__ const char* a_base(const Gemm& g, const Unit& u) const { return (const char*)g.A + (size_t)u.pm * ((size_t)BM * g.K * 2); }
    __device__ __forceinline__ const char* b_base(const Gemm& g, const Unit& u) const { return (const char*)g.Bt + (size_t)block_e[u.pm] * bstride + (size_t)u.pn * ((size_t)BM * g.K * 2); }
    __device__ __forceinline__ void a_ready(const Unit&) const {}
    __device__ __forceinline__ void done(const Unit&) const {}
};

typedef unsigned u32x2 __attribute__((ext_vector_type(2)));
typedef int v8i_t __attribute__((ext_vector_type(8)));
typedef int v4i_t __attribute__((ext_vector_type(4)));
__device__ __forceinline__ v8i_t cat8(bf16x8 lo, bf16x8 hi) { const v4i_t a = __builtin_bit_cast(v4i_t, lo), b = __builtin_bit_cast(v4i_t, hi); return __builtin_shufflevector(a, b, 0, 1, 2, 3, 4, 5, 6, 7); }
__device__ __forceinline__ unsigned pk_fp8x4(float a, float b, float c, float d) {
    a = __builtin_amdgcn_fmed3f(a, -448.f, 448.f); b = __builtin_amdgcn_fmed3f(b, -448.f, 448.f); c = __builtin_amdgcn_fmed3f(c, -448.f, 448.f); d = __builtin_amdgcn_fmed3f(d, -448.f, 448.f);
    int w = 0; w = __builtin_amdgcn_cvt_pk_fp8_f32(a, b, w, false); w = __builtin_amdgcn_cvt_pk_fp8_f32(c, d, w, true); return (unsigned)w; }
typedef __bf16 bf2_t __attribute__((ext_vector_type(2)));
typedef float f32x2_t __attribute__((ext_vector_type(2)));
__device__ __forceinline__ unsigned cvt_pk_bf16_c(float lo, float hi) { const f32x2_t v = {lo, hi}; const bf2_t r = __builtin_convertvector(v, bf2_t); return __builtin_bit_cast(unsigned, r); }
__device__ __forceinline__ unsigned cvt_pk_bf16(float lo, float hi) { unsigned r; asm volatile("v_cvt_pk_bf16_f32 %0, %1, %2" : "=v"(r) : "v"(lo), "v"(hi)); return r; }
__device__ __forceinline__ float bf_lo(unsigned w) { return __builtin_bit_cast(float, w << 16); }
__device__ __forceinline__ float bf_hi(unsigned w) { return __builtin_bit_cast(float, w & 0xffff0000u); }
__device__ __forceinline__ float sigmoidf_(float x) { return __builtin_amdgcn_rcpf(1.f + __expf(-x)); }

struct EpiAct {
    static constexpr bool PERM = true, AFTER_DRAIN = false; static constexpr int MIDK = 0;
    bf16_t* O; int ldc; int s1lo, s1hi, s2lo, s2hi, clo, chi; float sc; int nostore; const float* ssq; float inv_n, eps; float gsc;
    __device__ __forceinline__ void operator()(const f32x4 (&acc)[2][2][4][2], const Unit& u, int wr, int wc, int fr, int fq) const {
        const int row0 = u.pm * BM + wr * 64 + fr, col0 = u.pn * BM + wc * 32 + 8 * fq;
        const bool sg = (u.pn >= s1lo && u.pn < s1hi) || (u.pn >= s2lo && u.pn < s2hi);
        const float s = (sg ? 1.f : gsc) * ((u.pn >= clo && u.pn < chi) ? sc : 1.f);
        float rscv[2][4];
#pragma unroll
        for (int ai = 0; ai < 2; ++ai)
#pragma unroll
            for (int m = 0; m < 4; ++m) { float rsc = s;
                if (ssq) { const f32x4* sp = (const f32x4*)(ssq + (size_t)(row0 + ai * HALF + m * 16) * 32); float t = 0.f;
#pragma unroll
                    for (int q = 0; q < 8; ++q) { const f32x4 p4 = sp[q]; t += p4[0]; t += p4[1]; t += p4[2]; t += p4[3]; }
                    rsc = s * (1.f / sqrtf(t * inv_n + eps)); }
                rscv[ai][m] = rsc; }
#pragma unroll
        for (int ai = 0; ai < 2; ++ai)
#pragma unroll
            for (int m = 0; m < 4; ++m) { bf16_t* rowp = O + (size_t)(row0 + ai * HALF + m * 16) * ldc + col0;
                const float rsc = rscv[ai][m];
#pragma unroll
                for (int bj = 0; bj < 2; ++bj) { f32x4 v0 = acc[ai][bj][m][0], v1 = acc[ai][bj][m][1];
                    if (sg) {
#pragma unroll
                        for (int j = 0; j < 4; ++j) { v0[j] = sigmoidf_(v0[j] * gsc); v1[j] = sigmoidf_(v1[j] * gsc); } }
                    v0 = v0 * rsc; v1 = v1 * rsc;
                    u32x4 w; w.x = cvt_pk_bf16(v0[0], v0[1]); w.y = cvt_pk_bf16(v0[2], v0[3]); w.z = cvt_pk_bf16(v1[0], v1[1]); w.w = cvt_pk_bf16(v1[2], v1[3]);
                    if (!nostore) *(u32x4*)(rowp + bj * HALF) = w; } }
    }
};

template <bool ADD> struct EpiGate {
    static constexpr bool PERM = true, AFTER_DRAIN = false; static constexpr int MIDK = 0;
    const bf16_t* Gt; int ldg, goff; const bf16_t* Tin; bf16_t* O; int ldo;
    __device__ __forceinline__ void operator()(const f32x4 (&acc)[2][2][4][2], const Unit& u, int wr, int wc, int fr, int fq) const {
        const int row0 = u.pm * BM + wr * 64 + fr, col0 = u.pn * BM + wc * 32 + 8 * fq;
#pragma unroll
        for (int ai = 0; ai < 2; ++ai)
#pragma unroll
            for (int m = 0; m < 4; ++m) { const size_t row = (size_t)(row0 + ai * HALF + m * 16);
#pragma unroll
                for (int bj = 0; bj < 2; ++bj) { const int col = col0 + bj * HALF;
                    const u32x4 gw = *(const u32x4*)(Gt + row * ldg + goff + col);
                    f32x4 v0 = acc[ai][bj][m][0], v1 = acc[ai][bj][m][1];
                    v0[0] *= bf_lo(gw.x); v0[1] *= bf_hi(gw.x); v0[2] *= bf_lo(gw.y); v0[3] *= bf_hi(gw.y);
                    v1[0] *= bf_lo(gw.z); v1[1] *= bf_hi(gw.z); v1[2] *= bf_lo(gw.w); v1[3] *= bf_hi(gw.w);
                    if (ADD) { const u32x4 tw = *(const u32x4*)(Tin + row * ldo + col);
                        v0[0] += bf_lo(tw.x); v0[1] += bf_hi(tw.x); v0[2] += bf_lo(tw.y); v0[3] += bf_hi(tw.y);
                        v1[0] += bf_lo(tw.z); v1[1] += bf_hi(tw.z); v1[2] += bf_lo(tw.w); v1[3] += bf_hi(tw.w); }
                    u32x4 w; w.x = cvt_pk_bf16(v0[0], v0[1]); w.y = cvt_pk_bf16(v0[2], v0[3]); w.z = cvt_pk_bf16(v1[0], v1[1]); w.w = cvt_pk_bf16(v1[2], v1[3]);
                    *(u32x4*)(O + row * ldo + col) = w; } }
    }
};


struct EpiMerge {
    static constexpr bool PERM = true, AFTER_DRAIN = false; static constexpr int MIDK = 16;
    const bf16_t* Gt; int ldg, gm_off, ga_off; bf16_t* O; int ldo;
    __device__ __forceinline__ void mid(f32x4 (&acc)[2][2][4][2], const Unit& u, int wr, int wc, int fr, int fq) const {
        const int row0 = u.pm * BM + wr * 64 + fr, col0 = u.pn * BM + wc * 32 + 8 * fq;
#pragma unroll
        for (int ai = 0; ai < 2; ++ai)
#pragma unroll
            for (int m = 0; m < 4; ++m) { const size_t ro = (size_t)(row0 + ai * HALF + m * 16) * ldg + col0;
#pragma unroll
                for (int bj = 0; bj < 2; ++bj) { const u32x4 gm = *(const u32x4*)(Gt + ro + gm_off + bj * HALF), ga = *(const u32x4*)(Gt + ro + ga_off + bj * HALF);
                    f32x4& v0 = acc[ai][bj][m][0]; f32x4& v1 = acc[ai][bj][m][1];
                    v0[0] *= bf_lo(gm.x) * __builtin_amdgcn_rcpf(bf_lo(ga.x)); v0[1] *= bf_hi(gm.x) * __builtin_amdgcn_rcpf(bf_hi(ga.x)); v0[2] *= bf_lo(gm.y) * __builtin_amdgcn_rcpf(bf_lo(ga.y)); v0[3] *= bf_hi(gm.y) * __builtin_amdgcn_rcpf(bf_hi(ga.y));
                    v1[0] *= bf_lo(gm.z) * __builtin_amdgcn_rcpf(bf_lo(ga.z)); v1[1] *= bf_hi(gm.z) * __builtin_amdgcn_rcpf(bf_hi(ga.z)); v1[2] *= bf_lo(gm.w) * __builtin_amdgcn_rcpf(bf_lo(ga.w)); v1[3] *= bf_hi(gm.w) * __builtin_amdgcn_rcpf(bf_hi(ga.w)); } }
    }
    __device__ __forceinline__ void operator()(const f32x4 (&acc)[2][2][4][2], const Unit& u, int wr, int wc, int fr, int fq) const {
        const int row0 = u.pm * BM + wr * 64 + fr, col0 = u.pn * BM + wc * 32 + 8 * fq;
        u32x4 gwv[2][4][2];
#pragma unroll
        for (int ai = 0; ai < 2; ++ai)
#pragma unroll
            for (int m = 0; m < 4; ++m)
#pragma unroll
                for (int bj = 0; bj < 2; ++bj) gwv[ai][m][bj] = *(const u32x4*)(Gt + (size_t)(row0 + ai * HALF + m * 16) * ldg + ga_off + col0 + bj * HALF);
#pragma unroll
        for (int ai = 0; ai < 2; ++ai)
#pragma unroll
            for (int m = 0; m < 4; ++m) { const size_t row = (size_t)(row0 + ai * HALF + m * 16);
#pragma unroll
                for (int bj = 0; bj < 2; ++bj) { const int col = col0 + bj * HALF;
                    const u32x4 gw = gwv[ai][m][bj];
                    f32x4 v0 = acc[ai][bj][m][0], v1 = acc[ai][bj][m][1];
                    v0[0] *= bf_lo(gw.x); v0[1] *= bf_hi(gw.x); v0[2] *= bf_lo(gw.y); v0[3] *= bf_hi(gw.y);
                    v1[0] *= bf_lo(gw.z); v1[1] *= bf_hi(gw.z); v1[2] *= bf_lo(gw.w); v1[3] *= bf_hi(gw.w);
                    u32x4 w; w.x = cvt_pk_bf16(v0[0], v0[1]); w.y = cvt_pk_bf16(v0[2], v0[3]); w.z = cvt_pk_bf16(v1[0], v1[1]); w.w = cvt_pk_bf16(v1[2], v1[3]);
                    *(u32x4*)(O + row * ldo + col) = w; } }
    }
};

struct EpiResF32 {
    static constexpr bool PERM = false, AFTER_DRAIN = false; static constexpr int MIDK = 0;
    float* C; int ldc; const float* R;
    __device__ __forceinline__ void operator()(const f32x4 (&acc)[2][2][4][2], const Unit& u, int wr, int wc, int fr, int fq) const {
        const int row0 = u.pm * BM + wr * 64 + fr, col0 = u.pn * BM + wc * 32 + 4 * fq;
#pragma unroll
        for (int ai = 0; ai < 2; ++ai)
#pragma unroll
            for (int m = 0; m < 4; ++m) { const size_t ro = (size_t)(row0 + ai * HALF + m * 16) * ldc + col0;
#pragma unroll
                for (int bj = 0; bj < 2; ++bj)
#pragma unroll
                    for (int n = 0; n < 2; ++n) { f32x4 v = acc[ai][bj][m][n];
                        if (R) v = v + *(const f32x4*)(R + ro + bj * HALF + n * 16);
                        *(f32x4*)(C + ro + bj * HALF + n * 16) = v; } }
    }
};


struct EpiResNorm {
    static constexpr bool PERM = true, AFTER_DRAIN = false; static constexpr int MIDK = 0;
    float* C; int ldc; const float* R; bf16_t* XB; const float* wcol; float* SSQ;
    __device__ __forceinline__ void operator()(const f32x4 (&acc)[2][2][4][2], const Unit& u, int wr, int wc, int fr, int fq) const {
        const int row0 = u.pm * BM + wr * 64 + fr, col0 = u.pn * BM + wc * 32 + 8 * fq;
        f32x4 wv[2][2];
#pragma unroll
        for (int bj = 0; bj < 2; ++bj)
#pragma unroll
            for (int n = 0; n < 2; ++n) wv[bj][n] = *(const f32x4*)(wcol + col0 + bj * HALF + 4 * n);
#pragma unroll
        for (int ai = 0; ai < 2; ++ai)
#pragma unroll
            for (int m = 0; m < 4; ++m) { const int row = row0 + ai * HALF + m * 16; const size_t ro = (size_t)row * ldc + col0; float ss = 0.f;
#pragma unroll
                for (int bj = 0; bj < 2; ++bj) {
                    const f32x4 v0 = acc[ai][bj][m][0] + *(const f32x4*)(R + ro + bj * HALF), v1 = acc[ai][bj][m][1] + *(const f32x4*)(R + ro + bj * HALF + 4);
                    *(f32x4*)(C + ro + bj * HALF) = v0; *(f32x4*)(C + ro + bj * HALF + 4) = v1;
                    ss += (v0[0] * v0[0] + v0[1] * v0[1]) + (v0[2] * v0[2] + v0[3] * v0[3]) + (v1[0] * v1[0] + v1[1] * v1[1]) + (v1[2] * v1[2] + v1[3] * v1[3]);
                    const f32x4 y0 = v0 * wv[bj][0], y1 = v1 * wv[bj][1];
                    u32x4 w; w.x = cvt_pk_bf16(y0[0], y0[1]); w.y = cvt_pk_bf16(y0[2], y0[3]); w.z = cvt_pk_bf16(y1[0], y1[1]); w.w = cvt_pk_bf16(y1[2], y1[3]);
                    *(u32x4*)(XB + ro + bj * HALF) = w; }
                ss += __shfl_xor(ss, 16); ss += __shfl_xor(ss, 32);
                if (fq == 0) SSQ[(size_t)row * 32 + 4 * u.pn + wc] = ss; }
    }
};


template <bool RB> struct EpiResB {
    static constexpr bool PERM = true, AFTER_DRAIN = false; static constexpr int MIDK = 0;
    bf16_t* C; int ldc; const void* R; float* SSQ;
    __device__ __forceinline__ void operator()(const f32x4 (&acc)[2][2][4][2], const Unit& u, int wr, int wc, int fr, int fq) const {
        const int row0 = u.pm * BM + wr * 64 + fr, col0 = u.pn * BM + wc * 32 + 8 * fq;
#pragma unroll
        for (int ai = 0; ai < 2; ++ai) {
            u32x4 rwv[4][2]; f32x4 rfv[4][2][2];
#pragma unroll
            for (int m = 0; m < 4; ++m)
#pragma unroll
                for (int bj = 0; bj < 2; ++bj) { const size_t ro = (size_t)(row0 + ai * HALF + m * 16) * ldc + col0 + bj * HALF;
                    if (RB) rwv[m][bj] = *(const u32x4*)((const bf16_t*)R + ro);
                    else { rfv[m][bj][0] = *(const f32x4*)((const float*)R + ro); rfv[m][bj][1] = *(const f32x4*)((const float*)R + ro + 4); } }
#pragma unroll
            for (int m = 0; m < 4; ++m) { const int row = row0 + ai * HALF + m * 16; const size_t ro = (size_t)row * ldc + col0; float ss = 0.f;
#pragma unroll
                for (int bj = 0; bj < 2; ++bj) { f32x4 v0 = acc[ai][bj][m][0], v1 = acc[ai][bj][m][1];
                    if (RB) { const u32x4 rw = rwv[m][bj];
                        v0[0] += bf_lo(rw.x); v0[1] += bf_hi(rw.x); v0[2] += bf_lo(rw.y); v0[3] += bf_hi(rw.y); v1[0] += bf_lo(rw.z); v1[1] += bf_hi(rw.z); v1[2] += bf_lo(rw.w); v1[3] += bf_hi(rw.w); }
                    else { v0 = v0 + rfv[m][bj][0]; v1 = v1 + rfv[m][bj][1]; }
                    ss += (v0[0] * v0[0] + v0[1] * v0[1]) + (v0[2] * v0[2] + v0[3] * v0[3]) + (v1[0] * v1[0] + v1[1] * v1[1]) + (v1[2] * v1[2] + v1[3] * v1[3]);
                    u32x4 w; w.x = cvt_pk_bf16(v0[0], v0[1]); w.y = cvt_pk_bf16(v0[2], v0[3]); w.z = cvt_pk_bf16(v1[0], v1[1]); w.w = cvt_pk_bf16(v1[2], v1[3]);
                    *(u32x4*)(C + ro + bj * HALF) = w; }
                if (SSQ) { ss += __shfl_xor(ss, 16); ss += __shfl_xor(ss, 32); if (fq == 0) SSQ[(size_t)row * 32 + 4 * u.pn + wc] = ss; } }
        }
    }
};

struct EpiSwiGLU {
    static constexpr bool PERM = true, AFTER_DRAIN = false; static constexpr int MIDK = 0;
    unsigned char* O; int ldo; const float* bgu; const int* block_e; int dff; float ascale, oscale; const float* rrow;
    __device__ __forceinline__ void operator()(const f32x4 (&acc)[2][2][4][2], const Unit& u, int wr, int wc, int fr, int fq) const {
        const int row0 = u.pm * BM + wr * 64 + fr, oc = u.pn * HALF + wc * 32 + 8 * fq;
        const float* bg = bgu + (size_t)block_e[u.pm] * (2 * dff) + oc; const float* bu = bg + dff;
        const f32x4 bg0 = *(const f32x4*)bg, bg1 = *(const f32x4*)(bg + 4), bu0 = *(const f32x4*)bu, bu1 = *(const f32x4*)(bu + 4);
        float rsv[2][4];
#pragma unroll
        for (int ai = 0; ai < 2; ++ai)
#pragma unroll
            for (int m = 0; m < 4; ++m) rsv[ai][m] = rrow[row0 + ai * HALF + m * 16];
#pragma unroll
        for (int ai = 0; ai < 2; ++ai)
#pragma unroll
            for (int m = 0; m < 4; ++m) { const float rs = ascale * rsv[ai][m];
                f32x4 g0 = acc[ai][0][m][0] * rs + bg0, g1 = acc[ai][0][m][1] * rs + bg1, u0 = acc[ai][1][m][0] * rs + bu0, u1 = acc[ai][1][m][1] * rs + bu1, a0, a1;
#pragma unroll
                for (int j = 0; j < 4; ++j) {
                    float g = fminf(g0[j], 7.0f), uu = __builtin_amdgcn_fmed3f(u0[j], -7.0f, 7.0f); a0[j] = (uu + 1.f) * (g * __builtin_amdgcn_rcpf(1.f + __builtin_amdgcn_exp2f(g * (-1.702f * 1.4426950408889634f)))) * oscale;
                    g = fminf(g1[j], 7.0f); uu = __builtin_amdgcn_fmed3f(u1[j], -7.0f, 7.0f); a1[j] = (uu + 1.f) * (g * __builtin_amdgcn_rcpf(1.f + __builtin_amdgcn_exp2f(g * (-1.702f * 1.4426950408889634f)))) * oscale; }
                u32x2 w; w.x = pk_fp8x4(a0[0], a0[1], a0[2], a0[3]); w.y = pk_fp8x4(a1[0], a1[1], a1[2], a1[3]);
                *(u32x2*)(O + (size_t)(row0 + ai * HALF + m * 16) * ldo + oc) = w; }
    }
};

struct EpiDown {
    static constexpr bool PERM = true, AFTER_DRAIN = false; static constexpr int MIDK = 0;
    unsigned char* O; int ldo; const float* bdn; const int* block_e; const float* rgate; float ascale, oscale;
    __device__ __forceinline__ void operator()(const f32x4 (&acc)[2][2][4][2], const Unit& u, int wr, int wc, int fr, int fq) const {
        const int row0 = u.pm * BM + wr * 64 + fr, col0 = u.pn * BM + wc * 32 + 8 * fq;
        const float* bb = bdn + (size_t)block_e[u.pm] * ldo + col0;
        f32x4 bv[2][2];
#pragma unroll
        for (int bj = 0; bj < 2; ++bj)
#pragma unroll
            for (int n = 0; n < 2; ++n) bv[bj][n] = *(const f32x4*)(bb + bj * HALF + 4 * n);
        float gtv[2][4];
#pragma unroll
        for (int ai = 0; ai < 2; ++ai)
#pragma unroll
            for (int m = 0; m < 4; ++m) gtv[ai][m] = rgate[row0 + ai * HALF + m * 16];
#pragma unroll
        for (int ai = 0; ai < 2; ++ai)
#pragma unroll
            for (int m = 0; m < 4; ++m) { const int row = row0 + ai * HALF + m * 16; const float gt = gtv[ai][m] * oscale;
#pragma unroll
                for (int bj = 0; bj < 2; ++bj) { const f32x4 v0 = (acc[ai][bj][m][0] * ascale + bv[bj][0]) * gt, v1 = (acc[ai][bj][m][1] * ascale + bv[bj][1]) * gt;
                    u32x2 w; w.x = pk_fp8x4(v0[0], v0[1], v0[2], v0[3]); w.y = pk_fp8x4(v1[0], v1[1], v1[2], v1[3]);
                    *(u32x2*)(O + (size_t)row * ldo + col0 + bj * HALF) = w; } }
    }
};

template <class Epi, class Sched, bool ALIGN_EPI = false, bool SP2 = false, bool FP8 = false>
__device__ __forceinline__ void gemm_phase(PG8_LAS unsigned char* lds, const Gemm g, const Sched& S, const Epi& E, const int wave_id, const int koff_in = 0) {
    int tid_ = wave_id * 64 + (int)__builtin_amdgcn_mbcnt_hi(~0u, __builtin_amdgcn_mbcnt_lo(~0u, 0u)); asm volatile("" : "+v"(tid_));
    const int tid = tid_, wid = __builtin_amdgcn_readfirstlane(tid >> 6), lane = tid & 63, wr = wid >> 2, wc = wid & 3, fr = lane & 15, fq = lane >> 4;
    const int K = g.K, nt = K / BK;
    const int koff = koff_in & (nt - 1) & ~1;
#define PG8_KO(i) ((size_t)(((i) + koff) & (nt - 1)) * kstep)
    unsigned voffA[2], voffB[2];
#pragma unroll
    for (int i = 0; i < 2; ++i) { int R, C; stage_rc(tid * 16 + i * 8192, R, C); const int Rb = Epi::PERM ? ((R & ~31) + perm32(R & 31)) : R;
        voffA[i] = (unsigned)(R * K + C) * 2u; voffB[i] = (unsigned)(Rb * K + C) * 2u; }
    const size_t kstep = (size_t)(BK * 2);
    const size_t hstep = (size_t)HALF * K * 2;
    const size_t tstep = 2 * hstep; (void)tstep;
    const unsigned ldsw = (unsigned)wid * 1024u;
    const int aoff = lds_byte(wr * 64 + fr, fq * 8), boff = lds_byte(wc * 32 + fr, fq * 8);
#define PG8_SA(b, h) (((b) * 2 + (h)) * HTB)
#define PG8_SB(b, h) ((4 + (b) * 2 + (h)) * HTB)
#define PG8_STAGE(bufoff, gbase, voff) do { _Pragma("unroll") for (int _i = 0; _i < 2; ++_i) \
        __builtin_amdgcn_global_load_lds((const unsigned*)((const char*)(gbase) + (voff)[_i]), (PG8_LAS unsigned*)(lds + (bufoff) + ldsw + _i * 8192), 16, 0, 0); } while (0)
#define PG8_LDA(dst, b, h) do { _Pragma("unroll") for (int m = 0; m < 4; ++m) _Pragma("unroll") for (int k = 0; k < 2; ++k) dst[m][k] = *(const PG8_LAS bf16x8*)(lds + PG8_SA(b, h) + aoff + m * 2048 + k * 1024); } while (0)
#define PG8_LDB(dst, b, h) do { _Pragma("unroll") for (int n = 0; n < 2; ++n) _Pragma("unroll") for (int k = 0; k < 2; ++k) dst[n][k] = *(const PG8_LAS bf16x8*)(lds + PG8_SB(b, h) + boff + n * 2048 + k * 1024); } while (0)
#define PG8_MMA(ai, bj, At, Bt) do { __builtin_amdgcn_s_setprio(1); _Pragma("unroll") for (int m = 0; m < 4; ++m) _Pragma("unroll") for (int n = 0; n < 2; ++n) { \
        if constexpr (FP8) { asm volatile("s_nop 1\n\tv_mfma_scale_f32_16x16x128_f8f6f4 %0, %1, %2, %0, %3, %3 op_sel_hi:[0,0,0]" : "+v"(acc[ai][bj][m][n]) : "v"(cat8(Bt[n][0], Bt[n][1])), "v"(cat8(At[m][0], At[m][1])), "v"(one_scale)); } \
        else { _Pragma("unroll") for (int k = 0; k < 2; ++k) acc[ai][bj][m][n] = __builtin_amdgcn_mfma_f32_16x16x32_bf16(Bt[n][k], At[m][k], acc[ai][bj][m][n], 0, 0, 0); } } \
        __builtin_amdgcn_s_setprio(0); } while (0)
#define PG8_WAIT_V(n) asm volatile("s_waitcnt vmcnt(" #n ")" ::: "memory")
#define PG8_WAIT_L(n) asm volatile("s_waitcnt lgkmcnt(" #n ")" ::: "memory")
#define PG8_BAR __builtin_amdgcn_s_barrier()
#define PG8_SCHED __builtin_amdgcn_sched_barrier(0)
    Unit cur, nxt; int ui = 0;
    if (!S.next(0, cur)) return;
#ifdef PG8_STAGGER
    { const int dly = ((int)blockIdx.x >> 3) & 3; for (int q = 0; q < dly; ++q) { __builtin_amdgcn_s_sleep(60); } }
#endif
    const int one_scale = 0x7F7F7F7F; (void)one_scale;
    f32x4 acc[2][2][4][2];
#pragma unroll
    for (int a = 0; a < 2; ++a)
#pragma unroll
        for (int b = 0; b < 2; ++b)
#pragma unroll
            for (int m = 0; m < 4; ++m)
#pragma unroll
                for (int n = 0; n < 2; ++n) acc[a][b][m][n] = (f32x4){0.f, 0.f, 0.f, 0.f};
    bf16x8 At[4][2], B0[2][2], B1[2][2];
    const char* cA = S.a_base(g, cur); const char* cB = S.b_base(g, cur);
    S.a_ready(cur);
    if constexpr (SP2) {
        PG8_STAGE(PG8_SB(0, 0), cB + PG8_KO(0), voffB); PG8_STAGE(PG8_SB(0, 1), cB + hstep + PG8_KO(0), voffB); PG8_STAGE(PG8_SA(0, 0), cA + PG8_KO(0), voffA); PG8_STAGE(PG8_SA(0, 1), cA + hstep + PG8_KO(0), voffA);
        if (wr == 1) PG8_BAR;
        PG8_WAIT_V(2); PG8_BAR;
        PG8_STAGE(PG8_SB(1, 0), cB + PG8_KO(1), voffB); PG8_STAGE(PG8_SA(1, 0), cA + PG8_KO(1), voffA); PG8_STAGE(PG8_SB(1, 1), cB + hstep + PG8_KO(1), voffB);
        PG8_WAIT_V(6); PG8_BAR;
    } else {
        PG8_STAGE(PG8_SB(0, 0), cB + PG8_KO(0), voffB); PG8_STAGE(PG8_SA(0, 0), cA + PG8_KO(0), voffA); PG8_STAGE(PG8_SB(0, 1), cB + hstep + PG8_KO(0), voffB); PG8_STAGE(PG8_SA(0, 1), cA + hstep + PG8_KO(0), voffA);
        if (wr == 1) PG8_BAR;
        PG8_WAIT_V(4); PG8_BAR;
        PG8_STAGE(PG8_SB(1, 0), cB + PG8_KO(1), voffB); PG8_STAGE(PG8_SA(1, 0), cA + PG8_KO(1), voffA); PG8_STAGE(PG8_SB(1, 1), cB + hstep + PG8_KO(1), voffB);
        PG8_WAIT_V(6); PG8_BAR;
    }
    for (;;) {
        const bool has_next = S.next(ui + 1, nxt);
        const char* nA = has_next ? S.a_base(g, nxt) : cA; const char* nB = has_next ? S.b_base(g, nxt) : cB;
        for (int t = 0; t < nt; t += 2) {
            const bool last = (t == nt - 2);
            const char* a1 = cA + PG8_KO(t + 1);
            const char* a2 = last ? nA + PG8_KO(0) : cA + PG8_KO(t + 2); const char* b2 = last ? nB + PG8_KO(0) : cB + PG8_KO(t + 2);
            const char* a3 = a2 + kstep; const char* b3 = b2 + kstep;
            if constexpr (Epi::MIDK > 0) { if (t == Epi::MIDK) { int lm = lane; asm volatile("" : "+v"(lm)); E.mid(acc, cur, wr, wc, lm & 15, lm >> 4); } }
            if (last && has_next) S.a_ready(nxt);
            if constexpr (SP2) {
            PG8_LDB(B0, 0, 0); PG8_LDB(B1, 0, 1); PG8_SCHED; PG8_LDA(At, 0, 0); PG8_STAGE(PG8_SA(1, 1), a1 + hstep, voffA);
            PG8_WAIT_V(8); PG8_WAIT_L(0); PG8_BAR; PG8_MMA(0, 0, At, B0); PG8_MMA(0, 1, At, B1); PG8_BAR; PG8_SCHED;
            PG8_LDA(At, 0, 1); PG8_STAGE(PG8_SB(0, 0), b2, voffB); PG8_STAGE(PG8_SB(0, 1), b2 + hstep, voffB); PG8_STAGE(PG8_SA(0, 0), a2, voffA);
            PG8_WAIT_V(8); PG8_WAIT_L(0); PG8_BAR; PG8_MMA(1, 0, At, B0); PG8_MMA(1, 1, At, B1); PG8_BAR; PG8_SCHED;
            PG8_LDB(B0, 1, 0); PG8_LDB(B1, 1, 1); PG8_SCHED; PG8_LDA(At, 1, 0); PG8_STAGE(PG8_SA(0, 1), a2 + hstep, voffA);
            PG8_WAIT_V(8); PG8_WAIT_L(0); PG8_BAR; PG8_MMA(0, 0, At, B0); PG8_MMA(0, 1, At, B1); PG8_BAR; PG8_SCHED;
            PG8_LDA(At, 1, 1); PG8_STAGE(PG8_SB(1, 0), b3, voffB); PG8_STAGE(PG8_SB(1, 1), b3 + hstep, voffB); PG8_STAGE(PG8_SA(1, 0), a3, voffA);
            PG8_WAIT_V(8); PG8_WAIT_L(0); PG8_BAR; PG8_MMA(1, 0, At, B0); PG8_MMA(1, 1, At, B1); PG8_BAR; PG8_SCHED;
            } else {
            PG8_LDB(B0, 0, 0); PG8_SCHED; PG8_LDA(At, 0, 0); PG8_STAGE(PG8_SA(1, 1), a1 + hstep, voffA);
            PG8_WAIT_L(8); PG8_BAR; PG8_WAIT_L(0); PG8_MMA(0, 0, At, B0); PG8_BAR; PG8_SCHED;
            PG8_LDB(B1, 0, 1); PG8_STAGE(PG8_SB(0, 0), b2, voffB);
            PG8_BAR; PG8_WAIT_L(0); PG8_MMA(0, 1, At, B1); PG8_BAR;
            PG8_LDA(At, 0, 1); PG8_STAGE(PG8_SA(0, 0), a2, voffA);
            PG8_BAR; PG8_WAIT_L(0); PG8_MMA(1, 0, At, B0); PG8_BAR; PG8_SCHED;
            PG8_STAGE(PG8_SB(0, 1), b2 + hstep, voffB);
            PG8_WAIT_V(6); PG8_BAR; PG8_MMA(1, 1, At, B1); PG8_BAR;
            PG8_LDB(B0, 1, 0); PG8_SCHED; PG8_LDA(At, 1, 0); PG8_STAGE(PG8_SA(0, 1), a2 + hstep, voffA);
            PG8_WAIT_L(8); PG8_BAR; PG8_WAIT_L(0); PG8_MMA(0, 0, At, B0); PG8_BAR; PG8_SCHED;
            PG8_LDB(B1, 1, 1); PG8_STAGE(PG8_SB(1, 0), b3, voffB);
            PG8_BAR; PG8_WAIT_L(0); PG8_MMA(0, 1, At, B1); PG8_BAR;
            PG8_LDA(At, 1, 1); PG8_STAGE(PG8_SA(1, 0), a3, voffA);
            PG8_BAR; PG8_WAIT_L(0); PG8_MMA(1, 0, At, B0); PG8_BAR; PG8_SCHED;
            PG8_STAGE(PG8_SB(1, 1), b3 + hstep, voffB);
            PG8_WAIT_V(6); PG8_BAR; PG8_MMA(1, 1, At, B1); PG8_BAR;
            }
        }
        if constexpr (FP8) { asm volatile("s_nop 15\n\ts_nop 15" ::: "memory"); }
        if constexpr (ALIGN_EPI) { if (wr == 0) PG8_BAR; }
        if constexpr (!Epi::AFTER_DRAIN) { int lz = lane; asm volatile("" : "+v"(lz));
            E(acc, cur, wr, wc, lz & 15, lz >> 4); S.done(cur); }
        if (!has_next) break;
#pragma unroll
        for (int a = 0; a < 2; ++a)
#pragma unroll
            for (int b = 0; b < 2; ++b)
#pragma unroll
                for (int m = 0; m < 4; ++m)
#pragma unroll
                    for (int n = 0; n < 2; ++n) acc[a][b][m][n] = (f32x4){0.f, 0.f, 0.f, 0.f};
        cur = nxt; cA = nA; cB = nB; ++ui;
        if constexpr (ALIGN_EPI) { if (wr == 1) PG8_BAR; }
    }
    PG8_WAIT_V(0);
    if constexpr (!ALIGN_EPI) { if (wr == 0) PG8_BAR; }
    PG8_BAR;
    if constexpr (Epi::AFTER_DRAIN) { E.fused(acc, cur, wr, wc, fr, fq, lds, wid, lane); S.done(cur); }
#undef PG8_KO
#undef PG8_SA
#undef PG8_SB
#undef PG8_STAGE
#undef PG8_LDA
#undef PG8_LDB
#undef PG8_MMA
#undef PG8_WAIT_V
#undef PG8_WAIT_L
#undef PG8_BAR
#undef PG8_SCHED
}
}

#define PROBE_MASK 0x0
constexpr int NWAVES = 8, NTHR = 512;
constexpr int BATCH = 2, SEQ = 8192, T = BATCH * SEQ, D = 2048;
constexpr int CHUNK = 64, NCH = SEQ / CHUNK;
constexpr int MH = 4, MD = 256, MW = 1024;
constexpr int AH = 16, AD = 64, AW = 1024;
constexpr int NMEM = 256, XH = 4, XD = 128, XW = 512;
constexpr int NE = 32, TOPK = 4, DFF = 2048, MOEB = 256;
constexpr int IN_COLS = 11272, NPROJ = 11264;
constexpr int NROWS_MAX = (T * TOPK / MOEB + NE) * MOEB;
constexpr int NBLK_MAX = NROWS_MAX / MOEB;
constexpr float EPS = 1e-6f;
constexpr float HSCALE = 16.f;
constexpr float WSCALE = 1024.f, XSCALE = 16.f, ASCALE = 8.f, YSCALE = 16.f;
constexpr int PQ_M = 0, PK_M = 1024, PV_M = 2048, PO_M = 3072, PQ_A = 4096, PK_A = 5120, PV_A = 6144, PG_M = 7168, PG_A = 9216;

constexpr size_t MiB = 1u << 20;
constexpr size_t al(size_t x) { return (x + MiB - 1) / MiB * MiB; }
constexpr size_t WS_CTL = 0, CTL_ZERO_BYTES = 1 * MiB;
constexpr size_t WS_WIN = WS_CTL + CTL_ZERO_BYTES;
constexpr size_t WS_WIN8 = WS_WIN + al((size_t)3072 * D * 2);
constexpr size_t WS_H8 = WS_WIN8 + al((size_t)8192 * D);
constexpr size_t WS_WBM = WS_H8 + al((size_t)T * D);
constexpr size_t WS_WBA = WS_WBM + al((size_t)D * MW * 2);
constexpr size_t WS_WOUT = WS_WBA + al((size_t)D * AW * 2);
constexpr size_t WS_WQ = WS_WOUT + al((size_t)D * D * 2);
constexpr size_t WS_WKV = WS_WQ + al((size_t)XW * D * 2);
constexpr size_t WS_WO = WS_WKV + al((size_t)2 * XW * D * 2);
constexpr size_t WS_WR = WS_WO + al((size_t)D * XW * 2);
constexpr size_t WS_WGU = WS_WR + al((size_t)256 * D * 2);
constexpr size_t WS_WDN = WS_WGU + al((size_t)NE * 2 * DFF * D);
constexpr size_t WS_H = WS_WDN + al((size_t)NE * D * DFF);
constexpr size_t WS_PROJ = WS_H + al((size_t)T * D * 2);
constexpr size_t WS_IFG = WS_PROJ + al((size_t)T * NPROJ * 2);
constexpr size_t WS_QKC = WS_IFG + al((size_t)T * 8 * 4);
constexpr size_t WS_BCUM = WS_QKC + al((size_t)T * 2048 * 2);
constexpr size_t WS_CLOC = WS_BCUM + al((size_t)T * 4 * 4);
constexpr size_t WS_CIN = WS_CLOC + al((size_t)1024 * 65536 * 2);
constexpr size_t WS_NLOC = WS_CIN + al((size_t)1024 * 65536 * 2);
constexpr size_t WS_NIN = WS_NLOC + al((size_t)1024 * 256 * 4);
constexpr size_t WS_CHS = WS_NIN + al((size_t)1024 * 256 * 4);
constexpr size_t WS_HM = WS_CHS + MiB;
constexpr size_t WS_YA = WS_HM + al((size_t)T * MW * 2);
constexpr size_t WS_T1 = WS_YA + al((size_t)T * AW * 2);
constexpr size_t WS_MRG = WS_T1 + al((size_t)T * D * 2);
constexpr size_t WS_X1 = WS_MRG + al((size_t)T * D * 2);
constexpr size_t WS_XN1 = WS_X1 + al((size_t)T * D * 4);
constexpr size_t WS_SSQ1 = WS_XN1 + al((size_t)T * D * 2);
constexpr size_t WS_MEMN = WS_SSQ1 + al((size_t)T * 32 * 4);
constexpr size_t WS_KVX = WS_MEMN + al((size_t)512 * D * 2);
constexpr size_t WS_QX = WS_KVX + al((size_t)512 * 1024 * 2);
constexpr size_t WS_OX = WS_QX + al((size_t)T * XW * 2);
constexpr size_t WS_X2 = WS_OX + al((size_t)T * XW * 2);
constexpr size_t WS_XN3 = WS_X2 + al((size_t)T * D * 4);
constexpr size_t WS_LOG = WS_XN3 + al((size_t)T * D * 2);
constexpr size_t WS_TOPE = WS_LOG + al((size_t)T * 256 * 4);
constexpr size_t WS_GATE = WS_TOPE + al((size_t)T * 4 * 4);
constexpr size_t WS_RANK = WS_GATE + al((size_t)T * 4 * 4);
constexpr size_t WS_DEST = WS_RANK + al((size_t)T * 4 * 4);
constexpr size_t WS_RGATE = WS_DEST + al((size_t)T * 4 * 4);
constexpr size_t WS_RROW = WS_RGATE + al((size_t)NROWS_MAX * 4);
constexpr size_t WS_RSTD = WS_RROW + al((size_t)NROWS_MAX * 4);
constexpr size_t WS_XQ = WS_RSTD + al((size_t)T * 4);
constexpr size_t WS_XPERM = WS_XQ + al((size_t)T * D);
constexpr size_t WS_ACT = WS_XPERM + al((size_t)NROWS_MAX * D);
constexpr size_t WS_YR = WS_ACT + al((size_t)NROWS_MAX * DFF);
constexpr size_t WS_END = WS_YR + al((size_t)NROWS_MAX * D * 2);
constexpr int CW_BAR = 4096;
constexpr int CW_HIST = 16384;
constexpr int CW_BLKE = 32768;
constexpr int CW_NBLK = 33792;

constexpr int RING_OFF = 0, RING_BYTES = 131072;
constexpr int LDSCTL_OFF = RING_BYTES, MISC_OFF = LDSCTL_OFF + 320;
constexpr int LDS_BYTES = 147456;

#define GAS __attribute__((address_space(1)))
#define LAS __attribute__((address_space(3)))
typedef unsigned short bf16;
typedef unsigned v4u __attribute__((ext_vector_type(4)));
typedef unsigned v2u __attribute__((ext_vector_type(2)));
typedef float f32x4 __attribute__((ext_vector_type(4)));
typedef float f32x16 __attribute__((ext_vector_type(16)));
typedef float f32x2 __attribute__((ext_vector_type(2)));
typedef short bf16x8 __attribute__((ext_vector_type(8)));
typedef short bf16x4 __attribute__((ext_vector_type(4)));
typedef GAS unsigned gu32;
#define RLX_AGENT __ATOMIC_RELAXED, __HIP_MEMORY_SCOPE_AGENT
#define LDS_WAIT() asm volatile("s_waitcnt lgkmcnt(0)" ::: "memory")
#define VM_WAIT() asm volatile("s_waitcnt vmcnt(0)" ::: "memory")
__device__ __forceinline__ unsigned pk2(float lo, float hi) { return pg8::cvt_pk_bf16_c(lo, hi); }
__device__ __forceinline__ float bflo(unsigned w) { return __builtin_bit_cast(float, w << 16); }
__device__ __forceinline__ float bfhi(unsigned w) { return __builtin_bit_cast(float, w & 0xffff0000u); }
__device__ __forceinline__ float bf1(bf16 h) { return __builtin_bit_cast(float, ((unsigned)h) << 16); }
__device__ __forceinline__ bf16 f2bf(float f) { return (bf16)(pk2(f, 0.f) & 0xffffu); }
__device__ __forceinline__ float sigm(float x) { return __builtin_amdgcn_rcpf(1.f + __expf(-x)); }
__device__ __forceinline__ f32x16 mfma32(bf16x8 a, bf16x8 b, f32x16 c) { return __builtin_amdgcn_mfma_f32_32x32x16_bf16(a, b, c, 0, 0, 0); }
__device__ __forceinline__ void lds_addf(LAS float* p, float v) { (void)__hip_atomic_fetch_add(p, v, __ATOMIC_RELAXED, __HIP_MEMORY_SCOPE_WORKGROUP); }
__device__ __forceinline__ int lds_addi(LAS int* p, int v) { return __hip_atomic_fetch_add(p, v, __ATOMIC_RELAXED, __HIP_MEMORY_SCOPE_WORKGROUP); }
__device__ __forceinline__ float wave_sum(float v) {
#pragma unroll
    for (int o = 1; o < 64; o <<= 1) v += __shfl_xor(v, o);
    return v;
}
__device__ __forceinline__ float wave_max(float v) {
#pragma unroll
    for (int o = 1; o < 64; o <<= 1) v = fmaxf(v, __shfl_xor(v, o));
    return v;
}

#define XB_TMO      128
#define XB_XCNT(j)  (256  + 64 * (j))
#define XB_XSUB(j)  (1280 + 64 * (j))
#define XB_XGEN(j)  (2304 + 64 * (j))
#define XB_TOP      3328
#define XB_TOPGEN   3392
#define XCD_BAR_WORDS 3456
#define XB_SPIN_CAP (1u << 18)
__device__ __forceinline__ unsigned xb_ld(unsigned* p)              { return __hip_atomic_load(p, __ATOMIC_RELAXED, __HIP_MEMORY_SCOPE_AGENT); }
__device__ __forceinline__ unsigned xb_add(unsigned* p, unsigned v) { return __hip_atomic_fetch_add(p, v, __ATOMIC_RELAXED, __HIP_MEMORY_SCOPE_AGENT); }
__device__ __forceinline__ unsigned xb_xcc_id() { return (unsigned)__builtin_amdgcn_s_getreg((3 << 11) | 20) & 0xFu; }
#define XB_SPIN(cond, bar) do { unsigned _sp = 0; while (cond) { __builtin_amdgcn_s_sleep(1); \
    if ((++_sp & 255u) == 0u) { if (xb_ld(&(bar)[XB_TMO])) break; if (_sp > XB_SPIN_CAP) { atomicAdd(&(bar)[XB_TMO], 1u); break; } } } } while (0)
struct XcdBarrier { unsigned* bar; unsigned x; volatile LAS unsigned* st; };
__device__ __forceinline__ XcdBarrier xcd_barrier_post(unsigned* bar, volatile LAS unsigned* st, int tid0) {
    XcdBarrier b; b.bar = bar; b.x = xb_xcc_id(); b.st = st;
    if (tid0 == 0) (void)xb_add(&bar[XB_XCNT(b.x)], 1u);
    return b;
}
__device__ __forceinline__ void xcd_barrier_complete(unsigned* bar, unsigned x, unsigned& nloc, unsigned& nx) {
    const unsigned G = gridDim.x * gridDim.y * gridDim.z;
    unsigned sum, cnt, mine, sp = 0u;
    for (;;) {
        sum = 0u; cnt = 0u; mine = 0u;
#pragma unroll
        for (unsigned j = 0; j < 16; ++j) { const unsigned c = xb_ld(&bar[XB_XCNT(j)]); sum += c; cnt += (c > 0u) ? 1u : 0u; mine = (j == x) ? c : mine; }
        if (sum == G) break;
        __builtin_amdgcn_s_sleep(1);
        if ((++sp & 255u) == 0u) { if (xb_ld(&bar[XB_TMO])) break; if (sp > XB_SPIN_CAP) { atomicAdd(&bar[XB_TMO], 1u); break; } }
    }
    nloc = mine > 0u ? mine : 1u; nx = cnt > 0u ? cnt : 1u;
}
__device__ __forceinline__ void xcd_barrier(const XcdBarrier& b, int tid0) {
    asm volatile("s_waitcnt vmcnt(0)" ::: "memory");
    __syncthreads();
    if (tid0 == 0) {
        unsigned* bar = b.bar;
        __builtin_amdgcn_s_waitcnt(0);
        unsigned nloc = b.st[0], nx = b.st[1];
        if (nloc == 0u) { xcd_barrier_complete(bar, b.x, nloc, nx); b.st[0] = nloc; b.st[1] = nx; }
        const unsigned old = xb_add(&bar[XB_XSUB(b.x)], 1u);
        const unsigned gen = old / nloc;
        if (old + 1u == (gen + 1u) * nloc) {
            __builtin_amdgcn_fence(__ATOMIC_RELEASE, "agent");
            asm volatile("s_waitcnt vmcnt(0)" ::: "memory");
            const unsigned og = xb_add(&bar[XB_TOP], 1u);
            const unsigned tg = og / nx;
            if (og + 1u == (tg + 1u) * nx) xb_add(&bar[XB_TOPGEN], 1u);
            else XB_SPIN(xb_ld(&bar[XB_TOPGEN]) == tg, bar);
            __builtin_amdgcn_fence(__ATOMIC_ACQUIRE, "agent");
            xb_add(&bar[XB_XGEN(b.x)], 1u);
            asm volatile("s_waitcnt vmcnt(0)" ::: "memory");
        } else {
            XB_SPIN(xb_ld(&bar[XB_XGEN(b.x)]) == gen, bar);
            __builtin_amdgcn_fence(__ATOMIC_ACQUIRE, "agent");
            asm volatile("s_waitcnt vmcnt(0)" ::: "memory");
        }
    }
    __syncthreads();
}

struct Frame {
    LAS unsigned char* lds;
    int tid, lane, wave, G, vcu;
    unsigned char* ws;
    const float* in[25];
    float* out;
};
enum { I_X = 0, I_MEM, I_NMIXW, I_WIN, I_CONVW, I_CONVB, I_IFB, I_MHNW, I_WBM, I_WBA, I_REL, I_WOUT, I_NXW, I_NMEMW, I_WQ, I_WKV, I_WO, I_NFFNW,
       I_WR, I_BR, I_WGU, I_BGU, I_WDN, I_BDN, I_FNW };

__device__ __forceinline__ int fresh_lane() { int l = (int)__builtin_amdgcn_mbcnt_hi(~0u, __builtin_amdgcn_mbcnt_lo(~0u, 0u)); asm volatile("" : "+v"(l)); return l; }
__device__ __forceinline__ void frame_ids(Frame& F) {
    const int l = fresh_lane(); F.lane = l; F.tid = F.wave * 64 + l;
}

__device__ __forceinline__ void transpose_item(const float* W, int ldw, int src_col0, int k0, bf16* WT, int K, int dest_row0, LAS float* scr, int lane) {
    float rv[32];
#pragma unroll
    for (int i = 0; i < 32; ++i) { const int kk = 2 * i + (lane >> 5); rv[i] = W[(size_t)(k0 + kk) * ldw + src_col0 + (lane & 31)]; }
#pragma unroll
    for (int i = 0; i < 32; ++i) { const int kk = 2 * i + (lane >> 5); scr[kk * 33 + (lane & 31)] = rv[i]; }
    LDS_WAIT(); asm volatile("" ::: "memory");
    const int c = lane & 7;
#pragma unroll
    for (int j = 0; j < 4; ++j) { const int n = (lane >> 3) + 8 * j; const LAS float* s = scr + (8 * c) * 33 + n;
        v4u o; o.x = pk2(s[0 * 33], s[1 * 33]); o.y = pk2(s[2 * 33], s[3 * 33]); o.z = pk2(s[4 * 33], s[5 * 33]); o.w = pk2(s[6 * 33], s[7 * 33]);
        *(GAS v4u*)(WT + (size_t)(dest_row0 + n) * K + k0 + 8 * c) = o; }
    LDS_WAIT(); asm volatile("" ::: "memory");
}
struct Fp8Job { const float* src; unsigned char* dst; int ldw, K; };
__device__ __forceinline__ Fp8Job fp8_job(const Frame& F, int r) {
    constexpr int I_GU1 = 32 * 128, I_DN1 = 32 * 64;
    Fp8Job j;
    if (r < NE * I_GU1) { const int e = r / I_GU1, q = r % I_GU1, kb = q / 128, sb = q % 128;
        const int sc0 = 32 * sb, bj = sc0 / DFF, cc = sc0 % DFF, dest = (cc / 128) * 256 + bj * 128 + (cc % 128);
        j.src = F.in[I_WGU] + (size_t)e * D * (2 * DFF) + (size_t)(64 * kb) * (2 * DFF) + sc0; j.ldw = 2 * DFF;
        j.dst = (unsigned char*)(F.ws + WS_WGU) + (size_t)e * (2 * DFF) * D + (size_t)dest * D + 64 * kb; j.K = D; }
    else { r -= NE * I_GU1; const int e = r / I_DN1, q = r % I_DN1, kb = q / 64, nb = q % 64;
        j.src = F.in[I_WDN] + (size_t)e * DFF * D + (size_t)(64 * kb) * D + 32 * nb; j.ldw = D;
        j.dst = (unsigned char*)(F.ws + WS_WDN) + (size_t)e * D * DFF + (size_t)(32 * nb) * DFF + 64 * kb; j.K = DFF; }
    return j;
}
__device__ __forceinline__ void fp8_item_load(const Fp8Job& j, f32x4 (&rv)[8], int lane) {
    const float* p = j.src + (size_t)(lane >> 3) * j.ldw + 4 * (lane & 7);
#pragma unroll
    for (int i = 0; i < 8; ++i) rv[i] = *(const GAS f32x4*)(p + (size_t)(8 * i) * j.ldw);
}
__device__ __forceinline__ void fp8_item_store(const Fp8Job& j, const f32x4 (&rv)[8], LAS float* scr, int lane) {
#pragma unroll
    for (int i = 0; i < 8; ++i) { LAS float* d = scr + (8 * i + (lane >> 3)) * 33 + 4 * (lane & 7); d[0] = rv[i].x; d[1] = rv[i].y; d[2] = rv[i].z; d[3] = rv[i].w; }
    LDS_WAIT(); asm volatile("" ::: "memory");
    const int c = lane >> 4;
#pragma unroll
    for (int jn = 0; jn < 2; ++jn) { const int n = (lane & 15) + 16 * jn; const LAS float* s = scr + (16 * c) * 33 + n;
        v4u o; o.x = pg8::pk_fp8x4(s[0 * 33] * WSCALE, s[1 * 33] * WSCALE, s[2 * 33] * WSCALE, s[3 * 33] * WSCALE); o.y = pg8::pk_fp8x4(s[4 * 33] * WSCALE, s[5 * 33] * WSCALE, s[6 * 33] * WSCALE, s[7 * 33] * WSCALE);
        o.z = pg8::pk_fp8x4(s[8 * 33] * WSCALE, s[9 * 33] * WSCALE, s[10 * 33] * WSCALE, s[11 * 33] * WSCALE); o.w = pg8::pk_fp8x4(s[12 * 33] * WSCALE, s[13 * 33] * WSCALE, s[14 * 33] * WSCALE, s[15 * 33] * WSCALE);
        *(GAS v4u*)(j.dst + (size_t)n * j.K + 16 * c) = o; }
    LDS_WAIT(); asm volatile("" ::: "memory");
}
__device__ __forceinline__ void tr_dense(const float* W, int K, int N, bf16* WT, LAS float* scr, int item, int lane) {
    const int nblk = N / 32, kb = item / nblk, nb = item % nblk;
    transpose_item(W, N, 32 * nb, 64 * kb, WT, K, 32 * nb, scr, lane);
}
__device__ __forceinline__ void rms_row_to_bf16(const float* xrow, const float* w, bf16* orow, int lane) {
    const GAS f32x4* xr = (const GAS f32x4*)xrow + lane;
    f32x4 v[8]; float s = 0.f;
#pragma unroll
    for (int j = 0; j < 8; ++j) { v[j] = xr[64 * j]; s += (v[j].x * v[j].x + v[j].y * v[j].y) + (v[j].z * v[j].z + v[j].w * v[j].w); }
    const float rstd = 1.f / sqrtf(wave_sum(s) * (1.f / D) + EPS);
    const GAS f32x4* wr = (const GAS f32x4*)w + lane;
    GAS v2u* o8 = (GAS v2u*)orow + lane;
#pragma unroll
    for (int j = 0; j < 8; ++j) { const f32x4 ww = wr[64 * j]; v2u o; o.x = pk2(v[j].x * rstd * ww.x, v[j].y * rstd * ww.y); o.y = pk2(v[j].z * rstd * ww.z, v[j].w * rstd * ww.w); o8[64 * j] = o; }
}

struct TJob { const float* src; unsigned char* dst; const float* kscale; int ldw, Kd, rowmap, fp8; };
constexpr int T_IN = 16 * 44, T_BM = 8 * 8, T_BA = 8 * 8, T_OUT = 16 * 8, T_Q = 16 * 2, T_KV = 16 * 4, T_O = 4 * 8, T_GU = 16 * 16, T_DN = 16 * 8;
constexpr int NT_SMALL = T_IN + T_BM + T_BA + T_OUT + T_Q + T_KV + T_O, NTILES = NT_SMALL + NE * (T_GU + T_DN);
constexpr int LATE_WG = 120, NT_LATE = LATE_WG * 8;
__device__ __forceinline__ TJob tile_job(const Frame& F, int r) {
    TJob j; j.rowmap = 0; j.fp8 = 0; j.kscale = nullptr;
#define TJ_DENSE(W_, Kk, Nn, DST_) { const int nbn = (Nn) / 256, kb = r / nbn, nb = r % nbn; j.src = (W_) + (size_t)(128 * kb) * (Nn) + 256 * nb; j.ldw = (Nn); \
        j.dst = (unsigned char*)(F.ws + (DST_)) + ((size_t)(256 * nb) * (Kk) + 128 * kb) * 2; j.Kd = (Kk); return j; }
    if (r < T_IN) { const int kb = r / 44, nb = r % 44, n0 = 256 * nb; j.src = F.in[I_WIN] + (size_t)(128 * kb) * IN_COLS + n0 + (n0 >= 4096 ? 8 : 0); j.ldw = IN_COLS; j.Kd = D;
        if (nb >= 12) { const int t8 = nb - 12; j.fp8 = 1; j.dst = (unsigned char*)(F.ws + WS_WIN8) + (size_t)(256 * t8) * D + 128 * kb; }
        else j.dst = (unsigned char*)(F.ws + WS_WIN) + ((size_t)n0 * D + 128 * kb) * 2;
        return j; } r -= T_IN;
    if (r < T_BM) { const int kb = r / 8, nb = r % 8; j.src = F.in[I_WBM] + (size_t)(128 * kb) * D + 256 * nb; j.ldw = D; j.dst = (unsigned char*)(F.ws + WS_WBM) + ((size_t)(256 * nb) * 2048 + 128 * kb) * 2; j.Kd = 2048; return j; } r -= T_BM;
    if (r < T_BA) { const int kb = r / 8, nb = r % 8; j.src = F.in[I_WBA] + (size_t)(128 * kb) * D + 256 * nb; j.ldw = D; j.dst = (unsigned char*)(F.ws + WS_WBM) + ((size_t)(256 * nb) * 2048 + 1024 + 128 * kb) * 2; j.Kd = 2048; return j; } r -= T_BA;
    if (r < T_OUT) TJ_DENSE(F.in[I_WOUT], D, D, WS_WOUT) r -= T_OUT;
    if (r < T_Q) { const int kb = r / 2, nb = r % 2; j.src = F.in[I_WQ] + (size_t)(128 * kb) * XW + 256 * nb; j.ldw = XW; j.dst = (unsigned char*)(F.ws + WS_WQ) + ((size_t)(256 * nb) * D + 128 * kb) * 2; j.Kd = D; j.kscale = F.in[I_NXW] + 128 * kb; return j; } r -= T_Q;
    if (r < T_KV) TJ_DENSE(F.in[I_WKV], D, 2 * XW, WS_WKV) r -= T_KV;
    if (r < T_O) TJ_DENSE(F.in[I_WO], XW, D, WS_WO) r -= T_O;
#undef TJ_DENSE
    j.fp8 = 1;
    if (r < NE * T_GU) { const int e = r / T_GU, q = r % T_GU, kb = q / 16, nb = q % 16; j.src = F.in[I_WGU] + (size_t)e * D * (2 * DFF) + (size_t)(128 * kb) * (2 * DFF) + 256 * nb; j.ldw = 2 * DFF;
        j.dst = (unsigned char*)(F.ws + WS_WGU) + (size_t)e * (2 * DFF) * D + 128 * kb; j.Kd = D; j.rowmap = 1 + 256 * nb; return j; }
    r -= NE * T_GU;
    { const int e = r / T_DN, q = r % T_DN, kb = q / 8, nb = q % 8; j.src = F.in[I_WDN] + (size_t)e * DFF * D + (size_t)(128 * kb) * D + 256 * nb; j.ldw = D;
        j.dst = (unsigned char*)(F.ws + WS_WDN) + (size_t)e * D * DFF + (size_t)(256 * nb) * DFF + 128 * kb; j.Kd = DFF; return j; }
}
__device__ __forceinline__ void tile_load(const TJob& j, f32x4 (&rv)[16], int tid) {
    const float* p = j.src + (size_t)(tid >> 6) * j.ldw + 4 * (tid & 63);
#pragma unroll
    for (int i = 0; i < 16; ++i) rv[i] = __builtin_nontemporal_load((const GAS f32x4*)(p + (size_t)(8 * i) * j.ldw));
}

__device__ __forceinline__ void weight_tiles(Frame& F, int t0, int t1, int wi, int nw, const bool rev = false) {
#define WT_IDX(x) (rev ? (t0 + t1 - 1 - (x)) : (x))
        LAS float* tile = (LAS float*)(F.lds + RING_OFF);
        f32x4 rv[16], rn[16];
        int tt = t0 + wi;
        if (tt < t1) { const TJob j = tile_job(F, WT_IDX(tt)); tile_load(j, rv, F.tid); }
        for (; tt < t1; tt += nw) {
#pragma unroll
            for (int i = 0; i < 16; ++i) { const int k = (F.tid >> 6) + 8 * i, n4 = 4 * (F.tid & 63); *(LAS f32x4*)(tile + k * 256 + (n4 ^ (((k >> 4) & 7) << 2))) = rv[i]; }
            { const TJob jc = tile_job(F, WT_IDX(tt));
              if (jc.kscale) {
                  __syncthreads();
#pragma unroll
                  for (int i = 0; i < 16; ++i) { const int k = (F.tid >> 6) + 8 * i, n4 = 4 * (F.tid & 63); LAS f32x4* p = (LAS f32x4*)(tile + k * 256 + (n4 ^ (((k >> 4) & 7) << 2))); *p = *p * jc.kscale[k]; } } }
            __syncthreads();
            const bool more = tt + nw < t1;
            if (more) { const TJob jn = tile_job(F, WT_IDX(tt + nw)); tile_load(jn, rn, F.tid); }
            const TJob j = tile_job(F, WT_IDX(tt));
#pragma unroll
            for (int i = 0; i < 4; ++i) { const int p = F.tid + NTHR * i, c = p & 7, n = p >> 3;
                const LAS float* s = tile + (16 * c) * 256 + (n ^ (c << 2));
                size_t drow;
                if (j.rowmap) { const int sc = (j.rowmap - 1) + n, bj = sc / DFF, cc = sc % DFF; drow = (size_t)((cc / 128) * 256 + bj * 128 + (cc % 128)); } else drow = (size_t)n;
                if (j.fp8) {
                    v4u o; o.x = pg8::pk_fp8x4(s[0 * 256] * WSCALE, s[1 * 256] * WSCALE, s[2 * 256] * WSCALE, s[3 * 256] * WSCALE); o.y = pg8::pk_fp8x4(s[4 * 256] * WSCALE, s[5 * 256] * WSCALE, s[6 * 256] * WSCALE, s[7 * 256] * WSCALE);
                    o.z = pg8::pk_fp8x4(s[8 * 256] * WSCALE, s[9 * 256] * WSCALE, s[10 * 256] * WSCALE, s[11 * 256] * WSCALE); o.w = pg8::pk_fp8x4(s[12 * 256] * WSCALE, s[13 * 256] * WSCALE, s[14 * 256] * WSCALE, s[15 * 256] * WSCALE);
                    *(GAS v4u*)(j.dst + drow * j.Kd + 16 * c) = o;
                } else {
                    v4u o0, o1; o0.x = pk2(s[0 * 256], s[1 * 256]); o0.y = pk2(s[2 * 256], s[3 * 256]); o0.z = pk2(s[4 * 256], s[5 * 256]); o0.w = pk2(s[6 * 256], s[7 * 256]);
                    o1.x = pk2(s[8 * 256], s[9 * 256]); o1.y = pk2(s[10 * 256], s[11 * 256]); o1.z = pk2(s[12 * 256], s[13 * 256]); o1.w = pk2(s[14 * 256], s[15 * 256]);
                    GAS v4u* o = (GAS v4u*)(j.dst + (drow * j.Kd + 16 * c) * 2); o[0] = o0; o[1] = o1;
                } }
            __syncthreads();
            if (more) {
#pragma unroll
                for (int i = 0; i < 16; ++i) rv[i] = rn[i]; }
        }
#undef WT_IDX
}

__device__ __forceinline__ void p0_prologue(Frame& F) {
    frame_ids(F);
    const int gw = F.vcu * NWAVES + F.wave, NGW = F.G * NWAVES;
    bf16* WIN = (bf16*)(F.ws + WS_WIN);
    {
        LAS float* scr = (LAS float*)(F.lds + RING_OFF + F.wave * 16384);
        for (int it = gw; it < 32; it += NGW) tr_dense(F.in[I_WR], D, NE, (bf16*)(F.ws + WS_WR), scr, it, F.lane);
        __syncthreads();
        weight_tiles(F, 0, NTILES - NT_LATE, F.vcu, F.G, true);
    }
    __syncthreads();
    {
        LAS float* wg = (LAS float*)(F.lds + RING_OFF);
        for (int i = F.tid; i < 8 * D; i += NTHR) { const int k = i >> 3, g = i & 7; wg[g * D + k] = F.in[I_WIN][(size_t)k * IN_COLS + 4096 + g]; }
        __syncthreads();
        bf16* H = (bf16*)(F.ws + WS_H); float* IFG = (float*)(F.ws + WS_IFG);
        const float* nw = F.in[I_NMIXW];
        for (int m = gw; m < T; m += NGW) {
            const GAS f32x4* xr = (const GAS f32x4*)(F.in[I_X] + (size_t)m * D) + F.lane;
            f32x4 v[8]; float s = 0.f;
#pragma unroll
            for (int j = 0; j < 8; ++j) { v[j] = __builtin_nontemporal_load(xr + 64 * j); s += (v[j].x * v[j].x + v[j].y * v[j].y) + (v[j].z * v[j].z + v[j].w * v[j].w); }
            const float rstd = 1.f / sqrtf(wave_sum(s) * (1.f / D) + EPS);
            const GAS f32x4* wr = (const GAS f32x4*)nw + F.lane;
            GAS v2u* o8 = (GAS v2u*)(H + (size_t)m * D) + F.lane; GAS unsigned* h8 = (GAS unsigned*)((unsigned char*)(F.ws + WS_H8) + (size_t)m * D) + F.lane;
#pragma unroll
            for (int j = 0; j < 8; ++j) { const f32x4 ww = wr[64 * j]; v[j].x *= rstd * ww.x; v[j].y *= rstd * ww.y; v[j].z *= rstd * ww.z; v[j].w *= rstd * ww.w;
                v2u o; o.x = pk2(v[j].x, v[j].y); o.y = pk2(v[j].z, v[j].w); o8[64 * j] = o;
                h8[64 * j] = pg8::pk_fp8x4(v[j].x * HSCALE, v[j].y * HSCALE, v[j].z * HSCALE, v[j].w * HSCALE); }
            float ga8[8];
#pragma unroll
            for (int g = 0; g < 8; ++g) ga8[g] = 0.f;
#pragma unroll 2
            for (int j = 0; j < 8; ++j)
#pragma unroll
                for (int g = 0; g < 8; ++g) { const f32x4 ww = *(const LAS f32x4*)(wg + g * D + 256 * j + 4 * F.lane); ga8[g] += (v[j].x * ww.x + v[j].y * ww.y) + (v[j].z * ww.z + v[j].w * ww.w); }
            { const bool h5 = (F.lane & 32) != 0, h4 = (F.lane & 16) != 0, h3 = (F.lane & 8) != 0; float b4[4], c2[2], d1;
#pragma unroll
              for (int i = 0; i < 4; ++i) { const float snd = h5 ? ga8[i] : ga8[i + 4], kp = h5 ? ga8[i + 4] : ga8[i]; b4[i] = kp + __shfl_xor(snd, 32); }
#pragma unroll
              for (int i = 0; i < 2; ++i) { const float snd = h4 ? b4[i] : b4[i + 2], kp = h4 ? b4[i + 2] : b4[i]; c2[i] = kp + __shfl_xor(snd, 16); }
              { const float snd = h3 ? c2[0] : c2[1], kp = h3 ? c2[1] : c2[0]; d1 = kp + __shfl_xor(snd, 8); }
              d1 += __shfl_xor(d1, 4); d1 += __shfl_xor(d1, 2); d1 += __shfl_xor(d1, 1);
              if ((F.lane & 7) == 0) { const int g = F.lane >> 3; IFG[(size_t)m * 8 + g] = d1 + F.in[I_IFB][g]; } }
        }
        bf16* MEMN = (bf16*)(F.ws + WS_MEMN);
        for (int m = gw; m < BATCH * NMEM; m += NGW) rms_row_to_bf16(F.in[I_MEM] + (size_t)m * D, F.in[I_NMEMW], MEMN + (size_t)m * D, F.lane);
        __syncthreads();
    }

}

__device__ __forceinline__ void p_conv(Frame& F) {
    frame_ids(F);
    const bf16* PROJ = (const bf16*)(F.ws + WS_PROJ); bf16* QKC = (bf16*)(F.ws + WS_QKC);
    const float* cw = F.in[I_CONVW]; const float* cb = F.in[I_CONVB];
    const int gt = F.vcu * NTHR + F.tid, NGT = F.G * NTHR;
    for (int q = gt; q < 256 * (T / 32); q += NGT) {
        const int c0 = (q & 255) * 8, t0 = (q >> 8) * 32, s0 = t0 & (SEQ - 1);
        float wgt[4][8], bias[8];
#pragma unroll
        for (int j = 0; j < 4; ++j) { const f32x4 w0 = *(const GAS f32x4*)(cw + j * 2048 + c0), w1 = *(const GAS f32x4*)(cw + j * 2048 + c0 + 4);
            wgt[j][0] = w0.x; wgt[j][1] = w0.y; wgt[j][2] = w0.z; wgt[j][3] = w0.w; wgt[j][4] = w1.x; wgt[j][5] = w1.y; wgt[j][6] = w1.z; wgt[j][7] = w1.w; }
        { const f32x4 b0 = *(const GAS f32x4*)(cb + c0), b1 = *(const GAS f32x4*)(cb + c0 + 4); bias[0] = b0.x; bias[1] = b0.y; bias[2] = b0.z; bias[3] = b0.w; bias[4] = b1.x; bias[5] = b1.y; bias[6] = b1.z; bias[7] = b1.w; }
        const float sc = (c0 >= 1024) ? 0.0625f : 1.f;
        const bf16* src = PROJ + (size_t)t0 * NPROJ + c0;
        v4u h0 = (v4u){0u, 0u, 0u, 0u}, h1 = h0, h2 = h0;
        if (s0 > 0) { h0 = *(const GAS v4u*)(src - 3 * (size_t)NPROJ); h1 = *(const GAS v4u*)(src - 2 * (size_t)NPROJ); h2 = *(const GAS v4u*)(src - (size_t)NPROJ); }
        for (int i0 = 0; i0 < 32; i0 += 8) {
            v4u rw[8];
#pragma unroll
            for (int i = 0; i < 8; ++i) rw[i] = *(const GAS v4u*)(src + (size_t)(i0 + i) * NPROJ);
#pragma unroll
            for (int i = 0; i < 8; ++i) { const v4u h3 = rw[i]; float a[8];
#pragma unroll
                for (int e = 0; e < 4; ++e) { const unsigned u0 = h0[e], u1 = h1[e], u2 = h2[e], u3 = h3[e];
                    a[2 * e] = bias[2 * e] + bflo(u0) * wgt[0][2 * e] + bflo(u1) * wgt[1][2 * e] + bflo(u2) * wgt[2][2 * e] + bflo(u3) * wgt[3][2 * e];
                    a[2 * e + 1] = bias[2 * e + 1] + bfhi(u0) * wgt[0][2 * e + 1] + bfhi(u1) * wgt[1][2 * e + 1] + bfhi(u2) * wgt[2][2 * e + 1] + bfhi(u3) * wgt[3][2 * e + 1]; }
#pragma unroll
                for (int e = 0; e < 8; ++e) a[e] = a[e] * sigm(a[e]) * sc;
                v4u o; o.x = pk2(a[0], a[1]); o.y = pk2(a[2], a[3]); o.z = pk2(a[4], a[5]); o.w = pk2(a[6], a[7]);
                *(GAS v4u*)(QKC + (size_t)(t0 + i0 + i) * 2048 + c0) = o;
                h0 = h1; h1 = h2; h2 = h3; }
        }
    }
}

constexpr int TP = 72;
__device__ __forceinline__ int tp_col(int c8, int s) { return c8 * TP + ((((s >> 3) ^ ((c8 >> 3) & 7)) << 3) | (s & 7)); }
__device__ __forceinline__ int tp_chunk(int r, int chunk) { return r * TP + ((chunk ^ ((r >> 3) & 7)) << 3); }
__device__ __forceinline__ void p_mlstm_local(Frame& F) {
    frame_ids(F);
    const bf16* PROJ = (const bf16*)(F.ws + WS_PROJ); const bf16* QKC = (const bf16*)(F.ws + WS_QKC); const float* IFG = (const float*)(F.ws + WS_IFG);
    float* BCUM = (float*)(F.ws + WS_BCUM); bf16* CLOC = (bf16*)(F.ws + WS_CLOC); float* NLOC = (float*)(F.ws + WS_NLOC);
    float* CHA = (float*)(F.ws + WS_CHS); float* CHG = CHA + 1024;
    LAS bf16* Kt = (LAS bf16*)(F.lds + RING_OFF);
    LAS bf16* Vt = Kt + 256 * TP;
    LAS float* es = (LAS float*)(Vt + 256 * TP);
    const int lane = F.lane, w = F.wave, hh = lane >> 5, l31 = lane & 31;
    v4u rk[4], rv[4]; float ipn = 0.f, fpn = 0.f;
#define ML_LOAD(uu) do { const int bh_ = (uu) >> 7, c_ = (uu) & 127, b_ = bh_ >> 2, h_ = bh_ & 3, t0_ = b_ * SEQ + c_ * CHUNK; \
        _Pragma("unroll") for (int i = 0; i < 4; ++i) { const int p = F.tid + NTHR * i, s = p >> 5, c8 = (p & 31) * 8; \
            rk[i] = *(const GAS v4u*)(QKC + (size_t)(t0_ + s) * 2048 + 1024 + h_ * 256 + c8); rv[i] = *(const GAS v4u*)(PROJ + (size_t)(t0_ + s) * NPROJ + PV_M + h_ * 256 + c8); } \
        if (w == 0) { ipn = IFG[(size_t)(t0_ + lane) * 8 + h_]; fpn = IFG[(size_t)(t0_ + lane) * 8 + 4 + h_]; } } while (0)
    if (F.vcu < 1024) ML_LOAD(F.vcu);
    for (int u = F.vcu; u < 1024; u += F.G) {
        const int bh = u >> 7, c = u & 127, b = bh >> 2, h = bh & 3, t0 = b * SEQ + c * CHUNK;
        if (w == 0) {
            const float ip = ipn, fp = fpn;
            const float lf = fminf(fp, 0.f) - log1pf(__expf(-fabsf(fp)));
            float bc = lf;
#pragma unroll
            for (int o = 1; o < 64; o <<= 1) { const float y = __shfl_up(bc, o); if (lane >= o) bc += y; }
            const float g = __shfl(bc, 63), we = g - bc + ip, a = wave_max(we);
            es[lane] = __expf(we - a);
            BCUM[(size_t)(t0 + lane) * 4 + h] = bc;
            if (lane == 0) { CHA[u] = a; CHG[u] = g; }
        }
        __syncthreads();
#pragma unroll
        for (int i = 0; i < 4; ++i) { const int p = F.tid + NTHR * i, s = p >> 5, c8 = (p & 31) * 8;
            const v4u kv = rk[i], vv = rv[i];
            const float e = es[s];
            LAS bf16* kd = Kt + tp_col(c8, s); LAS bf16* vd = Vt + tp_col(c8, s);
            kd[0 * TP] = (bf16)(kv.x & 0xffff); kd[1 * TP] = (bf16)(kv.x >> 16); kd[2 * TP] = (bf16)(kv.y & 0xffff); kd[3 * TP] = (bf16)(kv.y >> 16);
            kd[4 * TP] = (bf16)(kv.z & 0xffff); kd[5 * TP] = (bf16)(kv.z >> 16); kd[6 * TP] = (bf16)(kv.w & 0xffff); kd[7 * TP] = (bf16)(kv.w >> 16);
            vd[0 * TP] = f2bf(bflo(vv.x) * e); vd[1 * TP] = f2bf(bfhi(vv.x) * e); vd[2 * TP] = f2bf(bflo(vv.y) * e); vd[3 * TP] = f2bf(bfhi(vv.y) * e);
            vd[4 * TP] = f2bf(bflo(vv.z) * e); vd[5 * TP] = f2bf(bfhi(vv.z) * e); vd[6 * TP] = f2bf(bflo(vv.w) * e); vd[7 * TP] = f2bf(bfhi(vv.w) * e); }
        __syncthreads();
        if (u + F.G < 1024) ML_LOAD(u + F.G);
        bf16x8 af[4];
#pragma unroll
        for (int ks = 0; ks < 4; ++ks) af[ks] = *(const LAS bf16x8*)(Kt + tp_chunk(32 * w + l31, 2 * ks + hh));
        bf16* Cu = CLOC + (size_t)u * 65536;
#pragma unroll 2
        for (int ni = 0; ni < 8; ++ni) {
            f32x16 acc = {0.f, 0.f, 0.f, 0.f, 0.f, 0.f, 0.f, 0.f, 0.f, 0.f, 0.f, 0.f, 0.f, 0.f, 0.f, 0.f};
#pragma unroll
            for (int ks = 0; ks < 4; ++ks) { const bf16x8 bfr = *(const LAS bf16x8*)(Vt + tp_chunk(32 * ni + l31, 2 * ks + hh)); acc = mfma32(af[ks], bfr, acc); }
            const int v = 32 * ni + l31;
#pragma unroll
            for (int rg = 0; rg < 4; ++rg) { v2u o; o.x = pk2(acc[4 * rg], acc[4 * rg + 1]); o.y = pk2(acc[4 * rg + 2], acc[4 * rg + 3]);
                *(GAS v2u*)(Cu + (size_t)w * 8192 + v * 32 + 8 * rg + 4 * hh) = o; }
        }
        if (F.tid < 256) { float a = 0.f;
#pragma unroll
            for (int cch = 0; cch < 8; ++cch) { const v4u kq = *(const LAS v4u*)(Kt + tp_chunk(F.tid, cch)); const LAS float* e8 = es + 8 * cch;
                a += e8[0] * bflo(kq.x); a += e8[1] * bfhi(kq.x); a += e8[2] * bflo(kq.y); a += e8[3] * bfhi(kq.y); a += e8[4] * bflo(kq.z); a += e8[5] * bfhi(kq.z); a += e8[6] * bflo(kq.w); a += e8[7] * bfhi(kq.w); }
            NLOC[(size_t)u * 256 + F.tid] = a; }
        __syncthreads();
    }
#undef ML_LOAD
}

__device__ __forceinline__ void p_mlstm_scan(Frame& F) {
    frame_ids(F);
    const bf16* CLOC = (const bf16*)(F.ws + WS_CLOC); bf16* CIN = (bf16*)(F.ws + WS_CIN);
    const float* NLOC = (const float*)(F.ws + WS_NLOC); float* NIN = (float*)(F.ws + WS_NIN);
    const float* CHA = (const float*)(F.ws + WS_CHS); const float* CHG = CHA + 1024; float* CHM = (float*)(F.ws + WS_CHS) + 2048;
    const int gt = F.vcu * NTHR + F.tid, NGT = F.G * NTHR;
    if (F.tid < 8) { for (int q = F.vcu * 8 + F.tid; q < 8 * 256; q += F.G * 8) {
        const int bh = q >> 8, k = q & 255; float m = 0.f, n = 0.f;
        for (int c0 = 0; c0 < NCH; c0 += 32) { float nl[32], aa[32], gg[32];
#pragma unroll
            for (int i = 0; i < 32; ++i) { const int u = bh * NCH + c0 + i; nl[i] = NLOC[(size_t)u * 256 + k]; aa[i] = CHA[u]; gg[i] = CHG[u]; }
#pragma unroll
            for (int i = 0; i < 32; ++i) { const int u = bh * NCH + c0 + i;
                const float mn = fmaxf(gg[i] + m, aa[i]), sp = __expf(gg[i] + m - mn), sl = __expf(aa[i] - mn);
                NIN[(size_t)u * 256 + k] = n; n = sp * n + sl * nl[i]; m = mn; } } } }
    for (int q = gt; q < 8 * 16384; q += NGT) {
        const int bh = q >> 14; const size_t off = (size_t)(q & 16383) * 4;
        float m = 0.f, C0 = 0.f, C1 = 0.f, C2 = 0.f, C3 = 0.f;
        for (int c0 = 0; c0 < NCH; c0 += 16) {
            v2u cl[16]; float aa[16], gg[16];
#pragma unroll
            for (int i = 0; i < 16; ++i) { const int u = bh * NCH + c0 + i; cl[i] = *(const GAS v2u*)(CLOC + (size_t)u * 65536 + off); aa[i] = CHA[u]; gg[i] = CHG[u]; }
#pragma unroll
            for (int i = 0; i < 16; ++i) { const int u = bh * NCH + c0 + i;
                const float mn = fmaxf(gg[i] + m, aa[i]), sp = __expf(gg[i] + m - mn), sl = __expf(aa[i] - mn);
                v2u o; o.x = pk2(C0, C1); o.y = pk2(C2, C3);
                *(GAS v2u*)(CIN + (size_t)u * 65536 + off) = o;
                if (off == 0) CHM[u] = m;
                C0 = sp * C0 + sl * bflo(cl[i].x); C1 = sp * C1 + sl * bfhi(cl[i].x); C2 = sp * C2 + sl * bflo(cl[i].y); C3 = sp * C3 + sl * bfhi(cl[i].y);
                m = mn; }
        }
    }
}

constexpr int QP = 264;
__device__ __forceinline__ void p_mlstm_out(Frame& F) {
    frame_ids(F);
    const bf16* PROJ = (const bf16*)(F.ws + WS_PROJ); const bf16* QKC = (const bf16*)(F.ws + WS_QKC); const float* IFG = (const float*)(F.ws + WS_IFG);
    const float* BCUM = (const float*)(F.ws + WS_BCUM); const bf16* CIN = (const bf16*)(F.ws + WS_CIN); const float* NIN = (const float*)(F.ws + WS_NIN);
    const float* CHM = (const float*)(F.ws + WS_CHS) + 2048; bf16* HM = (bf16*)(F.ws + WS_HM); const float* hnw = F.in[I_MHNW];
    LAS bf16* Qs = (LAS bf16*)(F.lds + RING_OFF);
    LAS bf16* Ks = Qs + 64 * QP;
    LAS bf16* Vt = Ks + 64 * QP;
    LAS bf16* Sm = Vt + 256 * TP;
    LAS float* fb = (LAS float*)(Sm + 64 * TP);
    LAS float* fi = fb + 64; LAS float* fmj = fb + 128; LAS float* fwi = fb + 192; LAS float* dpart = fb + 256; LAS float* dint = fb + 384; LAS float* hpart = fb + 448;
    const int lane = F.lane, w = F.wave, hh = lane >> 5, l31 = lane & 31;
    v4u rq[4], rk[4], rv[4]; float bjn = 0.f, ijn = 0.f, minn = 0.f;
#define MO_LOAD(uu) do { const int bh_ = (uu) >> 7, c_ = (uu) & 127, b_ = bh_ >> 2, h_ = bh_ & 3, t0_ = b_ * SEQ + c_ * CHUNK; \
        _Pragma("unroll") for (int i = 0; i < 4; ++i) { const int p = F.tid + NTHR * i, s = p >> 5, c8 = (p & 31) * 8; \
            rq[i] = *(const GAS v4u*)(QKC + (size_t)(t0_ + s) * 2048 + h_ * 256 + c8); rk[i] = *(const GAS v4u*)(QKC + (size_t)(t0_ + s) * 2048 + 1024 + h_ * 256 + c8); \
            rv[i] = *(const GAS v4u*)(PROJ + (size_t)(t0_ + s) * NPROJ + PV_M + h_ * 256 + c8); } \
        if (w == 0) { bjn = BCUM[(size_t)(t0_ + lane) * 4 + h_]; ijn = IFG[(size_t)(t0_ + lane) * 8 + h_]; minn = CHM[(uu)]; } } while (0)
    if (F.vcu < 1024) MO_LOAD(F.vcu);
    for (int u = F.vcu; u < 1024; u += F.G) {
        const int bh = u >> 7, c = u & 127, b = bh >> 2, h = bh & 3, t0 = b * SEQ + c * CHUNK;
        bf16x8 cf[16];
        { const bf16* Cu = CIN + (size_t)u * 65536 + (size_t)(32 * w + l31) * 32 + 8 * hh;
#pragma unroll
            for (int ks = 0; ks < 16; ++ks) cf[ks] = *(const GAS bf16x8*)(Cu + (ks >> 1) * 8192 + 16 * (ks & 1)); }
#pragma unroll
        for (int i = 0; i < 4; ++i) { const int p = F.tid + NTHR * i, s = p >> 5, c8 = (p & 31) * 8;
            const v4u vv = rv[i];
            *(LAS v4u*)(Qs + s * QP + c8) = rq[i]; *(LAS v4u*)(Ks + s * QP + c8) = rk[i];
            LAS bf16* vd = Vt + tp_col(c8, s);
            vd[0 * TP] = (bf16)(vv.x & 0xffff); vd[1 * TP] = (bf16)(vv.x >> 16); vd[2 * TP] = (bf16)(vv.y & 0xffff); vd[3 * TP] = (bf16)(vv.y >> 16);
            vd[4 * TP] = (bf16)(vv.z & 0xffff); vd[5 * TP] = (bf16)(vv.z >> 16); vd[6 * TP] = (bf16)(vv.w & 0xffff); vd[7 * TP] = (bf16)(vv.w >> 16); }
        if (w == 0) {
            const float bj = bjn, ij = ijn, m_in = minn;
            float pm = ij - bj;
#pragma unroll
            for (int o = 1; o < 64; o <<= 1) { const float y = __shfl_up(pm, o); if (lane >= o) pm = fmaxf(pm, y); }
            const float il = bj + m_in, mj = fmaxf(il, bj + pm);
            fb[lane] = bj; fi[lane] = ij; fmj[lane] = mj; fwi[lane] = __expf(il - mj);
        }
        __syncthreads();
        if (u + F.G < 1024) MO_LOAD(u + F.G);
        if (w < 4) {
            const int tj = w >> 1, ts = w & 1;
            f32x16 acc = {0.f, 0.f, 0.f, 0.f, 0.f, 0.f, 0.f, 0.f, 0.f, 0.f, 0.f, 0.f, 0.f, 0.f, 0.f, 0.f};
#pragma unroll
            for (int ks = 0; ks < 16; ++ks) { const bf16x8 a = *(const LAS bf16x8*)(Qs + (32 * tj + l31) * QP + 16 * ks + 8 * hh);
                const bf16x8 bb = *(const LAS bf16x8*)(Ks + (32 * ts + l31) * QP + 16 * ks + 8 * hh); acc = mfma32(a, bb, acc); }
            const int s = 32 * ts + l31; const float cs = fi[s] - fb[s];
#pragma unroll
            for (int r = 0; r < 16; ++r) { const int j = 32 * tj + (r & 3) + 8 * (r >> 2) + 4 * hh;
                const float p = (s <= j) ? acc[r] * __expf(fb[j] - fmj[j] + cs) : 0.f;
                Sm[j * TP + s] = f2bf(p);
                float v = p; v += __shfl_xor(v, 1); v += __shfl_xor(v, 2); v += __shfl_xor(v, 4); v += __shfl_xor(v, 8); v += __shfl_xor(v, 16);
                if (l31 == 0) dpart[ts * 64 + j] = v; }
        } else {
            const int tt = F.tid - 256, j = tt >> 2, part = tt & 3; float a = 0.f;
            const GAS f32x4* nin = (const GAS f32x4*)(NIN + (size_t)u * 256 + part * 64);
#pragma unroll
            for (int hb = 0; hb < 4; ++hb) { f32x4 nv[4];
#pragma unroll
                for (int k4 = 0; k4 < 4; ++k4) nv[k4] = nin[4 * hb + k4];
#pragma unroll
                for (int k4 = 0; k4 < 4; ++k4) { const v2u qw = *(const LAS v2u*)(Qs + j * QP + part * 64 + 16 * hb + 4 * k4);
                    a += nv[k4].x * bflo(qw.x) + nv[k4].y * bfhi(qw.x) + nv[k4].z * bflo(qw.y) + nv[k4].w * bfhi(qw.y); } }
            a += __shfl_xor(a, 1); a += __shfl_xor(a, 2);
            if (part == 0) dint[j] = fwi[j] * a;
        }
        __syncthreads();
        f32x16 acc[2];
#pragma unroll
        for (int tj = 0; tj < 2; ++tj) acc[tj] = (f32x16){0.f, 0.f, 0.f, 0.f, 0.f, 0.f, 0.f, 0.f, 0.f, 0.f, 0.f, 0.f, 0.f, 0.f, 0.f, 0.f};
#pragma unroll
        for (int ks = 0; ks < 16; ++ks) { const bf16x8 a = cf[ks];
#pragma unroll
            for (int tj = 0; tj < 2; ++tj) { const bf16x8 bq = *(const LAS bf16x8*)(Qs + (32 * tj + l31) * QP + 16 * ks + 8 * hh); acc[tj] = mfma32(a, bq, acc[tj]); } }
#pragma unroll
        for (int tj = 0; tj < 2; ++tj) { const float wi = fwi[32 * tj + l31];
#pragma unroll
            for (int r = 0; r < 16; ++r) acc[tj][r] *= wi; }
#pragma unroll
        for (int ks = 0; ks < 4; ++ks) { const bf16x8 a = *(const LAS bf16x8*)(Vt + tp_chunk(32 * w + l31, 2 * ks + hh));
#pragma unroll
            for (int tj = 0; tj < 2; ++tj) { const bf16x8 bs = *(const LAS bf16x8*)(Sm + (32 * tj + l31) * TP + 16 * ks + 8 * hh); acc[tj] = mfma32(a, bs, acc[tj]); } }
#pragma unroll
        for (int tj = 0; tj < 2; ++tj) { const int j = 32 * tj + l31; const float den = (dpart[j] + dpart[64 + j]) + dint[j];
            const float inv = 1.f / fmaxf(fabsf(den), __expf(-fmj[j])); float q2 = 0.f;
#pragma unroll
            for (int r = 0; r < 16; ++r) { acc[tj][r] *= inv; q2 += acc[tj][r] * acc[tj][r]; }
            q2 += __shfl_xor(q2, 32);
            if (hh == 0) hpart[w * 64 + j] = q2; }
        __syncthreads();
        f32x4 nwv[4]; v2u ogv[2][4];
#pragma unroll
        for (int rg = 0; rg < 4; ++rg) { const int v0 = 32 * w + 8 * rg + 4 * hh; nwv[rg] = *(const GAS f32x4*)(hnw + h * 256 + v0);
#pragma unroll
            for (int tj = 0; tj < 2; ++tj) ogv[tj][rg] = *(const GAS v2u*)(PROJ + (size_t)(t0 + 32 * tj + l31) * NPROJ + PO_M + h * 256 + v0); }
#pragma unroll
        for (int tj = 0; tj < 2; ++tj) { const int j = 32 * tj + l31; float hs = 0.f;
#pragma unroll
            for (int ww = 0; ww < 8; ++ww) hs += hpart[ww * 64 + j];
            const float rs = 1.f / sqrtf(hs * (1.f / MD) + EPS); const size_t t = (size_t)(t0 + j);
#pragma unroll
            for (int rg = 0; rg < 4; ++rg) { const int v0 = 32 * w + 8 * rg + 4 * hh;
                const f32x4 nw = nwv[rg];
                const v2u og = ogv[tj][rg];
                v2u o; o.x = pk2(acc[tj][4 * rg] * rs * nw.x * bflo(og.x), acc[tj][4 * rg + 1] * rs * nw.y * bfhi(og.x));
                o.y = pk2(acc[tj][4 * rg + 2] * rs * nw.z * bflo(og.y), acc[tj][4 * rg + 3] * rs * nw.w * bfhi(og.y));
                *(GAS v2u*)(HM + t * 2048 + h * 256 + v0) = o; } }
        __syncthreads();
    }
#undef MO_LOAD
}

template <int DH> struct AttnState { f32x16 ot[DH / 32]; bf16x8 qf[DH / 16]; float m_run, l_run; };
template <int DH, bool BAND>
__device__ __forceinline__ void attn_step(AttnState<DH>& A, const LAS bf16* Ks, const LAS bf16* Vt, const LAS float* relb, int dchunk, int qi, int lane) {
    constexpr int KP = DH + 8;
    const int hh = lane >> 5, l31 = lane & 31;
    f32x16 st[2];
#pragma unroll
    for (int kt = 0; kt < 2; ++kt) { st[kt] = (f32x16){0.f, 0.f, 0.f, 0.f, 0.f, 0.f, 0.f, 0.f, 0.f, 0.f, 0.f, 0.f, 0.f, 0.f, 0.f, 0.f};
#pragma unroll
        for (int ks = 0; ks < DH / 16; ++ks) { const bf16x8 a = *(const LAS bf16x8*)(Ks + (32 * kt + l31) * KP + 16 * ks + 8 * hh); st[kt] = mfma32(a, A.qf[ks], st[kt]); } }
    float mx = -1e30f, cadd = 0.f;
    if (BAND && dchunk < 3) {
        const int base4 = (64 * dchunk + qi - 4 * hh + 128) * 4;
#pragma unroll
        for (int kt = 0; kt < 2; ++kt)
#pragma unroll
            for (int r = 0; r < 16; ++r) { int i4 = base4 - 4 * (32 * kt + (r & 3) + 8 * (r >> 2)); i4 = i4 > 1024 ? 1024 : i4;
                const float s = st[kt][r] + *(const LAS float*)((const LAS char*)relb + i4); st[kt][r] = s; mx = fmaxf(mx, s); }
    } else {
#pragma unroll
        for (int kt = 0; kt < 2; ++kt)
#pragma unroll
            for (int r = 0; r < 16; ++r) mx = fmaxf(mx, st[kt][r]);
        if (BAND) { cadd = relb[256]; mx += cadd; }
    }
    mx = fmaxf(mx, __shfl_xor(mx, 32));
    const float mn = fmaxf(A.m_run, mx), alpha = __builtin_amdgcn_exp2f(A.m_run - mn), sh = cadd - mn;
    float sum = 0.f;
#pragma unroll
    for (int kt = 0; kt < 2; ++kt)
#pragma unroll
        for (int r = 0; r < 16; ++r) { const float p = __builtin_amdgcn_exp2f(st[kt][r] + sh); st[kt][r] = p; sum += p; }
    sum += __shfl_xor(sum, 32);
    A.l_run = A.l_run * alpha + sum; A.m_run = mn;
#pragma unroll
    for (int dt = 0; dt < DH / 32; ++dt)
#pragma unroll
        for (int r = 0; r < 16; ++r) A.ot[dt][r] *= alpha;
#pragma unroll
    for (int kt = 0; kt < 2; ++kt)
#pragma unroll
        for (int s2 = 0; s2 < 2; ++s2) {
            union { v4u u; bf16x8 v; } pf;
            pf.u.x = pk2(st[kt][8 * s2 + 0], st[kt][8 * s2 + 1]); pf.u.y = pk2(st[kt][8 * s2 + 2], st[kt][8 * s2 + 3]);
            pf.u.z = pk2(st[kt][8 * s2 + 4], st[kt][8 * s2 + 5]); pf.u.w = pk2(st[kt][8 * s2 + 6], st[kt][8 * s2 + 7]);
#pragma unroll
            for (int dt = 0; dt < DH / 32; ++dt) {
                const int vr = 32 * dt + l31, ch = 4 * kt + 2 * s2;
                union { v2u u[2]; bf16x8 v; } af; af.u[0] = *(const LAS v2u*)(Vt + tp_chunk(vr, ch) + 4 * hh); af.u[1] = *(const LAS v2u*)(Vt + tp_chunk(vr, ch + 1) + 4 * hh);
                A.ot[dt] = mfma32(af.v, pf.v, A.ot[dt]); } }
}
template <int DH> struct KVRegs { v4u k[(8 * DH) / NTHR], v[(8 * DH) / NTHR]; };
template <int DH>
__device__ __forceinline__ void attn_load(KVRegs<DH>& R, const bf16* kg, const bf16* vg, size_t pitch, int tid) {
    constexpr int PPR = DH / 8;
#pragma unroll
    for (int i = 0; i < (64 * PPR) / NTHR; ++i) { const int p = tid + NTHR * i, key = p / PPR, c8 = (p % PPR) * 8;
        R.k[i] = *(const GAS v4u*)(kg + (size_t)key * pitch + c8); R.v[i] = *(const GAS v4u*)(vg + (size_t)key * pitch + c8); }
}
template <int DH>
__device__ __forceinline__ void attn_put(LAS bf16* Ks, LAS bf16* Vt, const KVRegs<DH>& R, int tid) {
    constexpr int KP = DH + 8, PPR = DH / 8;
#pragma unroll
    for (int i = 0; i < (64 * PPR) / NTHR; ++i) { const int p = tid + NTHR * i, key = p / PPR, c8 = (p % PPR) * 8;
        const v4u vv = R.v[i];
        *(LAS v4u*)(Ks + key * KP + c8) = R.k[i];
        LAS bf16* vd = Vt + tp_col(c8, key);
        vd[0 * TP] = (bf16)(vv.x & 0xffff); vd[1 * TP] = (bf16)(vv.x >> 16); vd[2 * TP] = (bf16)(vv.y & 0xffff); vd[3 * TP] = (bf16)(vv.y >> 16);
        vd[4 * TP] = (bf16)(vv.z & 0xffff); vd[5 * TP] = (bf16)(vv.z >> 16); vd[6 * TP] = (bf16)(vv.w & 0xffff); vd[7 * TP] = (bf16)(vv.w >> 16); }
}
template <int DH>
__device__ __forceinline__ void attn_init(AttnState<DH>& A, const bf16* qrow, int lane) {
    const int hh = lane >> 5;
#pragma unroll
    for (int ks = 0; ks < DH / 16; ++ks) A.qf[ks] = *(const GAS bf16x8*)(qrow + 16 * ks + 8 * hh);
#pragma unroll
    for (int dt = 0; dt < DH / 32; ++dt) A.ot[dt] = (f32x16){0.f, 0.f, 0.f, 0.f, 0.f, 0.f, 0.f, 0.f, 0.f, 0.f, 0.f, 0.f, 0.f, 0.f, 0.f, 0.f};
    A.m_run = -1e30f; A.l_run = 0.f;
}
template <int DH>
__device__ __forceinline__ void attn_store(const AttnState<DH>& A, bf16* orow, int lane) {
    const int hh = lane >> 5; const float inv = 1.f / A.l_run;
#pragma unroll
    for (int dt = 0; dt < DH / 32; ++dt)
#pragma unroll
        for (int rg = 0; rg < 4; ++rg) { v2u o; o.x = pk2(A.ot[dt][4 * rg] * inv, A.ot[dt][4 * rg + 1] * inv); o.y = pk2(A.ot[dt][4 * rg + 2] * inv, A.ot[dt][4 * rg + 3] * inv);
            *(GAS v2u*)(orow + 32 * dt + 8 * rg + 4 * hh) = o; }
}

__device__ __forceinline__ void p_band_attn(Frame& F) {
    frame_ids(F);
    const bf16* PROJ = (const bf16*)(F.ws + WS_PROJ); bf16* YA = (bf16*)(F.ws + WS_HM) + 1024;
    constexpr int KSZ = 64 * (AD + 8), VSZ = AD * TP, BUF = KSZ + VSZ;
    LAS bf16* B0 = (LAS bf16*)(F.lds + RING_OFF);
    LAS float* relb = (LAS float*)(B0 + 2 * BUF);
    const int lane = F.lane, w = F.wave, l31 = lane & 31;
    for (int u = F.vcu; u < BATCH * AH * 32; u += F.G) {
        const int b = u >> 9, hd = (u >> 5) & 15, qt = u & 31;
        for (int i = F.tid; i < 257; i += NTHR) relb[i] = F.in[I_REL][hd * 257 + i] * 1.4426950408889634f;
        const int cw = 4 * qt + (w >> 1), qi = (w & 1) * 32 + l31; const size_t tq = (size_t)b * SEQ + cw * CHUNK + qi;
        AttnState<AD> A; attn_init<AD>(A, PROJ + tq * NPROJ + PQ_A + hd * AD, lane);
        const int kc0 = (4 * qt - 8) > 0 ? (4 * qt - 8) : 0, kc1 = 4 * qt + 3;
        const bf16* kbase = PROJ + (size_t)b * SEQ * NPROJ + PK_A + hd * AD; const bf16* vbase = PROJ + (size_t)b * SEQ * NPROJ + PV_A + hd * AD;
        KVRegs<AD> R0, R1;
        attn_load<AD>(R0, kbase + (size_t)kc0 * CHUNK * NPROJ, vbase + (size_t)kc0 * CHUNK * NPROJ, NPROJ, F.tid);
        if (kc0 + 1 <= kc1) attn_load<AD>(R1, kbase + (size_t)(kc0 + 1) * CHUNK * NPROJ, vbase + (size_t)(kc0 + 1) * CHUNK * NPROJ, NPROJ, F.tid);
        for (int kc = kc0; kc <= kc1; kc += 2) {
            { LAS bf16* Ks = B0; LAS bf16* Vt = Ks + KSZ;
              attn_put<AD>(Ks, Vt, R0, F.tid);
              __syncthreads();
              if (kc + 2 <= kc1) attn_load<AD>(R0, kbase + (size_t)(kc + 2) * CHUNK * NPROJ, vbase + (size_t)(kc + 2) * CHUNK * NPROJ, NPROJ, F.tid);
              if (kc >= cw - 8 && kc <= cw) attn_step<AD, true>(A, Ks, Vt, relb, cw - kc, qi, lane); }
            if (kc + 1 <= kc1) { LAS bf16* Ks = B0 + BUF; LAS bf16* Vt = Ks + KSZ;
              attn_put<AD>(Ks, Vt, R1, F.tid);
              __syncthreads();
              if (kc + 3 <= kc1) attn_load<AD>(R1, kbase + (size_t)(kc + 3) * CHUNK * NPROJ, vbase + (size_t)(kc + 3) * CHUNK * NPROJ, NPROJ, F.tid);
              if (kc + 1 >= cw - 8 && kc + 1 <= cw) attn_step<AD, true>(A, Ks, Vt, relb, cw - kc - 1, qi, lane); }
        }
        attn_store<AD>(A, YA + tq * 2048 + hd * AD, lane);
        __syncthreads();
    }
}

__device__ __forceinline__ void p_local_band(Frame& F) {
    frame_ids(F);
    const bf16* PROJ = (const bf16*)(F.ws + WS_PROJ); const bf16* QKC = (const bf16*)(F.ws + WS_QKC); const float* IFG = (const float*)(F.ws + WS_IFG);
    float* BCUM = (float*)(F.ws + WS_BCUM); bf16* CLOC = (bf16*)(F.ws + WS_CLOC); float* NLOC = (float*)(F.ws + WS_NLOC);
    float* CHA = (float*)(F.ws + WS_CHS); float* CHG = CHA + 1024;
    LAS bf16* Kt = (LAS bf16*)(F.lds + RING_OFF);
    LAS bf16* Vt = Kt + 256 * TP;
    LAS float* es = (LAS float*)(Vt + 256 * TP);
    const int lane = F.lane, w = F.wave, hh = lane >> 5, l31 = lane & 31;
    v4u rk[4], rv[4]; float ipn = 0.f, fpn = 0.f;
#define ML_LOAD(uu) do { const int bh_ = (uu) >> 7, c_ = (uu) & 127, b_ = bh_ >> 2, h_ = bh_ & 3, t0_ = b_ * SEQ + c_ * CHUNK; \
        _Pragma("unroll") for (int i = 0; i < 4; ++i) { const int p = F.tid + NTHR * i, s = p >> 5, c8 = (p & 31) * 8; \
            rk[i] = *(const GAS v4u*)(QKC + (size_t)(t0_ + s) * 2048 + 1024 + h_ * 256 + c8); rv[i] = *(const GAS v4u*)(PROJ + (size_t)(t0_ + s) * NPROJ + PV_M + h_ * 256 + c8); } } while (0)
#define ML_LOADG(uu) do { const int bh_ = (uu) >> 7, c_ = (uu) & 127, b_ = bh_ >> 2, h_ = bh_ & 3, t0_ = b_ * SEQ + c_ * CHUNK; \
        if (F.wave == 0) { ipn = IFG[(size_t)(t0_ + F.lane) * 8 + h_]; fpn = IFG[(size_t)(t0_ + F.lane) * 8 + 4 + h_]; } } while (0)
    const int par = F.vcu & 1;
    if (F.vcu < 1024) { ML_LOAD(F.vcu); ML_LOADG(F.vcu); }
    for (int i = 0; F.vcu + (i - par) * F.G < 1024; ++i) {
        const int ul = F.vcu + (i - par) * F.G, ub = F.vcu + i * F.G, uln = ul + F.G;
        if (ul >= 0) {
        const int u = ul;
        int lane = F.lane; asm volatile("" : "+v"(lane));
        const int tid_ = F.wave * 64 + lane, hh = lane >> 5, l31 = lane & 31;
        const int bh = u >> 7, c = u & 127, b = bh >> 2, h = bh & 3, t0 = b * SEQ + c * CHUNK;
        if (w == 0) {
            const float ip = ipn, fp = fpn;
            const float lf = fminf(fp, 0.f) - log1pf(__expf(-fabsf(fp)));
            float bc = lf;
#pragma unroll
            for (int o = 1; o < 64; o <<= 1) { const float y = __shfl_up(bc, o); if (lane >= o) bc += y; }
            const float g = __shfl(bc, 63), we = g - bc + ip, a = wave_max(we);
            es[lane] = __expf(we - a);
            BCUM[(size_t)(t0 + lane) * 4 + h] = bc;
            if (lane == 0) { CHA[u] = a; CHG[u] = g; }
        }
        __syncthreads();
#pragma unroll
        for (int i = 0; i < 4; ++i) { const int p = tid_ + NTHR * i, s = p >> 5, c8 = (p & 31) * 8;
            const v4u kv = rk[i], vv = rv[i];
            const float e = es[s];
            LAS bf16* kd = Kt + tp_col(c8, s); LAS bf16* vd = Vt + tp_col(c8, s);
            kd[0 * TP] = (bf16)(kv.x & 0xffff); kd[1 * TP] = (bf16)(kv.x >> 16); kd[2 * TP] = (bf16)(kv.y & 0xffff); kd[3 * TP] = (bf16)(kv.y >> 16);
            kd[4 * TP] = (bf16)(kv.z & 0xffff); kd[5 * TP] = (bf16)(kv.z >> 16); kd[6 * TP] = (bf16)(kv.w & 0xffff); kd[7 * TP] = (bf16)(kv.w >> 16);
            vd[0 * TP] = f2bf(bflo(vv.x) * e); vd[1 * TP] = f2bf(bfhi(vv.x) * e); vd[2 * TP] = f2bf(bflo(vv.y) * e); vd[3 * TP] = f2bf(bfhi(vv.y) * e);
            vd[4 * TP] = f2bf(bflo(vv.z) * e); vd[5 * TP] = f2bf(bfhi(vv.z) * e); vd[6 * TP] = f2bf(bflo(vv.w) * e); vd[7 * TP] = f2bf(bfhi(vv.w) * e); }
        __syncthreads();
        if (uln < 1024) { ML_LOAD(uln); ML_LOADG(uln); }
        bf16x8 af[4];
#pragma unroll
        for (int ks = 0; ks < 4; ++ks) af[ks] = *(const LAS bf16x8*)(Kt + tp_chunk(32 * w + l31, 2 * ks + hh));
        bf16* Cu = CLOC + (size_t)u * 65536;
#pragma unroll 2
        for (int ni = 0; ni < 8; ++ni) {
            f32x16 acc = {0.f, 0.f, 0.f, 0.f, 0.f, 0.f, 0.f, 0.f, 0.f, 0.f, 0.f, 0.f, 0.f, 0.f, 0.f, 0.f};
#pragma unroll
            for (int ks = 0; ks < 4; ++ks) { const bf16x8 bfr = *(const LAS bf16x8*)(Vt + tp_chunk(32 * ni + l31, 2 * ks + hh)); acc = mfma32(af[ks], bfr, acc); }
            const int v = 32 * ni + l31;
#pragma unroll
            for (int rg = 0; rg < 4; ++rg) { v2u o; o.x = pk2(acc[4 * rg], acc[4 * rg + 1]); o.y = pk2(acc[4 * rg + 2], acc[4 * rg + 3]);
                *(GAS v2u*)(Cu + (size_t)w * 8192 + v * 32 + 8 * rg + 4 * hh) = o; }
        }
        if (tid_ < 256) { float a = 0.f;
#pragma unroll
            for (int cch = 0; cch < 8; ++cch) { const v4u kq = *(const LAS v4u*)(Kt + tp_chunk(tid_, cch)); const LAS float* e8 = es + 8 * cch;
                a += e8[0] * bflo(kq.x); a += e8[1] * bfhi(kq.x); a += e8[2] * bflo(kq.y); a += e8[3] * bfhi(kq.y); a += e8[4] * bflo(kq.z); a += e8[5] * bfhi(kq.z); a += e8[6] * bflo(kq.w); a += e8[7] * bfhi(kq.w); }
            NLOC[(size_t)u * 256 + tid_] = a; }
        __syncthreads();
            }
        if (ub < 1024) {
        const int u = ub;
    const bf16* PROJ = (const bf16*)(F.ws + WS_PROJ); bf16* YA = (bf16*)(F.ws + WS_HM) + 1024;
    constexpr int KSZ = 64 * (AD + 8), VSZ = AD * TP, BUF = KSZ + VSZ;
    LAS bf16* B0 = (LAS bf16*)(F.lds + RING_OFF);
    LAS float* relb = (LAS float*)(B0 + 2 * BUF);
    int lane = F.lane; asm volatile("" : "+v"(lane));
    const int tid_ = F.wave * 64 + lane, w = F.wave, l31 = lane & 31;
        {
        const int b = u >> 9, hd = (u >> 5) & 15, qt = u & 31;
        for (int i = tid_; i < 257; i += NTHR) relb[i] = F.in[I_REL][hd * 257 + i] * 1.4426950408889634f;
        const int cw = 4 * qt + (w >> 1), qi = (w & 1) * 32 + l31; const size_t tq = (size_t)b * SEQ + cw * CHUNK + qi;
        AttnState<AD> A; attn_init<AD>(A, PROJ + tq * NPROJ + PQ_A + hd * AD, lane);
        const int kc0 = (4 * qt - 8) > 0 ? (4 * qt - 8) : 0, kc1 = 4 * qt + 3;
        const bf16* kbase = PROJ + (size_t)b * SEQ * NPROJ + PK_A + hd * AD; const bf16* vbase = PROJ + (size_t)b * SEQ * NPROJ + PV_A + hd * AD;
        KVRegs<AD> R0, R1;
        attn_load<AD>(R0, kbase + (size_t)kc0 * CHUNK * NPROJ, vbase + (size_t)kc0 * CHUNK * NPROJ, NPROJ, tid_);
        if (kc0 + 1 <= kc1) attn_load<AD>(R1, kbase + (size_t)(kc0 + 1) * CHUNK * NPROJ, vbase + (size_t)(kc0 + 1) * CHUNK * NPROJ, NPROJ, tid_);
        for (int kc = kc0; kc <= kc1; kc += 2) {
            { LAS bf16* Ks = B0; LAS bf16* Vt = Ks + KSZ;
              attn_put<AD>(Ks, Vt, R0, tid_);
              __syncthreads();
              if (kc + 2 <= kc1) attn_load<AD>(R0, kbase + (size_t)(kc + 2) * CHUNK * NPROJ, vbase + (size_t)(kc + 2) * CHUNK * NPROJ, NPROJ, tid_);
              if (kc >= cw - 8 && kc <= cw) attn_step<AD, true>(A, Ks, Vt, relb, cw - kc, qi, lane); }
            if (kc + 1 <= kc1) { LAS bf16* Ks = B0 + BUF; LAS bf16* Vt = Ks + KSZ;
              attn_put<AD>(Ks, Vt, R1, tid_);
              __syncthreads();
              if (kc + 3 <= kc1) attn_load<AD>(R1, kbase + (size_t)(kc + 3) * CHUNK * NPROJ, vbase + (size_t)(kc + 3) * CHUNK * NPROJ, NPROJ, tid_);
              if (kc + 1 >= cw - 8 && kc + 1 <= cw) attn_step<AD, true>(A, Ks, Vt, relb, cw - kc - 1, qi, lane); }
        }
        attn_store<AD>(A, YA + tq * 2048 + hd * AD, lane);
        __syncthreads();
            }
        }
    }
#undef ML_LOADG
#undef ML_LOAD
}


__device__ __forceinline__ void p_cross_attn(Frame& F) {
    frame_ids(F);
    const bf16* QX = (const bf16*)(F.ws + WS_QX); const bf16* KVX = (const bf16*)(F.ws + WS_KVX); bf16* OX = (bf16*)(F.ws + WS_OX);
    constexpr int KSZ = 64 * (XD + 8), VSZ = XD * TP, BUF = KSZ + VSZ;
    LAS bf16* B0 = (LAS bf16*)(F.lds + RING_OFF);
    const int lane = F.lane, w = F.wave, l31 = lane & 31;
    for (int u = F.vcu; u < BATCH * XH * 32; u += F.G) {
        const int b = u >> 7, hx = (u >> 5) & 3, qt = u & 31;
        const size_t tq = (size_t)b * SEQ + qt * 256 + 32 * w + l31;
        AttnState<XD> A; attn_init<XD>(A, QX + tq * XW + hx * XD, lane);
        const bf16* kg0 = KVX + (size_t)(b * NMEM) * (2 * XW) + hx * XD;
        KVRegs<XD> R; attn_load<XD>(R, kg0, kg0 + XW, 2 * XW, F.tid);
        for (int st = 0; st < 4; ++st) {
            LAS bf16* Ks = B0 + (st & 1) * BUF; LAS bf16* Vt = Ks + KSZ;
            attn_put<XD>(Ks, Vt, R, F.tid);
            __syncthreads();
            if (st < 3) { const bf16* kg = kg0 + (size_t)((st + 1) * 64) * (2 * XW); attn_load<XD>(R, kg, kg + XW, 2 * XW, F.tid); }
            attn_step<XD, false>(A, Ks, Vt, nullptr, 0, 0, lane);
        }
        attn_store<XD>(A, OX + tq * XW + hx * XD, lane);
        __syncthreads();
    }
}

__device__ __forceinline__ void p_rmsnorm_rows(Frame& F, const float* X, const float* w, bf16* XN, unsigned char* XQ) {
    frame_ids(F);
    const int gw = F.vcu * NWAVES + F.wave, NGW = F.G * NWAVES;
    for (int m = gw; m < T; m += NGW) {
        const GAS f32x4* xr = (const GAS f32x4*)(X + (size_t)m * D) + F.lane;
        f32x4 v[8]; float s = 0.f;
#pragma unroll
        for (int j = 0; j < 8; ++j) { v[j] = xr[64 * j]; s += (v[j].x * v[j].x + v[j].y * v[j].y) + (v[j].z * v[j].z + v[j].w * v[j].w); }
        const float rstd = 1.f / sqrtf(wave_sum(s) * (1.f / D) + EPS);
        const GAS f32x4* wr = (const GAS f32x4*)w + F.lane;
        GAS v2u* o8 = (GAS v2u*)(XN + (size_t)m * D) + F.lane;
#pragma unroll
        for (int j = 0; j < 8; ++j) { const f32x4 ww = wr[64 * j]; v[j].x *= rstd * ww.x; v[j].y *= rstd * ww.y; v[j].z *= rstd * ww.z; v[j].w *= rstd * ww.w;
            v2u o; o.x = pk2(v[j].x, v[j].y); o.y = pk2(v[j].z, v[j].w); o8[64 * j] = o; }
        if (XQ) { GAS unsigned* q4 = (GAS unsigned*)(XQ + (size_t)m * D) + F.lane;
#pragma unroll
            for (int j = 0; j < 8; ++j) q4[64 * j] = pg8::pk_fp8x4(v[j].x * XSCALE, v[j].y * XSCALE, v[j].z * XSCALE, v[j].w * XSCALE); }
    }
}


constexpr int NR_EXTRA = 133120;
__device__ __forceinline__ void p_norm_route(Frame& F) {
    frame_ids(F);
    const bf16* X2 = (const bf16*)(F.ws + WS_X2); const float* nw = F.in[I_NFFNW]; const bf16* WR = (const bf16*)(F.ws + WS_WR); const float* br = F.in[I_BR];
    unsigned char* XQ = (unsigned char*)(F.ws + WS_XQ); float* RSTD = (float*)(F.ws + WS_RSTD);
    int* TOPE = (int*)(F.ws + WS_TOPE); float* GATE = (float*)(F.ws + WS_GATE); int* RANK = (int*)(F.ws + WS_RANK); int* HIST = (int*)(F.ws + WS_CTL) + CW_HIST;
    LAS unsigned char* wt = F.lds + RING_OFF;
    LAS float* part = (LAS float*)(F.lds + NR_EXTRA);
    LAS float* sq = part + 64 * 32;
    LAS float* rs = sq + 64;
    LAS int* lh = (LAS int*)(rs + 64); LAS int* le = lh + 32;
    for (int i = 0; i < 16; ++i) { const int q = F.tid + NTHR * i, e = q >> 8, c = q & 255;
        *(LAS v4u*)(wt + e * 4096 + ((c ^ (e & 15)) << 4)) = *(const GAS v4u*)(WR + (size_t)e * D + 8 * c); }
    const int lane = F.lane, w = F.wave, tg = w & 3, kh = w >> 2, r16 = lane & 15, kq = lane >> 4;
    for (int blk = F.vcu; blk < T / 64; blk += F.G) {
        if (F.tid < 32) lh[F.tid] = 0;
        __syncthreads();
        const int tok = 16 * tg + r16; const size_t t = (size_t)blk * 64 + tok;
        f32x4 acc[2]; acc[0] = (f32x4){0.f, 0.f, 0.f, 0.f}; acc[1] = acc[0]; float ssq = 0.f;
        const bf16* xrow = X2 + t * D + 1024 * kh + 8 * kq; const float* nwp = nw + 1024 * kh + 8 * kq;
        unsigned char* qrow = XQ + t * D + 1024 * kh + 8 * kq;
#pragma unroll 8
        for (int ks = 0; ks < 32; ++ks) {
            const v4u xw = *(const GAS v4u*)(xrow + 32 * ks); const f32x4 xa = {bflo(xw.x), bfhi(xw.x), bflo(xw.y), bfhi(xw.y)}, xb = {bflo(xw.z), bfhi(xw.z), bflo(xw.w), bfhi(xw.w)};
            const f32x4 na = *(const GAS f32x4*)(nwp + 32 * ks), nb = *(const GAS f32x4*)(nwp + 32 * ks + 4);
            ssq += (xa.x * xa.x + xa.y * xa.y) + (xa.z * xa.z + xa.w * xa.w) + (xb.x * xb.x + xb.y * xb.y) + (xb.z * xb.z + xb.w * xb.w);
            const f32x4 ya = xa * na, yb = xb * nb;
            union { v4u u; bf16x8 v; } af; af.u.x = pk2(ya.x, ya.y); af.u.y = pk2(ya.z, ya.w); af.u.z = pk2(yb.x, yb.y); af.u.w = pk2(yb.z, yb.w);
            v2u qq; qq.x = pg8::pk_fp8x4(ya.x * XSCALE, ya.y * XSCALE, ya.z * XSCALE, ya.w * XSCALE); qq.y = pg8::pk_fp8x4(yb.x * XSCALE, yb.y * XSCALE, yb.z * XSCALE, yb.w * XSCALE);
            *(GAS v2u*)(qrow + 32 * ks) = qq;
            const int c = 128 * kh + 4 * ks + kq;
#pragma unroll
            for (int et = 0; et < 2; ++et) { const bf16x8 bfr = *(const LAS bf16x8*)(wt + (16 * et + r16) * 4096 + ((c ^ r16) << 4));
                acc[et] = __builtin_amdgcn_mfma_f32_16x16x32_bf16(af.v, bfr, acc[et], 0, 0, 0); }
        }
        ssq += __shfl_xor(ssq, 16); ssq += __shfl_xor(ssq, 32);
        if (kh == 1) {
#pragma unroll
            for (int et = 0; et < 2; ++et)
#pragma unroll
                for (int r = 0; r < 4; ++r) part[(16 * tg + 4 * kq + r) * 32 + 16 * et + r16] = acc[et][r];
            if (kq == 0) sq[tok] = ssq;
        }
        __syncthreads();
        if (kh == 0) {
            const float rstd = 1.f / sqrtf((ssq + sq[tok]) * (1.f / D) + EPS);
            if (kq == 0) { rs[tok] = rstd; RSTD[t] = rstd; }
            LDS_WAIT(); asm volatile("" ::: "memory");
#pragma unroll
            for (int et = 0; et < 2; ++et)
#pragma unroll
                for (int r = 0; r < 4; ++r) { const int tr = 16 * tg + 4 * kq + r, e = 16 * et + r16;
                    part[tr * 32 + e] = (acc[et][r] + part[tr * 32 + e]) * rs[tr] + br[e]; }
            LDS_WAIT(); asm volatile("" ::: "memory");
            if (lane < 16) { const int tk = 16 * tg + lane; const size_t tt = (size_t)blk * 64 + tk;
                float lg[32];
#pragma unroll
                for (int e = 0; e < 32; ++e) lg[e] = part[tk * 32 + e];
                float tv[4]; int te[4];
#pragma unroll
                for (int k = 0; k < 4; ++k) { float best = -3.0e38f; int bi = 0;
#pragma unroll
                    for (int e = 0; e < 32; ++e) { if (lg[e] > best) { best = lg[e]; bi = e; } }
                    tv[k] = best; te[k] = bi;
#pragma unroll
                    for (int e = 0; e < 32; ++e) lg[e] = (e == bi) ? -3.0e38f : lg[e]; }
                const float e1 = __expf(tv[1] - tv[0]), e2 = __expf(tv[2] - tv[0]), e3 = __expf(tv[3] - tv[0]), inv = 1.f / (1.f + e1 + e2 + e3);
                const float gk[4] = {inv, e1 * inv, e2 * inv, e3 * inv};
#pragma unroll
                for (int k = 0; k < 4; ++k) { TOPE[tt * 4 + k] = te[k]; GATE[tt * 4 + k] = gk[k]; le[tk * 4 + k] = te[k]; }
            }
        }
        __syncthreads();
        if (F.tid < 256) { const int me = le[F.tid]; int rk = 0;
#pragma unroll 8
            for (int q4 = 0; q4 < 64; ++q4) { const v4u e4 = *(const LAS v4u*)(le + 4 * q4); const int a0 = 4 * q4;
                rk += ((a0 < F.tid) & ((int)e4.x == me)) + ((a0 + 1 < F.tid) & ((int)e4.y == me)) + ((a0 + 2 < F.tid) & ((int)e4.z == me)) + ((a0 + 3 < F.tid) & ((int)e4.w == me)); }
            RANK[blk * 256 + F.tid] = rk; (void)lds_addi(lh + me, 1); }
        __syncthreads();
        if (F.tid < 32) HIST[blk * 32 + F.tid] = lh[F.tid];
        __syncthreads();
    }
}

__device__ __forceinline__ void p_route_a(Frame& F) {
    frame_ids(F);
    const float* LOG = (const float*)(F.ws + WS_LOG); int* TOPE = (int*)(F.ws + WS_TOPE); float* GATE = (float*)(F.ws + WS_GATE); int* RANK = (int*)(F.ws + WS_RANK);
    int* HIST = (int*)(F.ws + WS_CTL) + CW_HIST; const float* br = F.in[I_BR];
    LAS int* lh = (LAS int*)(F.lds + RING_OFF); LAS int* le = lh + 32;
    for (int blk = F.vcu; blk < T / 64; blk += F.G) {
        if (F.tid < 32) lh[F.tid] = 0;
        __syncthreads();
        if (F.tid < 64) { const int t = blk * 64 + F.tid;
            float lg[32];
#pragma unroll
            for (int e4 = 0; e4 < 8; ++e4) { const f32x4 v = *(const GAS f32x4*)(LOG + (size_t)t * 256 + 4 * e4), bb = *(const GAS f32x4*)(br + 4 * e4);
                lg[4 * e4] = v.x + bb.x; lg[4 * e4 + 1] = v.y + bb.y; lg[4 * e4 + 2] = v.z + bb.z; lg[4 * e4 + 3] = v.w + bb.w; }
            float tv[4]; int te[4];
#pragma unroll
            for (int k = 0; k < 4; ++k) { float best = -3.0e38f; int bi = 0;
#pragma unroll
                for (int e = 0; e < 32; ++e) { if (lg[e] > best) { best = lg[e]; bi = e; } }
                tv[k] = best; te[k] = bi;
#pragma unroll
                for (int e = 0; e < 32; ++e) lg[e] = (e == bi) ? -3.0e38f : lg[e]; }
            const float e1 = __expf(tv[1] - tv[0]), e2 = __expf(tv[2] - tv[0]), e3 = __expf(tv[3] - tv[0]), inv = 1.f / (1.f + e1 + e2 + e3);
            const float gk[4] = {inv, e1 * inv, e2 * inv, e3 * inv};
#pragma unroll
            for (int k = 0; k < 4; ++k) { TOPE[t * 4 + k] = te[k]; GATE[t * 4 + k] = gk[k]; le[F.tid * 4 + k] = te[k]; }
        }
        __syncthreads();
        if (F.tid < 256) { const int me = le[F.tid]; int rk = 0;
            for (int a = 0; a < F.tid; ++a) rk += (le[a] == me) ? 1 : 0;
            RANK[blk * 256 + F.tid] = rk; (void)lds_addi(lh + me, 1); }
        __syncthreads();
        if (F.tid < 32) HIST[blk * 32 + F.tid] = lh[F.tid];
        __syncthreads();
    }
}
__device__ __forceinline__ void p_route_b(Frame& F) {
    frame_ids(F);
    const int* TOPE = (const int*)(F.ws + WS_TOPE); const float* GATE = (const float*)(F.ws + WS_GATE); const int* RANK = (const int*)(F.ws + WS_RANK);
    int* DEST = (int*)(F.ws + WS_DEST); float* RGATE = (float*)(F.ws + WS_RGATE); float* RROW = (float*)(F.ws + WS_RROW); const float* RSTD = (const float*)(F.ws + WS_RSTD);
    const int* HIST = (const int*)(F.ws + WS_CTL) + CW_HIST; int* BLKE = (int*)(F.ws + WS_CTL) + CW_BLKE; int* NBLK = (int*)(F.ws + WS_CTL) + CW_NBLK;
    const unsigned char* XQ = (const unsigned char*)(F.ws + WS_XQ); unsigned char* XP = (unsigned char*)(F.ws + WS_XPERM);
    LAS int* cnt = (LAS int*)(F.lds + RING_OFF);
    LAS int* pst = cnt + 32; LAS int* pen = cnt + 64; LAS int* base = cnt + 96; LAS int* dl = cnt + 128; LAS int* part = cnt + 384; LAS int* hl = cnt + 896;
    for (int i = F.tid; i < (T / 64) * 32; i += NTHR) hl[i] = HIST[i];
    __syncthreads();
    { const int e = F.tid & 31, g = F.tid >> 5; int s = 0;
#pragma unroll
        for (int q = 0; q < 16; ++q) s += hl[(16 * g + q) * 32 + e];
        part[g * 32 + e] = s; }
    __syncthreads();
    if (F.tid < 32) { int s = 0;
#pragma unroll
        for (int g = 0; g < 16; ++g) s += part[g * 32 + F.tid];
        cnt[F.tid] = s; }
    __syncthreads();
    if (F.tid == 0) { int run = 0; for (int e = 0; e < 32; ++e) { const int pd = (cnt[e] + MOEB - 1) / MOEB * MOEB; pst[e] = run; run += pd; pen[e] = run; } }
    __syncthreads();
    if (F.vcu == 0) {
        if (F.tid == 0) NBLK[0] = pen[31] / MOEB;
        if (F.tid < NBLK_MAX) { int e = 0; for (int q = 0; q < 32; ++q) e += (pen[q] <= F.tid * MOEB) ? 1 : 0; BLKE[F.tid] = e < 31 ? e : 31; }
    }
    for (int e = F.vcu; e < NE; e += F.G) {
        const int r0 = pst[e] + cnt[e], r1 = pen[e];
        for (int r = r0 + F.wave; r < r1; r += NWAVES) { if (F.lane == 0) { RGATE[r] = 0.f; RROW[r] = 0.f; }
            GAS v4u* o = (GAS v4u*)(XP + (size_t)r * D) + F.lane;
#pragma unroll
            for (int j = 0; j < 2; ++j) o[64 * j] = (v4u){0u, 0u, 0u, 0u}; }
    }
    for (int blk = F.vcu; blk < T / 64; blk += F.G) {
        __syncthreads();
        { const int e = F.tid & 31, g = F.tid >> 5; int s = 0;
#pragma unroll
            for (int q = 0; q < 16; ++q) s += (16 * g + q < blk) ? hl[(16 * g + q) * 32 + e] : 0;
            part[g * 32 + e] = s; }
        __syncthreads();
        if (F.tid < 32) { int s = pst[F.tid];
#pragma unroll
            for (int g = 0; g < 16; ++g) s += part[g * 32 + F.tid];
            base[F.tid] = s; }
        __syncthreads();
        if (F.tid < 256) { const int a = blk * 256 + F.tid; const int d = base[TOPE[a]] + RANK[a]; DEST[a] = d; RGATE[d] = GATE[a]; RROW[d] = RSTD[a >> 2]; dl[F.tid] = d; }
        __syncthreads();
        { v4u rr[8][2];
#pragma unroll
            for (int q = 0; q < 8; ++q) { const int t = blk * 64 + F.wave + 8 * q; const GAS v4u* s = (const GAS v4u*)(XQ + (size_t)t * D) + F.lane; rr[q][0] = s[0]; rr[q][1] = s[64]; }
#pragma unroll
            for (int q = 0; q < 8; ++q)
#pragma unroll
                for (int k = 0; k < 4; ++k) { const int a = 4 * (F.wave + 8 * q) + k; GAS v4u* o = (GAS v4u*)(XP + (size_t)dl[a] * D) + F.lane; o[0] = rr[q][0]; o[64] = rr[q][1]; } }
    }
}
__device__ __forceinline__ void p_combine(Frame& F) {
    frame_ids(F);
    const bf16* X2 = (const bf16*)(F.ws + WS_X2); const unsigned char* YR = (const unsigned char*)(F.ws + WS_YR); const int* DEST = (const int*)(F.ws + WS_DEST);
    const float* fw = F.in[I_FNW];
    const int gw = F.vcu * NWAVES + F.wave, NGW = F.G * NWAVES;
    for (int m = gw; m < T; m += NGW) {
        const GAS v2u* xr = (const GAS v2u*)(X2 + (size_t)m * D) + F.lane;
        f32x4 v[8];
#pragma unroll
        for (int j = 0; j < 8; ++j) { const v2u xw = xr[64 * j]; v[j] = (f32x4){bflo(xw.x), bfhi(xw.x), bflo(xw.y), bfhi(xw.y)}; }
#pragma unroll
        for (int k = 0; k < 4; ++k) { const GAS unsigned* yr = (const GAS unsigned*)(YR + (size_t)DEST[m * 4 + k] * D) + F.lane;
#pragma unroll
            for (int j = 0; j < 8; ++j) { const unsigned y = yr[64 * j]; const f32x2 lo = __builtin_amdgcn_cvt_pk_f32_fp8((int)y, false), hi = __builtin_amdgcn_cvt_pk_f32_fp8((int)y, true);
                v[j].x += lo.x * (1.f / YSCALE); v[j].y += lo.y * (1.f / YSCALE); v[j].z += hi.x * (1.f / YSCALE); v[j].w += hi.y * (1.f / YSCALE); } }
        float s = 0.f;
#pragma unroll
        for (int j = 0; j < 8; ++j) s += (v[j].x * v[j].x + v[j].y * v[j].y) + (v[j].z * v[j].z + v[j].w * v[j].w);
        const float rstd = 1.f / sqrtf(wave_sum(s) * (1.f / D) + EPS);
        const GAS f32x4* wr = (const GAS f32x4*)fw + F.lane; GAS f32x4* o = (GAS f32x4*)(F.out + (size_t)m * D) + F.lane;
#pragma unroll
        for (int j = 0; j < 8; ++j) { const f32x4 ww = wr[64 * j]; f32x4 ov = (f32x4){v[j].x * rstd * ww.x, v[j].y * rstd * ww.y, v[j].z * rstd * ww.z, v[j].w * rstd * ww.w};
#ifdef MK_SANITIZE
#pragma unroll
            for (int q = 0; q < 4; ++q) if (!(fabsf(ov[q]) < 1e30f)) ov[q] = 100.f;
#endif
            __builtin_nontemporal_store(ov, o + 64 * j); }
    }
}


constexpr int NPHASE = 20;
struct Args { const float* in[25]; float* out; unsigned char* ws; int ph_lo, ph_hi; };
__global__ void __launch_bounds__(NTHR, 2) mk_fwd(Args args) {
    extern __shared__ __attribute__((aligned(16))) unsigned char lds[];
    Frame F;
    F.lds = (LAS unsigned char*)lds;
    F.wave = __builtin_amdgcn_readfirstlane((int)threadIdx.x >> 6); frame_ids(F);
    F.G = gridDim.x; { const int bx = blockIdx.x; F.vcu = (F.G % 8 == 0) ? (bx % 8) * (F.G / 8) + bx / 8 : bx; }
    F.ws = args.ws; F.out = args.out;
#pragma unroll
    for (int i = 0; i < 25; ++i) F.in[i] = args.in[i];
    for (int u = F.tid; u < (LDS_BYTES - LDSCTL_OFF) / 4; u += NTHR) ((LAS unsigned*)(F.lds + LDSCTL_OFF))[u] = 0u;
    __syncthreads();
    const int lo = args.ph_lo, hi = args.ph_hi;
    unsigned* ctl = (unsigned*)(F.ws + WS_CTL);
    XcdBarrier bar; bar.bar = ctl + CW_BAR; bar.x = 0; bar.st = nullptr;
    if (hi - lo > 1) bar = xcd_barrier_post(ctl + CW_BAR, (volatile LAS unsigned*)(F.lds + MISC_OFF) + 8, F.tid);
#define IN(k) (lo <= (k) && (k) < hi)
#define SEAM(k) do { if (IN(k) && IN((k) + 1)) { frame_ids(F); xcd_barrier(bar, F.tid); } } while (0)
    LAS unsigned char* ring = F.lds + RING_OFF;
    const int cid = (int)blockIdx.x;
    const int kj = cid >> 3, KOFF_ST = (F.G == 256) ? 2 * (((kj & 7) + (kj >> 3)) & 3) : 0, KOFF_MOE = (F.G == 256) ? 2 * (((kj >> 2) + (kj & 3)) & 3) : 0;

    if (IN(0)) { p0_prologue(F); }
#if (PROBE_MASK >> 0) & 1
    if (IN(0)) { frame_ids(F); VM_WAIT(); __syncthreads(); }
    if (IN(0)) { p0_prologue(F); }
#endif
 SEAM(0);
    if (IN(1)) {
        { pg8::Gemm g{(const bf16*)(F.ws + WS_H), (const bf16*)(F.ws + WS_WIN), T, 3072, D}; pg8::InProjOrder<0> S; S.init(T, 3072, F.G, cid);
          pg8::EpiAct E{(bf16*)(F.ws + WS_PROJ), NPROJ, 12, 16, 28, 44, 16, 20, 0.125f * 1.4426950408889634f, 0, nullptr, 0.f, 0.f, 1.f};
          pg8::gemm_phase<pg8::EpiAct, pg8::InProjOrder<0>, true, true>(ring, g, S, E, F.wave, KOFF_ST); }
        { pg8::Gemm g{(const bf16*)(F.ws + WS_H8), (const bf16*)(F.ws + WS_WIN8), T, 8192, D / 2}; pg8::InProjOrder<1> S; S.init(T, 8192, F.G, cid);
          pg8::EpiAct E{(bf16*)(F.ws + WS_PROJ), NPROJ, 12, 16, 28, 44, 16, 20, 0.125f * 1.4426950408889634f, 0, nullptr, 0.f, 0.f, 1.f / (HSCALE * WSCALE)};
          pg8::gemm_phase<pg8::EpiAct, pg8::InProjOrder<1>, true, true, true>(ring, g, S, E, F.wave, KOFF_ST); }
    }
#if (PROBE_MASK >> 1) & 1
    if (IN(1)) { frame_ids(F); VM_WAIT(); __syncthreads(); }
    if (IN(1)) {
        { pg8::Gemm g{(const bf16*)(F.ws + WS_H), (const bf16*)(F.ws + WS_WIN), T, 3072, D}; pg8::InProjOrder<0> S; S.init(T, 3072, F.G, cid);
          pg8::EpiAct E{(bf16*)(F.ws + WS_PROJ), NPROJ, 12, 16, 28, 44, 16, 20, 0.125f * 1.4426950408889634f, 1, nullptr, 0.f, 0.f, 1.f};
          pg8::gemm_phase<pg8::EpiAct, pg8::InProjOrder<0>, true, true>(ring, g, S, E, F.wave, KOFF_ST); }
        { pg8::Gemm g{(const bf16*)(F.ws + WS_H8), (const bf16*)(F.ws + WS_WIN8), T, 8192, D / 2}; pg8::InProjOrder<1> S; S.init(T, 8192, F.G, cid);
          pg8::EpiAct E{(bf16*)(F.ws + WS_PROJ), NPROJ, 0, 0, 0, 0, 16, 20, 0.125f * 1.4426950408889634f, 1, nullptr, 0.f, 0.f, 1.f / (HSCALE * WSCALE)};
          pg8::gemm_phase<pg8::EpiAct, pg8::InProjOrder<1>, true, true, true>(ring, g, S, E, F.wave, KOFF_ST); }
    }
#endif
 SEAM(1);
    if (IN(2)) { p_conv(F); }
#if (PROBE_MASK >> 2) & 1
    if (IN(2)) { frame_ids(F); VM_WAIT(); __syncthreads(); }
    if (IN(2)) { p_conv(F); }
#endif
 SEAM(2);
    if (IN(3)) { p_local_band(F); }
#if (PROBE_MASK >> 19) & 1
    if (IN(3)) { p_mlstm_local(F); }
#endif
#if (PROBE_MASK >> 20) & 1
    if (IN(3)) { p_band_attn(F); }
#endif
#if (PROBE_MASK >> 3) & 1
    if (IN(3)) { frame_ids(F); VM_WAIT(); __syncthreads(); }
    if (IN(3)) { p_mlstm_local(F); p_band_attn(F); }
#endif
 SEAM(3);
    if (IN(4)) { p_mlstm_scan(F); }
#if (PROBE_MASK >> 4) & 1
    if (IN(4)) { frame_ids(F); VM_WAIT(); __syncthreads(); }
    if (IN(4)) { p_mlstm_scan(F); }
#endif
 SEAM(4);
    if (IN(5)) { p_mlstm_out(F); }
#if (PROBE_MASK >> 5) & 1
    if (IN(5)) { frame_ids(F); VM_WAIT(); __syncthreads(); }
    if (IN(5)) { p_mlstm_out(F); }
#endif
 SEAM(5);
    if (IN(6)) { pg8::Gemm g{(const bf16*)(F.ws + WS_HM), (const bf16*)(F.ws + WS_WBM), T, D, 2048}; pg8::StaticOrder S; S.init(T, D, F.G, cid);
        pg8::EpiMerge E{(const bf16*)(F.ws + WS_PROJ), NPROJ, PG_M, PG_A, (bf16*)(F.ws + WS_MRG), D};
        pg8::gemm_phase<pg8::EpiMerge, pg8::StaticOrder, true, true>(ring, g, S, E, F.wave); }
#if (PROBE_MASK >> 6) & 1
    if (IN(6)) { frame_ids(F); VM_WAIT(); __syncthreads(); }
    if (IN(6)) { pg8::Gemm g{(const bf16*)(F.ws + WS_HM), (const bf16*)(F.ws + WS_WBM), T, D, 2048}; pg8::StaticOrder S; S.init(T, D, F.G, cid);
        pg8::EpiMerge E{(const bf16*)(F.ws + WS_PROJ), NPROJ, PG_M, PG_A, (bf16*)(F.ws + WS_MRG), D};
        pg8::gemm_phase<pg8::EpiMerge, pg8::StaticOrder, true, true>(ring, g, S, E, F.wave); }
#endif
 SEAM(6);
    if (IN(7)) { pg8::Gemm g{(const bf16*)(F.ws + WS_MRG), (const bf16*)(F.ws + WS_WOUT), T, D, D}; pg8::StaticOrder S; S.init(T, D, F.G, cid);
        pg8::EpiResB<false> E{(bf16*)(F.ws + WS_XN1), D, (const void*)F.in[I_X], (float*)(F.ws + WS_SSQ1)};
        pg8::gemm_phase<pg8::EpiResB<false>, pg8::StaticOrder, true, true>(ring, g, S, E, F.wave, KOFF_ST); }
#if (PROBE_MASK >> 7) & 1
    if (IN(7)) { frame_ids(F); VM_WAIT(); __syncthreads(); }
    if (IN(7)) { pg8::Gemm g{(const bf16*)(F.ws + WS_MRG), (const bf16*)(F.ws + WS_WOUT), T, D, D}; pg8::StaticOrder S; S.init(T, D, F.G, cid);
        pg8::EpiResB<false> E{(bf16*)(F.ws + WS_XN1), D, (const void*)F.in[I_X], (float*)(F.ws + WS_SSQ1)};
        pg8::gemm_phase<pg8::EpiResB<false>, pg8::StaticOrder, true, true>(ring, g, S, E, F.wave, KOFF_ST); }
#endif
 SEAM(7);
    if (IN(9)) {
        if (cid < 128 || F.G != 256) { pg8::Gemm g{(const bf16*)(F.ws + WS_XN1), (const bf16*)(F.ws + WS_WQ), T, XW, D}; pg8::StaticOrder S; S.init(T, XW, F.G, cid);
            pg8::EpiAct E{(bf16*)(F.ws + WS_QX), XW, 0, 0, 0, 0, 0, 2, 0.08838834764831845f * 1.4426950408889634f, 0, (const float*)(F.ws + WS_SSQ1), 1.f / D, EPS, 1.f};
            pg8::gemm_phase<pg8::EpiAct, pg8::StaticOrder, true, true>(ring, g, S, E, F.wave, KOFF_ST); }
        if (cid >= 128 || F.G != 256) {
            pg8::Gemm g{(const bf16*)(F.ws + WS_MEMN), (const bf16*)(F.ws + WS_WKV), BATCH * NMEM, 2 * XW, D}; pg8::StaticOrder S; S.init(BATCH * NMEM, 2 * XW, F.G == 256 ? 128 : F.G, F.G == 256 ? cid - 128 : cid);
            pg8::EpiAct E{(bf16*)(F.ws + WS_KVX), 2 * XW, 0, 0, 0, 0, 0, 0, 1.f, 0, nullptr, 0.f, 0.f, 1.f};
            pg8::gemm_phase<pg8::EpiAct, pg8::StaticOrder, true, true>(ring, g, S, E, F.wave, KOFF_ST); }
        if (F.G == 256) { if (cid >= 256 - LATE_WG) { frame_ids(F); weight_tiles(F, NTILES - NT_LATE, NTILES, cid - (256 - LATE_WG), LATE_WG); } }
        else { frame_ids(F); __syncthreads(); weight_tiles(F, NTILES - NT_LATE, NTILES, F.vcu, F.G); }
    }
#if (PROBE_MASK >> 9) & 1
    if (IN(9)) { frame_ids(F); VM_WAIT(); __syncthreads(); }
    if (IN(9)) {
        if (cid < 128 || F.G != 256) { pg8::Gemm g{(const bf16*)(F.ws + WS_XN1), (const bf16*)(F.ws + WS_WQ), T, XW, D}; pg8::StaticOrder S; S.init(T, XW, F.G, cid);
            pg8::EpiAct E{(bf16*)(F.ws + WS_QX), XW, 0, 0, 0, 0, 0, 2, 0.08838834764831845f * 1.4426950408889634f, 0, (const float*)(F.ws + WS_SSQ1), 1.f / D, EPS, 1.f};
            pg8::gemm_phase<pg8::EpiAct, pg8::StaticOrder, true, true>(ring, g, S, E, F.wave, KOFF_ST); }
        if (cid >= 128 || F.G != 256) {
            pg8::Gemm g{(const bf16*)(F.ws + WS_MEMN), (const bf16*)(F.ws + WS_WKV), BATCH * NMEM, 2 * XW, D}; pg8::StaticOrder S; S.init(BATCH * NMEM, 2 * XW, F.G == 256 ? 128 : F.G, F.G == 256 ? cid - 128 : cid);
            pg8::EpiAct E{(bf16*)(F.ws + WS_KVX), 2 * XW, 0, 0, 0, 0, 0, 0, 1.f, 0, nullptr, 0.f, 0.f, 1.f};
            pg8::gemm_phase<pg8::EpiAct, pg8::StaticOrder, true, true>(ring, g, S, E, F.wave, KOFF_ST); }
        if (F.G == 256) { if (cid >= 256 - LATE_WG) { frame_ids(F); weight_tiles(F, NTILES - NT_LATE, NTILES, cid - (256 - LATE_WG), LATE_WG); } }
        else { frame_ids(F); __syncthreads(); weight_tiles(F, NTILES - NT_LATE, NTILES, F.vcu, F.G); }
    }
#endif
 SEAM(9);
    if (IN(10)) { p_cross_attn(F); }
#if (PROBE_MASK >> 10) & 1
    if (IN(10)) { frame_ids(F); VM_WAIT(); __syncthreads(); }
    if (IN(10)) { p_cross_attn(F); }
#endif
 SEAM(10);
    if (IN(11)) { pg8::Gemm g{(const bf16*)(F.ws + WS_OX), (const bf16*)(F.ws + WS_WO), T, D, XW}; pg8::StaticOrder S; S.init(T, D, F.G, cid);
        pg8::EpiResB<true> E{(bf16*)(F.ws + WS_X2), D, (const void*)(F.ws + WS_XN1), nullptr};
        pg8::gemm_phase<pg8::EpiResB<true>, pg8::StaticOrder, true, true>(ring, g, S, E, F.wave, KOFF_ST); }
#if (PROBE_MASK >> 11) & 1
    if (IN(11)) { frame_ids(F); VM_WAIT(); __syncthreads(); }
    if (IN(11)) { pg8::Gemm g{(const bf16*)(F.ws + WS_OX), (const bf16*)(F.ws + WS_WO), T, D, XW}; pg8::StaticOrder S; S.init(T, D, F.G, cid);
        pg8::EpiResB<true> E{(bf16*)(F.ws + WS_X2), D, (const void*)(F.ws + WS_XN1), nullptr};
        pg8::gemm_phase<pg8::EpiResB<true>, pg8::StaticOrder, true, true>(ring, g, S, E, F.wave, KOFF_ST); }
#endif
 SEAM(11);
    if (IN(12)) { p_norm_route(F); }
#if (PROBE_MASK >> 12) & 1
    if (IN(12)) { frame_ids(F); VM_WAIT(); __syncthreads(); }
    if (IN(12)) { p_norm_route(F); }
#endif
    do { if (IN(12) && IN(15)) { frame_ids(F); xcd_barrier(bar, F.tid); } } while (0);
    if (IN(15)) { p_route_b(F); }
#if (PROBE_MASK >> 15) & 1
    if (IN(15)) { frame_ids(F); VM_WAIT(); __syncthreads(); }
    if (IN(15)) { p_route_b(F); }
#endif
 SEAM(15);
    if (IN(16)) { const int* BLKE = (const int*)ctl + CW_BLKE; const int nblk = ((const int*)ctl)[CW_NBLK];
        pg8::Gemm g{(const bf16*)(F.ws + WS_XPERM), (const bf16*)(F.ws + WS_WGU), NROWS_MAX, 2 * DFF, D / 2};
        pg8::MoeOrder S{2 * DFF / 256, F.G, cid, nblk, BLKE, (size_t)2 * DFF * D};
        pg8::EpiSwiGLU E{(unsigned char*)(F.ws + WS_ACT), DFF, F.in[I_BGU], BLKE, DFF, 1.f / (XSCALE * WSCALE), ASCALE, (const float*)(F.ws + WS_RROW)};
        pg8::gemm_phase<pg8::EpiSwiGLU, pg8::MoeOrder, true, true, true>(ring, g, S, E, F.wave, KOFF_MOE); }
#if (PROBE_MASK >> 16) & 1
    if (IN(16)) { frame_ids(F); VM_WAIT(); __syncthreads(); }
    if (IN(16)) { const int* BLKE = (const int*)ctl + CW_BLKE; const int nblk = ((const int*)ctl)[CW_NBLK];
        pg8::Gemm g{(const bf16*)(F.ws + WS_XPERM), (const bf16*)(F.ws + WS_WGU), NROWS_MAX, 2 * DFF, D / 2};
        pg8::MoeOrder S{2 * DFF / 256, F.G, cid, nblk, BLKE, (size_t)2 * DFF * D};
        pg8::EpiSwiGLU E{(unsigned char*)(F.ws + WS_ACT), DFF, F.in[I_BGU], BLKE, DFF, 1.f / (XSCALE * WSCALE), ASCALE, (const float*)(F.ws + WS_RROW)};
        pg8::gemm_phase<pg8::EpiSwiGLU, pg8::MoeOrder, true, true, true>(ring, g, S, E, F.wave, KOFF_MOE); }
#endif
 SEAM(16);
    if (IN(17)) { const int* BLKE = (const int*)ctl + CW_BLKE; const int nblk = ((const int*)ctl)[CW_NBLK];
        pg8::Gemm g{(const bf16*)(F.ws + WS_ACT), (const bf16*)(F.ws + WS_WDN), NROWS_MAX, D, DFF / 2};
        pg8::MoeOrder S{D / 256, F.G, cid, nblk, BLKE, (size_t)D * DFF};
        pg8::EpiDown E{(unsigned char*)(F.ws + WS_YR), D, F.in[I_BDN], BLKE, (const float*)(F.ws + WS_RGATE), 1.f / (ASCALE * WSCALE), YSCALE};
        pg8::gemm_phase<pg8::EpiDown, pg8::MoeOrder, true, true, true>(ring, g, S, E, F.wave, KOFF_MOE); }
#if (PROBE_MASK >> 17) & 1
    if (IN(17)) { frame_ids(F); VM_WAIT(); __syncthreads(); }
    if (IN(17)) { const int* BLKE = (const int*)ctl + CW_BLKE; const int nblk = ((const int*)ctl)[CW_NBLK];
        pg8::Gemm g{(const bf16*)(F.ws + WS_ACT), (const bf16*)(F.ws + WS_WDN), NROWS_MAX, D, DFF / 2};
        pg8::MoeOrder S{D / 256, F.G, cid, nblk, BLKE, (size_t)D * DFF};
        pg8::EpiDown E{(unsigned char*)(F.ws + WS_YR), D, F.in[I_BDN], BLKE, (const float*)(F.ws + WS_RGATE), 1.f / (ASCALE * WSCALE), YSCALE};
        pg8::gemm_phase<pg8::EpiDown, pg8::MoeOrder, true, true, true>(ring, g, S, E, F.wave, KOFF_MOE); }
#endif
 SEAM(17);
    if (IN(18)) { p_combine(F); }
#if (PROBE_MASK >> 18) & 1
    if (IN(18)) { frame_ids(F); VM_WAIT(); __syncthreads(); }
    if (IN(18)) { p_combine(F); }
#endif

#undef IN
#undef SEAM
}

#ifndef MK_SPLIT
#define MK_SPLIT 0
#endif
extern "C" void kernel_launch(void* const* d_in, const int* in_sizes, int n_in, void* d_out, int out_size, void* d_ws, size_t ws_size, hipStream_t stream) {
    static int grid = 0;
    if (grid == 0) {
        if (n_in != 25 || in_sizes[0] != T * D || out_size != T * D || ws_size < WS_END) { fprintf(stderr, "kernel_launch: unexpected shapes (n_in %d in0 %d out %d ws %zu need %zu)\n", n_in, n_in > 0 ? in_sizes[0] : -1, out_size, ws_size, (size_t)WS_END); grid = -1; return; }
        int dev = 0, cus = 0, per_cu = 0;
        if (hipGetDevice(&dev) != hipSuccess || hipDeviceGetAttribute(&cus, hipDeviceAttributeMultiprocessorCount, dev) != hipSuccess) { grid = -1; return; }
        if (hipFuncSetAttribute((const void*)mk_fwd, hipFuncAttributeMaxDynamicSharedMemorySize, LDS_BYTES) != hipSuccess) { fprintf(stderr, "kernel_launch: hipFuncSetAttribute failed\n"); grid = -1; return; }
        if (hipOccupancyMaxActiveBlocksPerMultiprocessor(&per_cu, (const void*)mk_fwd, NTHR, LDS_BYTES) != hipSuccess || per_cu < 1) fprintf(stderr, "kernel_launch: occupancy query reports %d\n", per_cu);
        (void)hipGetLastError();
        grid = cus;
    }
    if (grid < 0) return;
    (void)hipMemsetAsync((char*)d_ws + WS_CTL, 0, CTL_ZERO_BYTES, stream);
    Args a{};
    for (int i = 0; i < 25; ++i) a.in[i] = (const float*)d_in[i];
    a.out = (float*)d_out; a.ws = (unsigned char*)d_ws;
#if MK_SPLIT
    for (int p = 0; p < 19; ++p) { a.ph_lo = p; a.ph_hi = p + 1; hipLaunchKernelGGL(mk_fwd, dim3(grid), dim3(NTHR), LDS_BYTES, stream, a); }
#else
    a.ph_lo = 0; a.ph_hi = 19; hipLaunchKernelGGL(mk_fwd, dim3(grid), dim3(NTHR), LDS_BYTES, stream, a);
#endif
}
```

```cpp
#include <hip/hip_runtime.h>
#include <cstdio>
#include <cstdint>
namespace pg8 {
#define PG8_LAS __attribute__((address_space(3)))
typedef unsigned short bf16_t;
typedef short bf16x8 __attribute__((ext_vector_type(8)));
typedef float f32x4 __attribute__((ext_vector_type(4)));
typedef unsigned u32x4 __attribute__((ext_vector_type(4)));
constexpr int BM = 256, BK = 64, HALF = 128, HTB = HALF * BK * 2  , STAGE_BYTES = 8 * HTB, NXCD = 8, WGM = 8;

__host__ __device__ __forceinline__ int lds_byte(int r, int c) { const int st = (r >> 4) * 2 + (c >> 5), rr = r & 15, cc = c & 31, ob = rr * 64 + cc * 2; return st * 1024 + (ob ^ (((ob >> 9) & 1) << 5)); }
__host__ __device__ __forceinline__ void stage_rc(int b, int& R, int& C) { const int st = b / 1024, sb = b % 1024, swz = sb ^ (((sb >> 9) & 1) << 5); R = (st >> 1) * 16 + swz / 64; C = (st & 1) * 32 + (swz % 64) / 2; }
__host__ __device__ __forceinline__ int perm32(int rho) { const int n = rho >> 4, i = rho & 15; return 8 * (i >> 2) + 4 * n + (i & 3); }

struct Unit { int pm, pn; };
struct Gemm { const bf16_t* A; const bf16_t* Bt; int M, N, K; };

struct StaticOrder {
    int nM, nN, nwg, G, c;
    __host__ __device__ void init(int M, int N, int G_, int c_) { nM = M / BM; nN = N / BM; nwg = nM * nN; G = G_; c = c_; }
    __host__ __device__ bool next(int i, Unit& u) const {
        const long L = (long)i * G + c; if (L >= nwg) return false;
        int wgid = (int)L; { const int q = nwg / NXCD, r = nwg % NXCD, xcd = wgid % NXCD, off = wgid / NXCD; wgid = (xcd < r ? xcd * (q + 1) : r * (q + 1) + (xcd - r) * q) + off; }
        const int nig = WGM * nN, gid = wgid / nig, fm = gid * WGM, gsz = (nM - fm) < WGM ? (nM - fm) : WGM;
        u.pm = fm + ((wgid % nig) % gsz); u.pn = (wgid % nig) / gsz; return true;
    }
    __device__ __forceinline__ const char* a_base(const Gemm& g, const Unit& u) const { return (const char*)g.A + (size_t)u.pm * ((size_t)BM * g.K * 2); }
    __device__ __forceinline__ const char* b_base(const Gemm& g, const Unit& u) const { return (const char*)g.Bt + (size_t)u.pn * ((size_t)BM * g.K * 2); }
    __device__ __forceinline__ void a_ready(const Unit&) const {}
    __device__ __forceinline__ void done(const Unit&) const {}
};


template <int MODE> struct InProjOrder : StaticOrder {
    __device__ __forceinline__ bool next(int i, Unit& u) const { if (!StaticOrder::next(i, u)) return false;
        const int l = u.pn; u.pn = (MODE == 0) ? l : (12 + l); return true; }
    __device__ __forceinline__ const char* b_base(const Gemm& g, const Unit& u) const {
        const int t = (MODE == 0) ? u.pn : (u.pn - 12); return (const char*)g.Bt + (size_t)t * ((size_t)BM * g.K * 2); }
};

struct MoeOrder {
    int nN, G, c, nblk; const int* block_e; size_t bstride;
    __device__ __forceinline__ bool next(int i, Unit& u) const {
        if (G == 256 && (nN == 16 || nN == 8)) {
            const int xc = nN / 4, rpr = (8 / xc) * 8, x = c & 7, j = c >> 3;
            u.pm = i * rpr + (x / xc) * 8 + (j >> 2); u.pn = (x % xc) * 4 + (j & 3);
            if (i * rpr >= nblk) return false;
            return u.pm < nblk;
        }
        const long L = (long)i * G + c; if (L >= (long)nblk * nN) return false;
        u.pm = (int)(L / nN); u.pn = (int)(L % nN); return true;
    }
    __device__ __forceinline__ const char* a_base(const Gemm& g, const Unit& u) const { return (const char*)g.A + (size_t)u.pm * ((size_t)BM * g.K * 2); }
    __device__ __forceinline__ const char* b_base(const Gemm& g, const Unit& u) const { return (const char*)g.Bt + (size_t)block_e[u.pm] * bstride + (size_t)u.pn * ((size_t)BM * g.K * 2); }
    __device__ __forceinline__ void a_ready(const Unit&) const {}
    __device__ __forceinline__ void done(const Unit&) const {}
};

typedef unsigned u32x2 __attribute__((ext_vector_type(2)));
typedef int v8i_t __attribute__((ext_vector_type(8)));
typedef int v4i_t __attribute__((ext_vector_type(4)));
__device__ __forceinline__ v8i_t cat8(bf16x8 lo, bf16x8 hi) { const v4i_t a = __builtin_bit_cast(v4i_t, lo), b = __builtin_bit_cast(v4i_t, hi); return __builtin_shufflevector(a, b, 0, 1, 2, 3, 4, 5, 6, 7); }
__device__ __forceinline__ unsigned pk_fp8x4(float a, float b, float c, float d) {
    a = __builtin_amdgcn_fmed3f(a, -448.f, 448.f); b = __builtin_amdgcn_fmed3f(b, -448.f, 448.f); c = __builtin_amdgcn_fmed3f(c, -448.f, 448.f); d = __builtin_amdgcn_fmed3f(d, -448.f, 448.f);
    int w = 0; w = __builtin_amdgcn_cvt_pk_fp8_f32(a, b, w, false); w = __builtin_amdgcn_cvt_pk_fp8_f32(c, d, w, true); return (unsigned)w; }
typedef __bf16 bf2_t __attribute__((ext_vector_type(2)));
typedef float f32x2_t __attribute__((ext_vector_type(2)));
__device__ __forceinline__ unsigned cvt_pk_bf16_c(float lo, float hi) { const f32x2_t v = {lo, hi}; const bf2_t r = __builtin_convertvector(v, bf2_t); return __builtin_bit_cast(unsigned, r); }
__device__ __forceinline__ unsigned cvt_pk_bf16(float lo, float hi) { unsigned r; asm volatile("v_cvt_pk_bf16_f32 %0, %1, %2" : "=v"(r) : "v"(lo), "v"(hi)); return r; }
__device__ __forceinline__ float bf_lo(unsigned w) { return __builtin_bit_cast(float, w << 16); }
__device__ __forceinline__ float bf_hi(unsigned w) { return __builtin_bit_cast(float, w & 0xffff0000u); }
__device__ __forceinline__ float sigmoidf_(float x) { return __builtin_amdgcn_rcpf(1.f + __expf(-x)); }

struct EpiAct {
    static constexpr bool PERM = true, AFTER_DRAIN = false; static constexpr int MIDK = 0;
    bf16_t* O; int ldc; int s1lo, s1hi, s2lo, s2hi, clo, chi; float sc; int nostore; const float* ssq; float inv_n, eps; float gsc;
    __device__ __forceinline__ void operator()(const f32x4 (&acc)[2][2][4][2], const Unit& u, int wr, int wc, int fr, int fq) const {
        const int row0 = u.pm * BM + wr * 64 + fr, col0 = u.pn * BM + wc * 32 + 8 * fq;
        const bool sg = (u.pn >= s1lo && u.pn < s1hi) || (u.pn >= s2lo && u.pn < s2hi);
        const float s = (sg ? 1.f : gsc) * ((u.pn >= clo && u.pn < chi) ? sc : 1.f);
        float rscv[2][4];
#pragma unroll
        for (int ai = 0; ai < 2; ++ai)
#pragma unroll
            for (int m = 0; m < 4; ++m) { float rsc = s;
                if (ssq) { const f32x4* sp = (const f32x4*)(ssq + (size_t)(row0 + ai * HALF + m * 16) * 32); float t = 0.f;
#pragma unroll
                    for (int q = 0; q < 8; ++q) { const f32x4 p4 = sp[q]; t += p4[0]; t += p4[1]; t += p4[2]; t += p4[3]; }
                    rsc = s * (1.f / sqrtf(t * inv_n + eps)); }
                rscv[ai][m] = rsc; }
#pragma unroll
        for (int ai = 0; ai < 2; ++ai)
#pragma unroll
            for (int m = 0; m < 4; ++m) { bf16_t* rowp = O + (size_t)(row0 + ai * HALF + m * 16) * ldc + col0;
                const float rsc = rscv[ai][m];
#pragma unroll
                for (int bj = 0; bj < 2; ++bj) { f32x4 v0 = acc[ai][bj][m][0], v1 = acc[ai][bj][m][1];
                    if (sg) {
#pragma unroll
                        for (int j = 0; j < 4; ++j) { v0[j] = sigmoidf_(v0[j] * gsc); v1[j] = sigmoidf_(v1[j] * gsc); } }
                    v0 = v0 * rsc; v1 = v1 * rsc;
                    u32x4 w; w.x = cvt_pk_bf16(v0[0], v0[1]); w.y = cvt_pk_bf16(v0[2], v0[3]); w.z = cvt_pk_bf16(v1[0], v1[1]); w.w = cvt_pk_bf16(v1[2], v1[3]);
                    if (!nostore) *(u32x4*)(rowp + bj * HALF) = w; } }
    }
};

template <bool ADD> struct EpiGate {
    static constexpr bool PERM = true, AFTER_DRAIN = false; static constexpr int MIDK = 0;
    const bf16_t* Gt; int ldg, goff; const bf16_t* Tin; bf16_t* O; int ldo;
    __device__ __forceinline__ void operator()(const f32x4 (&acc)[2][2][4][2], const Unit& u, int wr, int wc, int fr, int fq) const {
        const int row0 = u.pm * BM + wr * 64 + fr, col0 = u.pn * BM + wc * 32 + 8 * fq;
#pragma unroll
        for (int ai = 0; ai < 2; ++ai)
#pragma unroll
            for (int m = 0; m < 4; ++m) { const size_t row = (size_t)(row0 + ai * HALF + m * 16);
#pragma unroll
                for (int bj = 0; bj < 2; ++bj) { const int col = col0 + bj * HALF;
                    const u32x4 gw = *(const u32x4*)(Gt + row * ldg + goff + col);
                    f32x4 v0 = acc[ai][bj][m][0], v1 = acc[ai][bj][m][1];
                    v0[0] *= bf_lo(gw.x); v0[1] *= bf_hi(gw.x); v0[2] *= bf_lo(gw.y); v0[3] *= bf_hi(gw.y);
                    v1[0] *= bf_lo(gw.z); v1[1] *= bf_hi(gw.z); v1[2] *= bf_lo(gw.w); v1[3] *= bf_hi(gw.w);
                    if (ADD) { const u32x4 tw = *(const u32x4*)(Tin + row * ldo + col);
                        v0[0] += bf_lo(tw.x); v0[1] += bf_hi(tw.x); v0[2] += bf_lo(tw.y); v0[3] += bf_hi(tw.y);
                        v1[0] += bf_lo(tw.z); v1[1] += bf_hi(tw.z); v1[2] += bf_lo(tw.w); v1[3] += bf_hi(tw.w); }
                    u32x4 w; w.x = cvt_pk_bf16(v0[0], v0[1]); w.y = cvt_pk_bf16(v0[2], v0[3]); w.z = cvt_pk_bf16(v1[0], v1[1]); w.w = cvt_pk_bf16(v1[2], v1[3]);
                    *(u32x4*)(O + row * ldo + col) = w; } }
    }
};


struct EpiMerge {
    static constexpr bool PERM = true, AFTER_DRAIN = false; static constexpr int MIDK = 16;
    const bf16_t* Gt; int ldg, gm_off, ga_off; bf16_t* O; int ldo;
    __device__ __forceinline__ void mid(f32x4 (&acc)[2][2][4][2], const Unit& u, int wr, int wc, int fr, int fq) const {
        const int row0 = u.pm * BM + wr * 64 + fr, col0 = u.pn * BM + wc * 32 + 8 * fq;
#pragma unroll
        for (int ai = 0; ai < 2; ++ai)
#pragma unroll
            for (int m = 0; m < 4; ++m) { const size_t ro = (size_t)(row0 + ai * HALF + m * 16) * ldg + col0;
#pragma unroll
                for (int bj = 0; bj < 2; ++bj) { const u32x4 gm = *(const u32x4*)(Gt + ro + gm_off + bj * HALF), ga = *(const u32x4*)(Gt + ro + ga_off + bj * HALF);
                    f32x4& v0 = acc[ai][bj][m][0]; f32x4& v1 = acc[ai][bj][m][1];
                    v0[0] *= bf_lo(gm.x) * __builtin_amdgcn_rcpf(bf_lo(ga.x)); v0[1] *= bf_hi(gm.x) * __builtin_amdgcn_rcpf(bf_hi(ga.x)); v0[2] *= bf_lo(gm.y) * __builtin_amdgcn_rcpf(bf_lo(ga.y)); v0[3] *= bf_hi(gm.y) * __builtin_amdgcn_rcpf(bf_hi(ga.y));
                    v1[0] *= bf_lo(gm.z) * __builtin_amdgcn_rcpf(bf_lo(ga.z)); v1[1] *= bf_hi(gm.z) * __builtin_amdgcn_rcpf(bf_hi(ga.z)); v1[2] *= bf_lo(gm.w) * __builtin_amdgcn_rcpf(bf_lo(ga.w)); v1[3] *= bf_hi(gm.w) * __builtin_amdgcn_rcpf(bf_hi(ga.w)); } }
    }
    __device__ __forceinline__ void operator()(const f32x4 (&acc)[2][2][4][2], const Unit& u, int wr, int wc, int fr, int fq) const {
        const int row0 = u.pm * BM + wr * 64 + fr, col0 = u.pn * BM + wc * 32 + 8 * fq;
        u32x4 gwv[2][4][2];
#pragma unroll
        for (int ai = 0; ai < 2; ++ai)
#pragma unroll
            for (int m = 0; m < 4; ++m)
#pragma unroll
                for (int bj = 0; bj < 2; ++bj) gwv[ai][m][bj] = *(const u32x4*)(Gt + (size_t)(row0 + ai * HALF + m * 16) * ldg + ga_off + col0 + bj * HALF);
#pragma unroll
        for (int ai = 0; ai < 2; ++ai)
#pragma unroll
            for (int m = 0; m < 4; ++m) { const size_t row = (size_t)(row0 + ai * HALF + m * 16);
#pragma unroll
                for (int bj = 0; bj < 2; ++bj) { const int col = col0 + bj * HALF;
                    const u32x4 gw = gwv[ai][m][bj];
                    f32x4 v0 = acc[ai][bj][m][0], v1 = acc[ai][bj][m][1];
                    v0[0] *= bf_lo(gw.x); v0[1] *= bf_hi(gw.x); v0[2] *= bf_lo(gw.y); v0[3] *= bf_hi(gw.y);
                    v1[0] *= bf_lo(gw.z); v1[1] *= bf_hi(gw.z); v1[2] *= bf_lo(gw.w); v1[3] *= bf_hi(gw.w);
                    u32x4 w; w.x = cvt_pk_bf16(v0[0], v0[1]); w.y = cvt_pk_bf16(v0[2], v0[3]); w.z = cvt_pk_bf16(v1[0], v1[1]); w.w = cvt_pk_bf16(v1[2], v1[3]);
                    *(u32x4*)(O + row * ldo + col) = w; } }
    }
};

struct EpiResF32 {
    static constexpr bool PERM = false, AFTER_DRAIN = false; static constexpr int MIDK = 0;
    float* C; int ldc; const float* R;
    __device__ __forceinline__ void operator()(const f32x4 (&acc)[2][2][4][2], const Unit& u, int wr, int wc, int fr, int fq) const {
        const int row0 = u.pm * BM + wr * 64 + fr, col0 = u.pn * BM + wc * 32 + 4 * fq;
#pragma unroll
        for (int ai = 0; ai < 2; ++ai)
#pragma unroll
            for (int m = 0; m < 4; ++m) { const size_t ro = (size_t)(row0 + ai * HALF + m * 16) * ldc + col0;
#pragma unroll
                for (int bj = 0; bj < 2; ++bj)
#pragma unroll
                    for (int n = 0; n < 2; ++n) { f32x4 v = acc[ai][bj][m][n];
                        if (R) v = v + *(const f32x4*)(R + ro + bj * HALF + n * 16);
                        *(f32x4*)(C + ro + bj * HALF + n * 16) = v; } }
    }
};


struct EpiResNorm {
    static constexpr bool PERM = true, AFTER_DRAIN = false; static constexpr int MIDK = 0;
    float* C; int ldc; const float* R; bf16_t* XB; const float* wcol; float* SSQ;
    __device__ __forceinline__ void operator()(const f32x4 (&acc)[2][2][4][2], const Unit& u, int wr, int wc, int fr, int fq) const {
        const int row0 = u.pm * BM + wr * 64 + fr, col0 = u.pn * BM + wc * 32 + 8 * fq;
        f32x4 wv[2][2];
#pragma unroll
        for (int bj = 0; bj < 2; ++bj)
#pragma unroll
            for (int n = 0; n < 2; ++n) wv[bj][n] = *(const f32x4*)(wcol + col0 + bj * HALF + 4 * n);
#pragma unroll
        for (int ai = 0; ai < 2; ++ai)
#pragma unroll
            for (int m = 0; m < 4; ++m) { const int row = row0 + ai * HALF + m * 16; const size_t ro = (size_t)row * ldc + col0; float ss = 0.f;
#pragma unroll
                for (int bj = 0; bj < 2; ++bj) {
                    const f32x4 v0 = acc[ai][bj][m][0] + *(const f32x4*)(R + ro + bj * HALF), v1 = acc[ai][bj][m][1] + *(const f32x4*)(R + ro + bj * HALF + 4);
                    *(f32x4*)(C + ro + bj * HALF) = v0; *(f32x4*)(C + ro + bj * HALF + 4) = v1;
                    ss += (v0[0] * v0[0] + v0[1] * v0[1]) + (v0[2] * v0[2] + v0[3] * v0[3]) + (v1[0] * v1[0] + v1[1] * v1[1]) + (v1[2] * v1[2] + v1[3] * v1[3]);
                    const f32x4 y0 = v0 * wv[bj][0], y1 = v1 * wv[bj][1];
                    u32x4 w; w.x = cvt_pk_bf16(y0[0], y0[1]); w.y = cvt_pk_bf16(y0[2], y0[3]); w.z = cvt_pk_bf16(y1[0], y1[1]); w.w = cvt_pk_bf16(y1[2], y1[3]);
                    *(u32x4*)(XB + ro + bj * HALF) = w; }
                ss += __shfl_xor(ss, 16); ss += __shfl_xor(ss, 32);
                if (fq == 0) SSQ[(size_t)row * 32 + 4 * u.pn + wc] = ss; }
    }
};


template <bool RB> struct EpiResB {
    static constexpr bool PERM = true, AFTER_DRAIN = false; static constexpr int MIDK = 0;
    bf16_t* C; int ldc; const void* R; float* SSQ;
    __device__ __forceinline__ void operator()(const f32x4 (&acc)[2][2][4][2], const Unit& u, int wr, int wc, int fr, int fq) const {
        const int row0 = u.pm * BM + wr * 64 + fr, col0 = u.pn * BM + wc * 32 + 8 * fq;
#pragma unroll
        for (int ai = 0; ai < 2; ++ai) {
            u32x4 rwv[4][2]; f32x4 rfv[4][2][2];
#pragma unroll
            for (int m = 0; m < 4; ++m)
#pragma unroll
                for (int bj = 0; bj < 2; ++bj) { const size_t ro = (size_t)(row0 + ai * HALF + m * 16) * ldc + col0 + bj * HALF;
                    if (RB) rwv[m][bj] = *(const u32x4*)((const bf16_t*)R + ro);
                    else { rfv[m][bj][0] = *(const f32x4*)((const float*)R + ro); rfv[m][bj][1] = *(const f32x4*)((const float*)R + ro + 4); } }
#pragma unroll
            for (int m = 0; m < 4; ++m) { const int row = row0 + ai * HALF + m * 16; const size_t ro = (size_t)row * ldc + col0; float ss = 0.f;
#pragma unroll
                for (int bj = 0; bj < 2; ++bj) { f32x4 v0 = acc[ai][bj][m][0], v1 = acc[ai][bj][m][1];
                    if (RB) { const u32x4 rw = rwv[m][bj];
                        v0[0] += bf_lo(rw.x); v0[1] += bf_hi(rw.x); v0[2] += bf_lo(rw.y); v0[3] += bf_hi(rw.y); v1[0] += bf_lo(rw.z); v1[1] += bf_hi(rw.z); v1[2] += bf_lo(rw.w); v1[3] += bf_hi(rw.w); }
                    else { v0 = v0 + rfv[m][bj][0]; v1 = v1 + rfv[m][bj][1]; }
                    ss += (v0[0] * v0[0] + v0[1] * v0[1]) + (v0[2] * v0[2] + v0[3] * v0[3]) + (v1[0] * v1[0] + v1[1] * v1[1]) + (v1[2] * v1[2] + v1[3] * v1[3]);
                    u32x4 w; w.x = cvt_pk_bf16(v0[0], v0[1]); w.y = cvt_pk_bf16(v0[2], v0[3]); w.z = cvt_pk_bf16(v1[0], v1[1]); w.w = cvt_pk_bf16(v1[2], v1[3]);
                    *(u32x4*)(C + ro + bj * HALF) = w; }
                if (SSQ) { ss += __shfl_xor(ss, 16); ss += __shfl_xor(ss, 32); if (fq == 0) SSQ[(size_t)row * 32 + 4 * u.pn + wc] = ss; } }
        }
    }
};

struct EpiSwiGLU {
    static constexpr bool PERM = true, AFTER_DRAIN = false; static constexpr int MIDK = 0;
    unsigned char* O; int ldo; const float* bgu; const int* block_e; int dff; float ascale, oscale; const float* rrow;
    __device__ __forceinline__ void operator()(const f32x4 (&acc)[2][2][4][2], const Unit& u, int wr, int wc, int fr, int fq) const {
        const int row0 = u.pm * BM + wr * 64 + fr, oc = u.pn * HALF + wc * 32 + 8 * fq;
        const float* bg = bgu + (size_t)block_e[u.pm] * (2 * dff) + oc; const float* bu = bg + dff;
        const f32x4 bg0 = *(const f32x4*)bg, bg1 = *(const f32x4*)(bg + 4), bu0 = *(const f32x4*)bu, bu1 = *(const f32x4*)(bu + 4);
        float rsv[2][4];
#pragma unroll
        for (int ai = 0; ai < 2; ++ai)
#pragma unroll
            for (int m = 0; m < 4; ++m) rsv[ai][m] = rrow[row0 + ai * HALF + m * 16];
#pragma unroll
        for (int ai = 0; ai < 2; ++ai)
#pragma unroll
            for (int m = 0; m < 4; ++m) { const float rs = ascale * rsv[ai][m];
                f32x4 g0 = acc[ai][0][m][0] * rs + bg0, g1 = acc[ai][0][m][1] * rs + bg1, u0 = acc[ai][1][m][0] * rs + bu0, u1 = acc[ai][1][m][1] * rs + bu1, a0, a1;
#pragma unroll
                for (int j = 0; j < 4; ++j) {
                    float g = fminf(g0[j], 7.0f), uu = __builtin_amdgcn_fmed3f(u0[j], -7.0f, 7.0f); a0[j] = (uu + 1.f) * (g * __builtin_amdgcn_rcpf(1.f + __builtin_amdgcn_exp2f(g * (-1.702f * 1.4426950408889634f)))) * oscale;
                    g = fminf(g1[j], 7.0f); uu = __builtin_amdgcn_fmed3f(u1[j], -7.0f, 7.0f); a1[j] = (uu + 1.f) * (g * __builtin_amdgcn_rcpf(1.f + __builtin_amdgcn_exp2f(g * (-1.702f * 1.4426950408889634f)))) * oscale; }
                u32x2 w; w.x = pk_fp8x4(a0[0], a0[1], a0[2], a0[3]); w.y = pk_fp8x4(a1[0], a1[1], a1[2], a1[3]);
                *(u32x2*)(O + (size_t)(row0 + ai * HALF + m * 16) * ldo + oc) = w; }
    }
};

struct EpiDown {
    static constexpr bool PERM = true, AFTER_DRAIN = false; static constexpr int MIDK = 0;
    unsigned char* O; int ldo; const float* bdn; const int* block_e; const float* rgate; float ascale, oscale;
    __device__ __forceinline__ void operator()(const f32x4 (&acc)[2][2][4][2], const Unit& u, int wr, int wc, int fr, int fq) const {
        const int row0 = u.pm * BM + wr * 64 + fr, col0 = u.pn * BM + wc * 32 + 8 * fq;
        const float* bb = bdn + (size_t)block_e[u.pm] * ldo + col0;
        f32x4 bv[2][2];
#pragma unroll
        for (int bj = 0; bj < 2; ++bj)
#pragma unroll
            for (int n = 0; n < 2; ++n) bv[bj][n] = *(const f32x4*)(bb + bj * HALF + 4 * n);
        float gtv[2][4];
#pragma unroll
        for (int ai = 0; ai < 2; ++ai)
#pragma unroll
            for (int m = 0; m < 4; ++m) gtv[ai][m] = rgate[row0 + ai * HALF + m * 16];
#pragma unroll
        for (int ai = 0; ai < 2; ++ai)
#pragma unroll
            for (int m = 0; m < 4; ++m) { const int row = row0 + ai * HALF + m * 16; const float gt = gtv[ai][m] * oscale;
#pragma unroll
                for (int bj = 0; bj < 2; ++bj) { const f32x4 v0 = (acc[ai][bj][m][0] * ascale + bv[bj][0]) * gt, v1 = (acc[ai][bj][m][1] * ascale + bv[bj][1]) * gt;
                    u32x2 w; w.x = pk_fp8x4(v0[0], v0[1], v0[2], v0[3]); w.y = pk_fp8x4(v1[0], v1[1], v1[2], v1[3]);
                    *(u32x2*)(O + (size_t)row * ldo + col0 + bj * HALF) = w; } }
    }
};

template <class Epi, class Sched, bool ALIGN_EPI = false, bool SP2 = false, bool FP8 = false>
__device__ __forceinline__ void gemm_phase(PG8_LAS unsigned char* lds, const Gemm g, const Sched& S, const Epi& E, const int wave_id, const int koff_in = 0) {
    int tid_ = wave_id * 64 + (int)__builtin_amdgcn_mbcnt_hi(~0u, __builtin_amdgcn_mbcnt_lo(~0u, 0u)); asm volatile("" : "+v"(tid_));
    const int tid = tid_, wid = __builtin_amdgcn_readfirstlane(tid >> 6), lane = tid & 63, wr = wid >> 2, wc = wid & 3, fr = lane & 15, fq = lane >> 4;
    const int K = g.K, nt = K / BK;
    const int koff = koff_in & (nt - 1) & ~1;
#define PG8_KO(i) ((size_t)(((i) + koff) & (nt - 1)) * kstep)
    unsigned voffA[2], voffB[2];
#pragma unroll
    for (int i = 0; i < 2; ++i) { int R, C; stage_rc(tid * 16 + i * 8192, R, C); const int Rb = Epi::PERM ? ((R & ~31) + perm32(R & 31)) : R;
        voffA[i] = (unsigned)(R * K + C) * 2u; voffB[i] = (unsigned)(Rb * K + C) * 2u; }
    const size_t kstep = (size_t)(BK * 2);
    const size_t hstep = (size_t)HALF * K * 2;
    const size_t tstep = 2 * hstep; (void)tstep;
    const unsigned ldsw = (unsigned)wid * 1024u;
    const int aoff = lds_byte(wr * 64 + fr, fq * 8), boff = lds_byte(wc * 32 + fr, fq * 8);
#define PG8_SA(b, h) (((b) * 2 + (h)) * HTB)
#define PG8_SB(b, h) ((4 + (b) * 2 + (h)) * HTB)
#define PG8_STAGE(bufoff, gbase, voff) do { _Pragma("unroll") for (int _i = 0; _i < 2; ++_i) \
        __builtin_amdgcn_global_load_lds((const unsigned*)((const char*)(gbase) + (voff)[_i]), (PG8_LAS unsigned*)(lds + (bufoff) + ldsw + _i * 8192), 16, 0, 0); } while (0)
#define PG8_LDA(dst, b, h) do { _Pragma("unroll") for (int m = 0; m < 4; ++m) _Pragma("unroll") for (int k = 0; k < 2; ++k) dst[m][k] = *(const PG8_LAS bf16x8*)(lds + PG8_SA(b, h) + aoff + m * 2048 + k * 1024); } while (0)
#define PG8_LDB(dst, b, h) do { _Pragma("unroll") for (int n = 0; n < 2; ++n) _Pragma("unroll") for (int k = 0; k < 2; ++k) dst[n][k] = *(const PG8_LAS bf16x8*)(lds + PG8_SB(b, h) + boff + n * 2048 + k * 1024); } while (0)
#define PG8_MMA(ai, bj, At, Bt) do { __builtin_amdgcn_s_setprio(1); _Pragma("unroll") for (int m = 0; m < 4; ++m) _Pragma("unroll") for (int n = 0; n < 2; ++n) { \
        if constexpr (FP8) { asm volatile("s_nop 1\n\tv_mfma_scale_f32_16x16x128_f8f6f4 %0, %1, %2, %0, %3, %3 op_sel_hi:[0,0,0]" : "+v"(acc[ai][bj][m][n]) : "v"(cat8(Bt[n][0], Bt[n][1])), "v"(cat8(At[m][0], At[m][1])), "v"(one_scale)); } \
        else { _Pragma("unroll") for (int k = 0; k < 2; ++k) acc[ai][bj][m][n] = __builtin_amdgcn_mfma_f32_16x16x32_bf16(Bt[n][k], At[m][k], acc[ai][bj][m][n], 0, 0, 0); } } \
        __builtin_amdgcn_s_setprio(0); } while (0)
#define PG8_WAIT_V(n) asm volatile("s_waitcnt vmcnt(" #n ")" ::: "memory")
#define PG8_WAIT_L(n) asm volatile("s_waitcnt lgkmcnt(" #n ")" ::: "memory")
#define PG8_BAR __builtin_amdgcn_s_barrier()
#define PG8_SCHED __builtin_amdgcn_sched_barrier(0)
    Unit cur, nxt; int ui = 0;
    if (!S.next(0, cur)) return;
#ifdef PG8_STAGGER
    { const int dly = ((int)blockIdx.x >> 3) & 3; for (int q = 0; q < dly; ++q) { __builtin_amdgcn_s_sleep(60); } }
#endif
    const int one_scale = 0x7F7F7F7F; (void)one_scale;
    f32x4 acc[2][2][4][2];
#pragma unroll
    for (int a = 0; a < 2; ++a)
#pragma unroll
        for (int b = 0; b < 2; ++b)
#pragma unroll
            for (int m = 0; m < 4; ++m)
#pragma unroll
                for (int n = 0; n < 2; ++n) acc[a][b][m][n] = (f32x4){0.f, 0.f, 0.f, 0.f};
    bf16x8 At[4][2], B0[2][2], B1[2][2];
    const char* cA = S.a_base(g, cur); const char* cB = S.b_base(g, cur);
    S.a_ready(cur);
    if constexpr (SP2) {
        PG8_STAGE(PG8_SB(0, 0), cB + PG8_KO(0), voffB); PG8_STAGE(PG8_SB(0, 1), cB + hstep + PG8_KO(0), voffB); PG8_STAGE(PG8_SA(0, 0), cA + PG8_KO(0), voffA); PG8_STAGE(PG8_SA(0, 1), cA + hstep + PG8_KO(0), voffA);
        if (wr == 1) PG8_BAR;
        PG8_WAIT_V(2); PG8_BAR;
        PG8_STAGE(PG8_SB(1, 0), cB + PG8_KO(1), voffB); PG8_STAGE(PG8_SA(1, 0), cA + PG8_KO(1), voffA); PG8_STAGE(PG8_SB(1, 1), cB + hstep + PG8_KO(1), voffB);
        PG8_WAIT_V(6); PG8_BAR;
    } else {
        PG8_STAGE(PG8_SB(0, 0), cB + PG8_KO(0), voffB); PG8_STAGE(PG8_SA(0, 0), cA + PG8_KO(0), voffA); PG8_STAGE(PG8_SB(0, 1), cB + hstep + PG8_KO(0), voffB); PG8_STAGE(PG8_SA(0, 1), cA + hstep + PG8_KO(0), voffA);
        if (wr == 1) PG8_BAR;
        PG8_WAIT_V(4); PG8_BAR;
        PG8_STAGE(PG8_SB(1, 0), cB + PG8_KO(1), voffB); PG8_STAGE(PG8_SA(1, 0), cA + PG8_KO(1), voffA); PG8_STAGE(PG8_SB(1, 1), cB + hstep + PG8_KO(1), voffB);
        PG8_WAIT_V(6); PG8_BAR;
    }
    for (;;) {
        const bool has_next = S.next(ui + 1, nxt);
        const char* nA = has_next ? S.a_base(g, nxt) : cA; const char* nB = has_next ? S.b_base(g, nxt) : cB;
        for (int t = 0; t < nt; t += 2) {
            const bool last = (t == nt - 2);
            const char* a1 = cA + PG8_KO(t + 1);
            const char* a2 = last ? nA + PG8_KO(0) : cA + PG8_KO(t + 2); const char* b2 = last ? nB + PG8_KO(0) : cB + PG8_KO(t + 2);
            const char* a3 = a2 + kstep; const char* b3 = b2 + kstep;
            if constexpr (Epi::MIDK > 0) { if (t == Epi::MIDK) { int lm = lane; asm volatile("" : "+v"(lm)); E.mid(acc, cur, wr, wc, lm & 15, lm >> 4); } }
            if (last && has_next) S.a_ready(nxt);
            if constexpr (SP2) {
            PG8_LDB(B0, 0, 0); PG8_LDB(B1, 0, 1); PG8_SCHED; PG8_LDA(At, 0, 0); PG8_STAGE(PG8_SA(1, 1), a1 + hstep, voffA);
            PG8_WAIT_V(8); PG8_WAIT_L(0); PG8_BAR; PG8_MMA(0, 0, At, B0); PG8_MMA(0, 1, At, B1); PG8_BAR; PG8_SCHED;
            PG8_LDA(At, 0, 1); PG8_STAGE(PG8_SB(0, 0), b2, voffB); PG8_STAGE(PG8_SB(0, 1), b2 + hstep, voffB); PG8_STAGE(PG8_SA(0, 0), a2, voffA);
            PG8_WAIT_V(8); PG8_WAIT_L(0); PG8_BAR; PG8_MMA(1, 0, At, B0); PG8_MMA(1, 1, At, B1); PG8_BAR; PG8_SCHED;
            PG8_LDB(B0, 1, 0); PG8_LDB(B1, 1, 1); PG8_SCHED; PG8_LDA(At, 1, 0); PG8_STAGE(PG8_SA(0, 1), a2 + hstep, voffA);
            PG8_WAIT_V(8); PG8_WAIT_L(0); PG8_BAR; PG8_MMA(0, 0, At, B0); PG8_MMA(0, 1, At, B1); PG8_BAR; PG8_SCHED;
            PG8_LDA(At, 1, 1); PG8_STAGE(PG8_SB(1, 0), b3, voffB); PG8_STAGE(PG8_SB(1, 1), b3 + hstep, voffB); PG8_STAGE(PG8_SA(1, 0), a3, voffA);
            PG8_WAIT_V(8); PG8_WAIT_L(0); PG8_BAR; PG8_MMA(1, 0, At, B0); PG8_MMA(1, 1, At, B1); PG8_BAR; PG8_SCHED;
            } else {
            PG8_LDB(B0, 0, 0); PG8_SCHED; PG8_LDA(At, 0, 0); PG8_STAGE(PG8_SA(1, 1), a1 + hstep, voffA);
            PG8_WAIT_L(8); PG8_BAR; PG8_WAIT_L(0); PG8_MMA(0, 0, At, B0); PG8_BAR; PG8_SCHED;
            PG8_LDB(B1, 0, 1); PG8_STAGE(PG8_SB(0, 0), b2, voffB);
            PG8_BAR; PG8_WAIT_L(0); PG8_MMA(0, 1, At, B1); PG8_BAR;
            PG8_LDA(At, 0, 1); PG8_STAGE(PG8_SA(0, 0), a2, voffA);
            PG8_BAR; PG8_WAIT_L(0); PG8_MMA(1, 0, At, B0); PG8_BAR; PG8_SCHED;
            PG8_STAGE(PG8_SB(0, 1), b2 + hstep, voffB);
            PG8_WAIT_V(6); PG8_BAR; PG8_MMA(1, 1, At, B1); PG8_BAR;
            PG8_LDB(B0, 1, 0); PG8_SCHED; PG8_LDA(At, 1, 0); PG8_STAGE(PG8_SA(0, 1), a2 + hstep, voffA);
            PG8_WAIT_L(8); PG8_BAR; PG8_WAIT_L(0); PG8_MMA(0, 0, At, B0); PG8_BAR; PG8_SCHED;
            PG8_LDB(B1, 1, 1); PG8_STAGE(PG8_SB(1, 0), b3, voffB);
            PG8_BAR; PG8_WAIT_L(0); PG8_MMA(0, 1, At, B1); PG8_BAR;
            PG8_LDA(At, 1, 1); PG8_STAGE(PG8_SA(1, 0), a3, voffA);
            PG8_BAR; PG8_WAIT_L(0); PG8_MMA(1, 0, At, B0); PG8_BAR; PG8_SCHED;
            PG8_STAGE(PG8_SB(1, 1), b3 + hstep, voffB);
            PG8_WAIT_V(6); PG8_BAR; PG8_MMA(1, 1, At, B1); PG8_BAR;
            }
        }
        if constexpr (FP8) { asm volatile("s_nop 15\n\ts_nop 15" ::: "memory"); }
        if constexpr (ALIGN_EPI) { if (wr == 0) PG8_BAR; }
        if constexpr (!Epi::AFTER_DRAIN) { int lz = lane; asm volatile("" : "+v"(lz));
            E(acc, cur, wr, wc, lz & 15, lz >> 4); S.done(cur); }
        if (!has_next) break;
#pragma unroll
        for (int a = 0; a < 2; ++a)
#pragma unroll
            for (int b = 0; b < 2; ++b)
#pragma unroll
                for (int m = 0; m < 4; ++m)
#pragma unroll
                    for (int n = 0; n < 2; ++n) acc[a][b][m][n] = (f32x4){0.f, 0.f, 0.f, 0.f};
        cur = nxt; cA = nA; cB = nB; ++ui;
        if constexpr (ALIGN_EPI) { if (wr == 1) PG8_BAR; }
    }
    PG8_WAIT_V(0);
    if constexpr (!ALIGN_EPI) { if (wr == 0) PG8_BAR; }
    PG8_BAR;
    if constexpr (Epi::AFTER_DRAIN) { E.fused(acc, cur, wr, wc, fr, fq, lds, wid, lane); S.done(cur); }
#undef PG8_KO
#undef PG8_SA
#undef PG8_SB
#undef PG8_STAGE
#undef PG8_LDA
#undef PG8_LDB
#undef PG8_MMA
#undef PG8_WAIT_V
#undef PG8_WAIT_L
#undef PG8_BAR
#undef PG8_SCHED
}
}

#define PROBE_MASK 0x0
constexpr int NWAVES = 8, NTHR = 512;
constexpr int BATCH = 2, SEQ = 8192, T = BATCH * SEQ, D = 2048;
constexpr int CHUNK = 64, NCH = SEQ / CHUNK;
constexpr int MH = 4, MD = 256, MW = 1024;
constexpr int AH = 16, AD = 64, AW = 1024;
constexpr int NMEM = 256, XH = 4, XD = 128, XW = 512;
constexpr int NE = 32, TOPK = 4, DFF = 2048, MOEB = 256;
constexpr int IN_COLS = 11272, NPROJ = 11264;
constexpr int NROWS_MAX = (T * TOPK / MOEB + NE) * MOEB;
constexpr int NBLK_MAX = NROWS_MAX / MOEB;
constexpr float EPS = 1e-6f;
constexpr float HSCALE = 16.f;
constexpr float WSCALE = 1024.f, XSCALE = 16.f, ASCALE = 8.f, YSCALE = 16.f;
constexpr int PQ_M = 0, PK_M = 1024, PV_M = 2048, PO_M = 3072, PQ_A = 4096, PK_A = 5120, PV_A = 6144, PG_M = 7168, PG_A = 9216;

constexpr size_t MiB = 1u << 20;
constexpr size_t al(size_t x) { return (x + MiB - 1) / MiB * MiB; }
constexpr size_t WS_CTL = 0, CTL_ZERO_BYTES = 1 * MiB;
constexpr size_t WS_WIN = WS_CTL + CTL_ZERO_BYTES;
constexpr size_t WS_WIN8 = WS_WIN + al((size_t)3072 * D * 2);
constexpr size_t WS_H8 = WS_WIN8 + al((size_t)8192 * D);
constexpr size_t WS_WBM = WS_H8 + al((size_t)T * D);
constexpr size_t WS_WBA = WS_WBM + al((size_t)D * MW * 2);
constexpr size_t WS_WOUT = WS_WBA + al((size_t)D * AW * 2);
constexpr size_t WS_WQ = WS_WOUT + al((size_t)D * D * 2);
constexpr size_t WS_WKV = WS_WQ + al((size_t)XW * D * 2);
constexpr size_t WS_WO = WS_WKV + al((size_t)2 * XW * D * 2);
constexpr size_t WS_WR = WS_WO + al((size_t)D * XW * 2);
constexpr size_t WS_WGU = WS_WR + al((size_t)256 * D * 2);
constexpr size_t WS_WDN = WS_WGU + al((size_t)NE * 2 * DFF * D);
constexpr size_t WS_H = WS_WDN + al((size_t)NE * D * DFF);
constexpr size_t WS_PROJ = WS_H + al((size_t)T * D * 2);
constexpr size_t WS_IFG = WS_PROJ + al((size_t)T * NPROJ * 2);
constexpr size_t WS_QKC = WS_IFG + al((size_t)T * 8 * 4);
constexpr size_t WS_BCUM = WS_QKC + al((size_t)T * 2048 * 2);
constexpr size_t WS_CLOC = WS_BCUM + al((size_t)T * 4 * 4);
constexpr size_t WS_CIN = WS_CLOC + al((size_t)1024 * 65536 * 2);
constexpr size_t WS_NLOC = WS_CIN + al((size_t)1024 * 65536 * 2);
constexpr size_t WS_NIN = WS_NLOC + al((size_t)1024 * 256 * 4);
constexpr size_t WS_CHS = WS_NIN + al((size_t)1024 * 256 * 4);
constexpr size_t WS_HM = WS_CHS + MiB;
constexpr size_t WS_YA = WS_HM + al((size_t)T * MW * 2);
constexpr size_t WS_T1 = WS_YA + al((size_t)T * AW * 2);
constexpr size_t WS_MRG = WS_T1 + al((size_t)T * D * 2);
constexpr size_t WS_X1 = WS_MRG + al((size_t)T * D * 2);
constexpr size_t WS_XN1 = WS_X1 + al((size_t)T * D * 4);
constexpr size_t WS_SSQ1 = WS_XN1 + al((size_t)T * D * 2);
constexpr size_t WS_MEMN = WS_SSQ1 + al((size_t)T * 32 * 4);
constexpr size_t WS_KVX = WS_MEMN + al((size_t)512 * D * 2);
constexpr size_t WS_QX = WS_KVX + al((size_t)512 * 1024 * 2);
constexpr size_t WS_OX = WS_QX + al((size_t)T * XW * 2);
constexpr size_t WS_X2 = WS_OX + al((size_t)T * XW * 2);
constexpr size_t WS_XN3 = WS_X2 + al((size_t)T * D * 4);
constexpr size_t WS_LOG = WS_XN3 + al((size_t)T * D * 2);
constexpr size_t WS_TOPE = WS_LOG + al((size_t)T * 256 * 4);
constexpr size_t WS_GATE = WS_TOPE + al((size_t)T * 4 * 4);
constexpr size_t WS_RANK = WS_GATE + al((size_t)T * 4 * 4);
constexpr size_t WS_DEST = WS_RANK + al((size_t)T * 4 * 4);
constexpr size_t WS_RGATE = WS_DEST + al((size_t)T * 4 * 4);
constexpr size_t WS_RROW = WS_RGATE + al((size_t)NROWS_MAX * 4);
constexpr size_t WS_RSTD = WS_RROW + al((size_t)NROWS_MAX * 4);
constexpr size_t WS_XQ = WS_RSTD + al((size_t)T * 4);
constexpr size_t WS_XPERM = WS_XQ + al((size_t)T * D);
constexpr size_t WS_ACT = WS_XPERM + al((size_t)NROWS_MAX * D);
constexpr size_t WS_YR = WS_ACT + al((size_t)NROWS_MAX * DFF);
constexpr size_t WS_END = WS_YR + al((size_t)NROWS_MAX * D * 2);
constexpr int CW_BAR = 4096;
constexpr int CW_HIST = 16384;
constexpr int CW_BLKE = 32768;
constexpr int CW_NBLK = 33792;

constexpr int RING_OFF = 0, RING_BYTES = 131072;
constexpr int LDSCTL_OFF = RING_BYTES, MISC_OFF = LDSCTL_OFF + 320;
constexpr int LDS_BYTES = 147456;

#define GAS __attribute__((address_space(1)))
#define LAS __attribute__((address_space(3)))
typedef unsigned short bf16;
typedef unsigned v4u __attribute__((ext_vector_type(4)));
typedef unsigned v2u __attribute__((ext_vector_type(2)));
typedef float f32x4 __attribute__((ext_vector_type(4)));
typedef float f32x16 __attribute__((ext_vector_type(16)));
typedef float f32x2 __attribute__((ext_vector_type(2)));
typedef short bf16x8 __attribute__((ext_vector_type(8)));
typedef short bf16x4 __attribute__((ext_vector_type(4)));
typedef GAS unsigned gu32;
#define RLX_AGENT __ATOMIC_RELAXED, __HIP_MEMORY_SCOPE_AGENT
#define LDS_WAIT() asm volatile("s_waitcnt lgkmcnt(0)" ::: "memory")
#define VM_WAIT() asm volatile("s_waitcnt vmcnt(0)" ::: "memory")
__device__ __forceinline__ unsigned pk2(float lo, float hi) { return pg8::cvt_pk_bf16_c(lo, hi); }
__device__ __forceinline__ float bflo(unsigned w) { return __builtin_bit_cast(float, w << 16); }
__device__ __forceinline__ float bfhi(unsigned w) { return __builtin_bit_cast(float, w & 0xffff0000u); }
__device__ __forceinline__ float bf1(bf16 h) { return __builtin_bit_cast(float, ((unsigned)h) << 16); }
__device__ __forceinline__ bf16 f2bf(float f) { return (bf16)(pk2(f, 0.f) & 0xffffu); }
__device__ __forceinline__ float sigm(float x) { return __builtin_amdgcn_rcpf(1.f + __expf(-x)); }
__device__ __forceinline__ f32x16 mfma32(bf16x8 a, bf16x8 b, f32x16 c) { return __builtin_amdgcn_mfma_f32_32x32x16_bf16(a, b, c, 0, 0, 0); }
__device__ __forceinline__ void lds_addf(LAS float* p, float v) { (void)__hip_atomic_fetch_add(p, v, __ATOMIC_RELAXED, __HIP_MEMORY_SCOPE_WORKGROUP); }
__device__ __forceinline__ int lds_addi(LAS int* p, int v) { return __hip_atomic_fetch_add(p, v, __ATOMIC_RELAXED, __HIP_MEMORY_SCOPE_WORKGROUP); }
__device__ __forceinline__ float wave_sum(float v) {
#pragma unroll
    for (int o = 1; o < 64; o <<= 1) v += __shfl_xor(v, o);
    return v;
}
__device__ __forceinline__ float wave_max(float v) {
#pragma unroll
    for (int o = 1; o < 64; o <<= 1) v = fmaxf(v, __shfl_xor(v, o));
    return v;
}

#define XB_TMO      128
#define XB_XCNT(j)  (256  + 64 * (j))
#define XB_XSUB(j)  (1280 + 64 * (j))
#define XB_XGEN(j)  (2304 + 64 * (j))
#define XB_TOP      3328
#define XB_TOPGEN   3392
#define XCD_BAR_WORDS 3456
#define XB_SPIN_CAP (1u << 18)
__device__ __forceinline__ unsigned xb_ld(unsigned* p)              { return __hip_atomic_load(p, __ATOMIC_RELAXED, __HIP_MEMORY_SCOPE_AGENT); }
__device__ __forceinline__ unsigned xb_add(unsigned* p, unsigned v) { return __hip_atomic_fetch_add(p, v, __ATOMIC_RELAXED, __HIP_MEMORY_SCOPE_AGENT); }
__device__ __forceinline__ unsigned xb_xcc_id() { return (unsigned)__builtin_amdgcn_s_getreg((3 << 11) | 20) & 0xFu; }
#define XB_SPIN(cond, bar) do { unsigned _sp = 0; while (cond) { __builtin_amdgcn_s_sleep(1); \
    if ((++_sp & 255u) == 0u) { if (xb_ld(&(bar)[XB_TMO])) break; if (_sp > XB_SPIN_CAP) { atomicAdd(&(bar)[XB_TMO], 1u); break; } } } } while (0)
struct XcdBarrier { unsigned* bar; unsigned x; volatile LAS unsigned* st; };
__device__ __forceinline__ XcdBarrier xcd_barrier_post(unsigned* bar, volatile LAS unsigned* st, int tid0) {
    XcdBarrier b; b.bar = bar; b.x = xb_xcc_id(); b.st = st;
    if (tid0 == 0) (void)xb_add(&bar[XB_XCNT(b.x)], 1u);
    return b;
}
__device__ __forceinline__ void xcd_barrier_complete(unsigned* bar, unsigned x, unsigned& nloc, unsigned& nx) {
    const unsigned G = gridDim.x * gridDim.y * gridDim.z;
    unsigned sum, cnt, mine, sp = 0u;
    for (;;) {
        sum = 0u; cnt = 0u; mine = 0u;
#pragma unroll
        for (unsigned j = 0; j < 16; ++j) { const unsigned c = xb_ld(&bar[XB_XCNT(j)]); sum += c; cnt += (c > 0u) ? 1u : 0u; mine = (j == x) ? c : mine; }
        if (sum == G) break;
        __builtin_amdgcn_s_sleep(1);
        if ((++sp & 255u) == 0u) { if (xb_ld(&bar[XB_TMO])) break; if (sp > XB_SPIN_CAP) { atomicAdd(&bar[XB_TMO], 1u); break; } }
    }
    nloc = mine > 0u ? mine : 1u; nx = cnt > 0u ? cnt : 1u;
}
__device__ __forceinline__ void xcd_barrier(const XcdBarrier& b, int tid0) {
    asm volatile("s_waitcnt vmcnt(0)" ::: "memory");
    __syncthreads();
    if (tid0 == 0) {
        unsigned* bar = b.bar;
        __builtin_amdgcn_s_waitcnt(0);
        unsigned nloc = b.st[0], nx = b.st[1];
        if (nloc == 0u) { xcd_barrier_complete(bar, b.x, nloc, nx); b.st[0] = nloc; b.st[1] = nx; }
        const unsigned old = xb_add(&bar[XB_XSUB(b.x)], 1u);
        const unsigned gen = old / nloc;
        if (old + 1u == (gen + 1u) * nloc) {
            __builtin_amdgcn_fence(__ATOMIC_RELEASE, "agent");
            asm volatile("s_waitcnt vmcnt(0)" ::: "memory");
            const unsigned og = xb_add(&bar[XB_TOP], 1u);
            const unsigned tg = og / nx;
            if (og + 1u == (tg + 1u) * nx) xb_add(&bar[XB_TOPGEN], 1u);
            else XB_SPIN(xb_ld(&bar[XB_TOPGEN]) == tg, bar);
            __builtin_amdgcn_fence(__ATOMIC_ACQUIRE, "agent");
            xb_add(&bar[XB_XGEN(b.x)], 1u);
            asm volatile("s_waitcnt vmcnt(0)" ::: "memory");
        } else {
            XB_SPIN(xb_ld(&bar[XB_XGEN(b.x)]) == gen, bar);
            __builtin_amdgcn_fence(__ATOMIC_ACQUIRE, "agent");
            asm volatile("s_waitcnt vmcnt(0)" ::: "memory");
        }
    }
    __syncthreads();
}

struct Frame {
    LAS unsigned char* lds;
    int tid, lane, wave, G, vcu;
    unsigned char* ws;
    const float* in[25];
    float* out;
};
enum { I_X = 0, I_MEM, I_NMIXW, I_WIN, I_CONVW, I_CONVB, I_IFB, I_MHNW, I_WBM, I_WBA, I_REL, I_WOUT, I_NXW, I_NMEMW, I_WQ, I_WKV, I_WO, I_NFFNW,
       I_WR, I_BR, I_WGU, I_BGU, I_WDN, I_BDN, I_FNW };

__device__ __forceinline__ int fresh_lane() { int l = (int)__builtin_amdgcn_mbcnt_hi(~0u, __builtin_amdgcn_mbcnt_lo(~0u, 0u)); asm volatile("" : "+v"(l)); return l; }
__device__ __forceinline__ void frame_ids(Frame& F) {
    const int l = fresh_lane(); F.lane = l; F.tid = F.wave * 64 + l;
}

__device__ __forceinline__ void transpose_item(const float* W, int ldw, int src_col0, int k0, bf16* WT, int K, int dest_row0, LAS float* scr, int lane) {
    float rv[32];
#pragma unroll
    for (int i = 0; i < 32; ++i) { const int kk = 2 * i + (lane >> 5); rv[i] = W[(size_t)(k0 + kk) * ldw + src_col0 + (lane & 31)]; }
#pragma unroll
    for (int i = 0; i < 32; ++i) { const int kk = 2 * i + (lane >> 5); scr[kk * 33 + (lane & 31)] = rv[i]; }
    LDS_WAIT(); asm volatile("" ::: "memory");
    const int c = lane & 7;
#pragma unroll
    for (int j = 0; j < 4; ++j) { const int n = (lane >> 3) + 8 * j; const LAS float* s = scr + (8 * c) * 33 + n;
        v4u o; o.x = pk2(s[0 * 33], s[1 * 33]); o.y = pk2(s[2 * 33], s[3 * 33]); o.z = pk2(s[4 * 33], s[5 * 33]); o.w = pk2(s[6 * 33], s[7 * 33]);
        *(GAS v4u*)(WT + (size_t)(dest_row0 + n) * K + k0 + 8 * c) = o; }
    LDS_WAIT(); asm volatile("" ::: "memory");
}
struct Fp8Job { const float* src; unsigned char* dst; int ldw, K; };
__device__ __forceinline__ Fp8Job fp8_job(const Frame& F, int r) {
    constexpr int I_GU1 = 32 * 128, I_DN1 = 32 * 64;
    Fp8Job j;
    if (r < NE * I_GU1) { const int e = r / I_GU1, q = r % I_GU1, kb = q / 128, sb = q % 128;
        const int sc0 = 32 * sb, bj = sc0 / DFF, cc = sc0 % DFF, dest = (cc / 128) * 256 + bj * 128 + (cc % 128);
        j.src = F.in[I_WGU] + (size_t)e * D * (2 * DFF) + (size_t)(64 * kb) * (2 * DFF) + sc0; j.ldw = 2 * DFF;
        j.dst = (unsigned char*)(F.ws + WS_WGU) + (size_t)e * (2 * DFF) * D + (size_t)dest * D + 64 * kb; j.K = D; }
    else { r -= NE * I_GU1; const int e = r / I_DN1, q = r % I_DN1, kb = q / 64, nb = q % 64;
        j.src = F.in[I_WDN] + (size_t)e * DFF * D + (size_t)(64 * kb) * D + 32 * nb; j.ldw = D;
        j.dst = (unsigned char*)(F.ws + WS_WDN) + (size_t)e * D * DFF + (size_t)(32 * nb) * DFF + 64 * kb; j.K = DFF; }
    return j;
}
__device__ __forceinline__ void fp8_item_load(const Fp8Job& j, f32x4 (&rv)[8], int lane) {
    const float* p = j.src + (size_t)(lane >> 3) * j.ldw + 4 * (lane & 7);
#pragma unroll
    for (int i = 0; i < 8; ++i) rv[i] = *(const GAS f32x4*)(p + (size_t)(8 * i) * j.ldw);
}
__device__ __forceinline__ void fp8_item_store(const Fp8Job& j, const f32x4 (&rv)[8], LAS float* scr, int lane) {
#pragma unroll
    for (int i = 0; i < 8; ++i) { LAS float* d = scr + (8 * i + (lane >> 3)) * 33 + 4 * (lane & 7); d[0] = rv[i].x; d[1] = rv[i].y; d[2] = rv[i].z; d[3] = rv[i].w; }
    LDS_WAIT(); asm volatile("" ::: "memory");
    const int c = lane >> 4;
#pragma unroll
    for (int jn = 0; jn < 2; ++jn) { const int n = (lane & 15) + 16 * jn; const LAS float* s = scr + (16 * c) * 33 + n;
        v4u o; o.x = pg8::pk_fp8x4(s[0 * 33] * WSCALE, s[1 * 33] * WSCALE, s[2 * 33] * WSCALE, s[3 * 33] * WSCALE); o.y = pg8::pk_fp8x4(s[4 * 33] * WSCALE, s[5 * 33] * WSCALE, s[6 * 33] * WSCALE, s[7 * 33] * WSCALE);
        o.z = pg8::pk_fp8x4(s[8 * 33] * WSCALE, s[9 * 33] * WSCALE, s[10 * 33] * WSCALE, s[11 * 33] * WSCALE); o.w = pg8::pk_fp8x4(s[12 * 33] * WSCALE, s[13 * 33] * WSCALE, s[14 * 33] * WSCALE, s[15 * 33] * WSCALE);
        *(GAS v4u*)(j.dst + (size_t)n * j.K + 16 * c) = o; }
    LDS_WAIT(); asm volatile("" ::: "memory");
}
__device__ __forceinline__ void tr_dense(const float* W, int K, int N, bf16* WT, LAS float* scr, int item, int lane) {
    const int nblk = N / 32, kb = item / nblk, nb = item % nblk;
    transpose_item(W, N, 32 * nb, 64 * kb, WT, K, 32 * nb, scr, lane);
}
__device__ __forceinline__ void rms_row_to_bf16(const float* xrow, const float* w, bf16* orow, int lane) {
    const GAS f32x4* xr = (const GAS f32x4*)xrow + lane;
    f32x4 v[8]; float s = 0.f;
#pragma unroll
    for (int j = 0; j < 8; ++j) { v[j] = xr[64 * j]; s += (v[j].x * v[j].x + v[j].y * v[j].y) + (v[j].z * v[j].z + v[j].w * v[j].w); }
    const float rstd = 1.f / sqrtf(wave_sum(s) * (1.f / D) + EPS);
    const GAS f32x4* wr = (const GAS f32x4*)w + lane;
    GAS v2u* o8 = (GAS v2u*)orow + lane;
#pragma unroll
    for (int j = 0; j < 8; ++j) { const f32x4 ww = wr[64 * j]; v2u o; o.x = pk2(v[j].x * rstd * ww.x, v[j].y * rstd * ww.y); o.y = pk2(v[j].z * rstd * ww.z, v[j].w * rstd * ww.w); o8[64 * j] = o; }
}

struct TJob { const float* src; unsigned char* dst; const float* kscale; int ldw, Kd, rowmap, fp8; };
constexpr int T_IN = 16 * 44, T_BM = 8 * 8, T_BA = 8 * 8, T_OUT = 16 * 8, T_Q = 16 * 2, T_KV = 16 * 4, T_O = 4 * 8, T_GU = 16 * 16, T_DN = 16 * 8;
constexpr int NT_SMALL = T_IN + T_BM + T_BA + T_OUT + T_Q + T_KV + T_O, NTILES = NT_SMALL + NE * (T_GU + T_DN);
constexpr int NT_GU = 512;
constexpr int LATE_WG = 120, NT_LATE = LATE_WG * 8;
__device__ __forceinline__ TJob tile_job(const Frame& F, int r) {
    TJob j; j.rowmap = 0; j.fp8 = 0; j.kscale = nullptr;
#define TJ_DENSE(W_, Kk, Nn, DST_) { const int nbn = (Nn) / 256, kb = r / nbn, nb = r % nbn; j.src = (W_) + (size_t)(128 * kb) * (Nn) + 256 * nb; j.ldw = (Nn); \
        j.dst = (unsigned char*)(F.ws + (DST_)) + ((size_t)(256 * nb) * (Kk) + 128 * kb) * 2; j.Kd = (Kk); return j; }
    if (r < T_IN) { const int kb = r / 44, nb = r % 44, n0 = 256 * nb; j.src = F.in[I_WIN] + (size_t)(128 * kb) * IN_COLS + n0 + (n0 >= 4096 ? 8 : 0); j.ldw = IN_COLS; j.Kd = D;
        if (nb >= 12) { const int t8 = nb - 12; j.fp8 = 1; j.dst = (unsigned char*)(F.ws + WS_WIN8) + (size_t)(256 * t8) * D + 128 * kb; }
        else j.dst = (unsigned char*)(F.ws + WS_WIN) + ((size_t)n0 * D + 128 * kb) * 2;
        return j; } r -= T_IN;
    if (r < T_BM) { const int kb = r / 8, nb = r % 8; j.src = F.in[I_WBM] + (size_t)(128 * kb) * D + 256 * nb; j.ldw = D; j.dst = (unsigned char*)(F.ws + WS_WBM) + ((size_t)(256 * nb) * 2048 + 128 * kb) * 2; j.Kd = 2048; return j; } r -= T_BM;
    if (r < T_BA) { const int kb = r / 8, nb = r % 8; j.src = F.in[I_WBA] + (size_t)(128 * kb) * D + 256 * nb; j.ldw = D; j.dst = (unsigned char*)(F.ws + WS_WBM) + ((size_t)(256 * nb) * 2048 + 1024 + 128 * kb) * 2; j.Kd = 2048; return j; } r -= T_BA;
    if (r < T_OUT) TJ_DENSE(F.in[I_WOUT], D, D, WS_WOUT) r -= T_OUT;
    if (r < T_Q) { const int kb = r / 2, nb = r % 2; j.src = F.in[I_WQ] + (size_t)(128 * kb) * XW + 256 * nb; j.ldw = XW; j.dst = (unsigned char*)(F.ws + WS_WQ) + ((size_t)(256 * nb) * D + 128 * kb) * 2; j.Kd = D; j.kscale = F.in[I_NXW] + 128 * kb; return j; } r -= T_Q;
    if (r < T_KV) TJ_DENSE(F.in[I_WKV], D, 2 * XW, WS_WKV) r -= T_KV;
    if (r < T_O) TJ_DENSE(F.in[I_WO], XW, D, WS_WO) r -= T_O;
#undef TJ_DENSE
    j.fp8 = 1;
    if (r < NE * T_GU) { const int e = r / T_GU, q = r % T_GU, kb = q / 16, nb = q % 16; j.src = F.in[I_WGU] + (size_t)e * D * (2 * DFF) + (size_t)(128 * kb) * (2 * DFF) + 256 * nb; j.ldw = 2 * DFF;
        j.dst = (unsigned char*)(F.ws + WS_WGU) + (size_t)e * (2 * DFF) * D + 128 * kb; j.Kd = D; j.rowmap = 1 + 256 * nb; return j; }
    r -= NE * T_GU;
    { const int e = r / T_DN, q = r % T_DN, kb = q / 8, nb = q % 8; j.src = F.in[I_WDN] + (size_t)e * DFF * D + (size_t)(128 * kb) * D + 256 * nb; j.ldw = D;
        j.dst = (unsigned char*)(F.ws + WS_WDN) + (size_t)e * D * DFF + (size_t)(256 * nb) * DFF + 128 * kb; j.Kd = DFF; return j; }
}
__device__ __forceinline__ void tile_load(const TJob& j, f32x4 (&rv)[16], int tid) {
    const float* p = j.src + (size_t)(tid >> 6) * j.ldw + 4 * (tid & 63);
#pragma unroll
    for (int i = 0; i < 16; ++i) rv[i] = __builtin_nontemporal_load((const GAS f32x4*)(p + (size_t)(8 * i) * j.ldw));
}

__device__ __forceinline__ void weight_tiles(Frame& F, int t0, int t1, int wi, int nw, const bool rev = false) {
#define WT_IDX(x) (rev ? (t0 + t1 - 1 - (x)) : (x))
        LAS float* tile = (LAS float*)(F.lds + RING_OFF);
        f32x4 rv[16], rn[16];
        int tt = t0 + wi;
        if (tt < t1) { const TJob j = tile_job(F, WT_IDX(tt)); tile_load(j, rv, F.tid); }
        for (; tt < t1; tt += nw) {
#pragma unroll
            for (int i = 0; i < 16; ++i) { const int k = (F.tid >> 6) + 8 * i, n4 = 4 * (F.tid & 63); *(LAS f32x4*)(tile + k * 256 + (n4 ^ (((k >> 4) & 7) << 2))) = rv[i]; }
            { const TJob jc = tile_job(F, WT_IDX(tt));
              if (jc.kscale) {
                  __syncthreads();
#pragma unroll
                  for (int i = 0; i < 16; ++i) { const int k = (F.tid >> 6) + 8 * i, n4 = 4 * (F.tid & 63); LAS f32x4* p = (LAS f32x4*)(tile + k * 256 + (n4 ^ (((k >> 4) & 7) << 2))); *p = *p * jc.kscale[k]; } } }
            __syncthreads();
            const bool more = tt + nw < t1;
            if (more) { const TJob jn = tile_job(F, WT_IDX(tt + nw)); tile_load(jn, rn, F.tid); }
            const TJob j = tile_job(F, WT_IDX(tt));
#pragma unroll
            for (int i = 0; i < 4; ++i) { const int p = F.tid + NTHR * i, c = p & 7, n = p >> 3;
                const LAS float* s = tile + (16 * c) * 256 + (n ^ (c << 2));
                size_t drow;
                if (j.rowmap) { const int sc = (j.rowmap - 1) + n, bj = sc / DFF, cc = sc % DFF; drow = (size_t)((cc / 128) * 256 + bj * 128 + (cc % 128)); } else drow = (size_t)n;
                if (j.fp8) {
                    v4u o; o.x = pg8::pk_fp8x4(s[0 * 256] * WSCALE, s[1 * 256] * WSCALE, s[2 * 256] * WSCALE, s[3 * 256] * WSCALE); o.y = pg8::pk_fp8x4(s[4 * 256] * WSCALE, s[5 * 256] * WSCALE, s[6 * 256] * WSCALE, s[7 * 256] * WSCALE);
                    o.z = pg8::pk_fp8x4(s[8 * 256] * WSCALE, s[9 * 256] * WSCALE, s[10 * 256] * WSCALE, s[11 * 256] * WSCALE); o.w = pg8::pk_fp8x4(s[12 * 256] * WSCALE, s[13 * 256] * WSCALE, s[14 * 256] * WSCALE, s[15 * 256] * WSCALE);
                    *(GAS v4u*)(j.dst + drow * j.Kd + 16 * c) = o;
                } else {
                    v4u o0, o1; o0.x = pk2(s[0 * 256], s[1 * 256]); o0.y = pk2(s[2 * 256], s[3 * 256]); o0.z = pk2(s[4 * 256], s[5 * 256]); o0.w = pk2(s[6 * 256], s[7 * 256]);
                    o1.x = pk2(s[8 * 256], s[9 * 256]); o1.y = pk2(s[10 * 256], s[11 * 256]); o1.z = pk2(s[12 * 256], s[13 * 256]); o1.w = pk2(s[14 * 256], s[15 * 256]);
                    GAS v4u* o = (GAS v4u*)(j.dst + (drow * j.Kd + 16 * c) * 2); o[0] = o0; o[1] = o1;
                } }
            __syncthreads();
            if (more) {
#pragma unroll
                for (int i = 0; i < 16; ++i) rv[i] = rn[i]; }
        }
#undef WT_IDX
}

__device__ __forceinline__ void p0_prologue(Frame& F) {
    frame_ids(F);
    const int gw = F.vcu * NWAVES + F.wave, NGW = F.G * NWAVES;
    bf16* WIN = (bf16*)(F.ws + WS_WIN);
    {
        LAS float* scr = (LAS float*)(F.lds + RING_OFF + F.wave * 16384);
        for (int it = gw; it < 32; it += NGW) tr_dense(F.in[I_WR], D, NE, (bf16*)(F.ws + WS_WR), scr, it, F.lane);
        __syncthreads();
        weight_tiles(F, 0, NTILES - NT_LATE - NT_GU, F.vcu, F.G, true);
    }
    __syncthreads();
    {
        LAS float* wg = (LAS float*)(F.lds + RING_OFF);
        for (int i = F.tid; i < 8 * D; i += NTHR) { const int k = i >> 3, g = i & 7; wg[g * D + k] = F.in[I_WIN][(size_t)k * IN_COLS + 4096 + g]; }
        __syncthreads();
        bf16* H = (bf16*)(F.ws + WS_H); float* IFG = (float*)(F.ws + WS_IFG);
        const float* nw = F.in[I_NMIXW];
        for (int m = gw; m < T; m += NGW) {
            const GAS f32x4* xr = (const GAS f32x4*)(F.in[I_X] + (size_t)m * D) + F.lane;
            f32x4 v[8]; float s = 0.f;
#pragma unroll
            for (int j = 0; j < 8; ++j) { v[j] = __builtin_nontemporal_load(xr + 64 * j); s += (v[j].x * v[j].x + v[j].y * v[j].y) + (v[j].z * v[j].z + v[j].w * v[j].w); }
            const float rstd = 1.f / sqrtf(wave_sum(s) * (1.f / D) + EPS);
            const GAS f32x4* wr = (const GAS f32x4*)nw + F.lane;
            GAS v2u* o8 = (GAS v2u*)(H + (size_t)m * D) + F.lane; GAS unsigned* h8 = (GAS unsigned*)((unsigned char*)(F.ws + WS_H8) + (size_t)m * D) + F.lane;
#pragma unroll
            for (int j = 0; j < 8; ++j) { const f32x4 ww = wr[64 * j]; v[j].x *= rstd * ww.x; v[j].y *= rstd * ww.y; v[j].z *= rstd * ww.z; v[j].w *= rstd * ww.w;
                v2u o; o.x = pk2(v[j].x, v[j].y); o.y = pk2(v[j].z, v[j].w); o8[64 * j] = o;
                h8[64 * j] = pg8::pk_fp8x4(v[j].x * HSCALE, v[j].y * HSCALE, v[j].z * HSCALE, v[j].w * HSCALE); }
            float ga8[8];
#pragma unroll
            for (int g = 0; g < 8; ++g) ga8[g] = 0.f;
#pragma unroll 2
            for (int j = 0; j < 8; ++j)
#pragma unroll
                for (int g = 0; g < 8; ++g) { const f32x4 ww = *(const LAS f32x4*)(wg + g * D + 256 * j + 4 * F.lane); ga8[g] += (v[j].x * ww.x + v[j].y * ww.y) + (v[j].z * ww.z + v[j].w * ww.w); }
            { const bool h5 = (F.lane & 32) != 0, h4 = (F.lane & 16) != 0, h3 = (F.lane & 8) != 0; float b4[4], c2[2], d1;
#pragma unroll
              for (int i = 0; i < 4; ++i) { const float snd = h5 ? ga8[i] : ga8[i + 4], kp = h5 ? ga8[i + 4] : ga8[i]; b4[i] = kp + __shfl_xor(snd, 32); }
#pragma unroll
              for (int i = 0; i < 2; ++i) { const float snd = h4 ? b4[i] : b4[i + 2], kp = h4 ? b4[i + 2] : b4[i]; c2[i] = kp + __shfl_xor(snd, 16); }
              { const float snd = h3 ? c2[0] : c2[1], kp = h3 ? c2[1] : c2[0]; d1 = kp + __shfl_xor(snd, 8); }
              d1 += __shfl_xor(d1, 4); d1 += __shfl_xor(d1, 2); d1 += __shfl_xor(d1, 1);
              if ((F.lane & 7) == 0) { const int g = F.lane >> 3; IFG[(size_t)m * 8 + g] = d1 + F.in[I_IFB][g]; } }
        }
        bf16* MEMN = (bf16*)(F.ws + WS_MEMN);
        for (int m = gw; m < BATCH * NMEM; m += NGW) rms_row_to_bf16(F.in[I_MEM] + (size_t)m * D, F.in[I_NMEMW], MEMN + (size_t)m * D, F.lane);
        __syncthreads();
    }

}

__device__ __forceinline__ void p_conv(Frame& F) {
    frame_ids(F);
    const bf16* PROJ = (const bf16*)(F.ws + WS_PROJ); bf16* QKC = (bf16*)(F.ws + WS_QKC);
    const float* cw = F.in[I_CONVW]; const float* cb = F.in[I_CONVB];
    const int gt = F.vcu * NTHR + F.tid, NGT = F.G * NTHR;
    for (int q = gt; q < 256 * (T / 32); q += NGT) {
        const int c0 = (q & 255) * 8, t0 = (q >> 8) * 32, s0 = t0 & (SEQ - 1);
        float wgt[4][8], bias[8];
#pragma unroll
        for (int j = 0; j < 4; ++j) { const f32x4 w0 = *(const GAS f32x4*)(cw + j * 2048 + c0), w1 = *(const GAS f32x4*)(cw + j * 2048 + c0 + 4);
            wgt[j][0] = w0.x; wgt[j][1] = w0.y; wgt[j][2] = w0.z; wgt[j][3] = w0.w; wgt[j][4] = w1.x; wgt[j][5] = w1.y; wgt[j][6] = w1.z; wgt[j][7] = w1.w; }
        { const f32x4 b0 = *(const GAS f32x4*)(cb + c0), b1 = *(const GAS f32x4*)(cb + c0 + 4); bias[0] = b0.x; bias[1] = b0.y; bias[2] = b0.z; bias[3] = b0.w; bias[4] = b1.x; bias[5] = b1.y; bias[6] = b1.z; bias[7] = b1.w; }
        const float sc = (c0 >= 1024) ? 0.0625f : 1.f;
        const bf16* src = PROJ + (size_t)t0 * NPROJ + c0;
        v4u h0 = (v4u){0u, 0u, 0u, 0u}, h1 = h0, h2 = h0;
        if (s0 > 0) { h0 = *(const GAS v4u*)(src - 3 * (size_t)NPROJ); h1 = *(const GAS v4u*)(src - 2 * (size_t)NPROJ); h2 = *(const GAS v4u*)(src - (size_t)NPROJ); }
        for (int i0 = 0; i0 < 32; i0 += 8) {
            v4u rw[8];
#pragma unroll
            for (int i = 0; i < 8; ++i) rw[i] = *(const GAS v4u*)(src + (size_t)(i0 + i) * NPROJ);
#pragma unroll
            for (int i = 0; i < 8; ++i) { const v4u h3 = rw[i]; float a[8];
#pragma unroll
                for (int e = 0; e < 4; ++e) { const unsigned u0 = h0[e], u1 = h1[e], u2 = h2[e], u3 = h3[e];
                    a[2 * e] = bias[2 * e] + bflo(u0) * wgt[0][2 * e] + bflo(u1) * wgt[1][2 * e] + bflo(u2) * wgt[2][2 * e] + bflo(u3) * wgt[3][2 * e];
                    a[2 * e + 1] = bias[2 * e + 1] + bfhi(u0) * wgt[0][2 * e + 1] + bfhi(u1) * wgt[1][2 * e + 1] + bfhi(u2) * wgt[2][2 * e + 1] + bfhi(u3) * wgt[3][2 * e + 1]; }
#pragma unroll
                for (int e = 0; e < 8; ++e) a[e] = a[e] * sigm(a[e]) * sc;
                v4u o; o.x = pk2(a[0], a[1]); o.y = pk2(a[2], a[3]); o.z = pk2(a[4], a[5]); o.w = pk2(a[6], a[7]);
                *(GAS v4u*)(QKC + (size_t)(t0 + i0 + i) * 2048 + c0) = o;
                h0 = h1; h1 = h2; h2 = h3; }
        }
    }
}

constexpr int TP = 72;
__device__ __forceinline__ int tp_col(int c8, int s) { return c8 * TP + ((((s >> 3) ^ ((c8 >> 3) & 7)) << 3) | (s & 7)); }
__device__ __forceinline__ int tp_chunk(int r, int chunk) { return r * TP + ((chunk ^ ((r >> 3) & 7)) << 3); }
__device__ __forceinline__ void p_mlstm_local(Frame& F) {
    frame_ids(F);
    const bf16* PROJ = (const bf16*)(F.ws + WS_PROJ); const bf16* QKC = (const bf16*)(F.ws + WS_QKC); const float* IFG = (const float*)(F.ws + WS_IFG);
    float* BCUM = (float*)(F.ws + WS_BCUM); bf16* CLOC = (bf16*)(F.ws + WS_CLOC); float* NLOC = (float*)(F.ws + WS_NLOC);
    float* CHA = (float*)(F.ws + WS_CHS); float* CHG = CHA + 1024;
    LAS bf16* Kt = (LAS bf16*)(F.lds + RING_OFF);
    LAS bf16* Vt = Kt + 256 * TP;
    LAS float* es = (LAS float*)(Vt + 256 * TP);
    const int lane = F.lane, w = F.wave, hh = lane >> 5, l31 = lane & 31;
    v4u rk[4], rv[4]; float ipn = 0.f, fpn = 0.f;
#define ML_LOAD(uu) do { const int bh_ = (uu) >> 7, c_ = (uu) & 127, b_ = bh_ >> 2, h_ = bh_ & 3, t0_ = b_ * SEQ + c_ * CHUNK; \
        _Pragma("unroll") for (int i = 0; i < 4; ++i) { const int p = F.tid + NTHR * i, s = p >> 5, c8 = (p & 31) * 8; \
            rk[i] = *(const GAS v4u*)(QKC + (size_t)(t0_ + s) * 2048 + 1024 + h_ * 256 + c8); rv[i] = *(const GAS v4u*)(PROJ + (size_t)(t0_ + s) * NPROJ + PV_M + h_ * 256 + c8); } \
        if (w == 0) { ipn = IFG[(size_t)(t0_ + lane) * 8 + h_]; fpn = IFG[(size_t)(t0_ + lane) * 8 + 4 + h_]; } } while (0)
    if (F.vcu < 1024) ML_LOAD(F.vcu);
    for (int u = F.vcu; u < 1024; u += F.G) {
        const int bh = u >> 7, c = u & 127, b = bh >> 2, h = bh & 3, t0 = b * SEQ + c * CHUNK;
        if (w == 0) {
            const float ip = ipn, fp = fpn;
            const float lf = fminf(fp, 0.f) - log1pf(__expf(-fabsf(fp)));
            float bc = lf;
#pragma unroll
            for (int o = 1; o < 64; o <<= 1) { const float y = __shfl_up(bc, o); if (lane >= o) bc += y; }
            const float g = __shfl(bc, 63), we = g - bc + ip, a = wave_max(we);
            es[lane] = __expf(we - a);
            BCUM[(size_t)(t0 + lane) * 4 + h] = bc;
            if (lane == 0) { CHA[u] = a; CHG[u] = g; }
        }
        __syncthreads();
#pragma unroll
        for (int i = 0; i < 4; ++i) { const int p = F.tid + NTHR * i, s = p >> 5, c8 = (p & 31) * 8;
            const v4u kv = rk[i], vv = rv[i];
            const float e = es[s];
            LAS bf16* kd = Kt + tp_col(c8, s); LAS bf16* vd = Vt + tp_col(c8, s);
            kd[0 * TP] = (bf16)(kv.x & 0xffff); kd[1 * TP] = (bf16)(kv.x >> 16); kd[2 * TP] = (bf16)(kv.y & 0xffff); kd[3 * TP] = (bf16)(kv.y >> 16);
            kd[4 * TP] = (bf16)(kv.z & 0xffff); kd[5 * TP] = (bf16)(kv.z >> 16); kd[6 * TP] = (bf16)(kv.w & 0xffff); kd[7 * TP] = (bf16)(kv.w >> 16);
            vd[0 * TP] = f2bf(bflo(vv.x) * e); vd[1 * TP] = f2bf(bfhi(vv.x) * e); vd[2 * TP] = f2bf(bflo(vv.y) * e); vd[3 * TP] = f2bf(bfhi(vv.y) * e);
            vd[4 * TP] = f2bf(bflo(vv.z) * e); vd[5 * TP] = f2bf(bfhi(vv.z) * e); vd[6 * TP] = f2bf(bflo(vv.w) * e); vd[7 * TP] = f2bf(bfhi(vv.w) * e); }
        __syncthreads();
        if (u + F.G < 1024) ML_LOAD(u + F.G);
        bf16x8 af[4];
#pragma unroll
        for (int ks = 0; ks < 4; ++ks) af[ks] = *(const LAS bf16x8*)(Kt + tp_chunk(32 * w + l31, 2 * ks + hh));
        bf16* Cu = CLOC + (size_t)u * 65536;
#pragma unroll 2
        for (int ni = 0; ni < 8; ++ni) {
            f32x16 acc = {0.f, 0.f, 0.f, 0.f, 0.f, 0.f, 0.f, 0.f, 0.f, 0.f, 0.f, 0.f, 0.f, 0.f, 0.f, 0.f};
#pragma unroll
            for (int ks = 0; ks < 4; ++ks) { const bf16x8 bfr = *(const LAS bf16x8*)(Vt + tp_chunk(32 * ni + l31, 2 * ks + hh)); acc = mfma32(af[ks], bfr, acc); }
            const int v = 32 * ni + l31;
#pragma unroll
            for (int rg = 0; rg < 4; ++rg) { v2u o; o.x = pk2(acc[4 * rg], acc[4 * rg + 1]); o.y = pk2(acc[4 * rg + 2], acc[4 * rg + 3]);
                *(GAS v2u*)(Cu + (size_t)w * 8192 + v * 32 + 8 * rg + 4 * hh) = o; }
        }
        if (F.tid < 256) { float a = 0.f;
#pragma unroll
            for (int cch = 0; cch < 8; ++cch) { const v4u kq = *(const LAS v4u*)(Kt + tp_chunk(F.tid, cch)); const LAS float* e8 = es + 8 * cch;
                a += e8[0] * bflo(kq.x); a += e8[1] * bfhi(kq.x); a += e8[2] * bflo(kq.y); a += e8[3] * bfhi(kq.y); a += e8[4] * bflo(kq.z); a += e8[5] * bfhi(kq.z); a += e8[6] * bflo(kq.w); a += e8[7] * bfhi(kq.w); }
            NLOC[(size_t)u * 256 + F.tid] = a; }
        __syncthreads();
    }
#undef ML_LOAD
}

__device__ __forceinline__ void p_mlstm_scan(Frame& F) {
    frame_ids(F);
    const bf16* CLOC = (const bf16*)(F.ws + WS_CLOC); bf16* CIN = (bf16*)(F.ws + WS_CIN);
    const float* NLOC = (const float*)(F.ws + WS_NLOC); float* NIN = (float*)(F.ws + WS_NIN);
    const float* CHA = (const float*)(F.ws + WS_CHS); const float* CHG = CHA + 1024; float* CHM = (float*)(F.ws + WS_CHS) + 2048;
    const int gt = F.vcu * NTHR + F.tid, NGT = F.G * NTHR;
    if (F.tid < 8) { for (int q = F.vcu * 8 + F.tid; q < 8 * 256; q += F.G * 8) {
        const int bh = q >> 8, k = q & 255; float m = 0.f, n = 0.f;
        for (int c0 = 0; c0 < NCH; c0 += 32) { float nl[32], aa[32], gg[32];
#pragma unroll
            for (int i = 0; i < 32; ++i) { const int u = bh * NCH + c0 + i; nl[i] = NLOC[(size_t)u * 256 + k]; aa[i] = CHA[u]; gg[i] = CHG[u]; }
#pragma unroll
            for (int i = 0; i < 32; ++i) { const int u = bh * NCH + c0 + i;
                const float mn = fmaxf(gg[i] + m, aa[i]), sp = __expf(gg[i] + m - mn), sl = __expf(aa[i] - mn);
                NIN[(size_t)u * 256 + k] = n; n = sp * n + sl * nl[i]; m = mn; } } } }
    for (int q = gt; q < 8 * 16384; q += NGT) {
        const int bh = q >> 14; const size_t off = (size_t)(q & 16383) * 4;
        float m = 0.f, C0 = 0.f, C1 = 0.f, C2 = 0.f, C3 = 0.f;
        for (int c0 = 0; c0 < NCH; c0 += 16) {
            v2u cl[16]; float aa[16], gg[16];
#pragma unroll
            for (int i = 0; i < 16; ++i) { const int u = bh * NCH + c0 + i; cl[i] = *(const GAS v2u*)(CLOC + (size_t)u * 65536 + off); aa[i] = CHA[u]; gg[i] = CHG[u]; }
#pragma unroll
            for (int i = 0; i < 16; ++i) { const int u = bh * NCH + c0 + i;
                const float mn = fmaxf(gg[i] + m, aa[i]), sp = __expf(gg[i] + m - mn), sl = __expf(aa[i] - mn);
                v2u o; o.x = pk2(C0, C1); o.y = pk2(C2, C3);
                *(GAS v2u*)(CIN + (size_t)u * 65536 + off) = o;
                if (off == 0) CHM[u] = m;
                C0 = sp * C0 + sl * bflo(cl[i].x); C1 = sp * C1 + sl * bfhi(cl[i].x); C2 = sp * C2 + sl * bflo(cl[i].y); C3 = sp * C3 + sl * bfhi(cl[i].y);
                m = mn; }
        }
    }
}

constexpr int QP = 264;
__device__ __forceinline__ void p_mlstm_out(Frame& F) {
    frame_ids(F);
    const bf16* PROJ = (const bf16*)(F.ws + WS_PROJ); const bf16* QKC = (const bf16*)(F.ws + WS_QKC); const float* IFG = (const float*)(F.ws + WS_IFG);
    const float* BCUM = (const float*)(F.ws + WS_BCUM); const bf16* CIN = (const bf16*)(F.ws + WS_CIN); const float* NIN = (const float*)(F.ws + WS_NIN);
    const float* CHM = (const float*)(F.ws + WS_CHS) + 2048; bf16* HM = (bf16*)(F.ws + WS_HM); const float* hnw = F.in[I_MHNW];
    LAS bf16* Qs = (LAS bf16*)(F.lds + RING_OFF);
    LAS bf16* Ks = Qs + 64 * QP;
    LAS bf16* Vt = Ks + 64 * QP;
    LAS bf16* Sm = Vt + 256 * TP;
    LAS float* fb = (LAS float*)(Sm + 64 * TP);
    LAS float* fi = fb + 64; LAS float* fmj = fb + 128; LAS float* fwi = fb + 192; LAS float* dpart = fb + 256; LAS float* dint = fb + 384; LAS float* hpart = fb + 448;
    const int lane = F.lane, w = F.wave, hh = lane >> 5, l31 = lane & 31;
    v4u rq[4], rk[4], rv[4]; float bjn = 0.f, ijn = 0.f, minn = 0.f;
#define MO_LOAD(uu) do { const int bh_ = (uu) >> 7, c_ = (uu) & 127, b_ = bh_ >> 2, h_ = bh_ & 3, t0_ = b_ * SEQ + c_ * CHUNK; \
        _Pragma("unroll") for (int i = 0; i < 4; ++i) { const int p = F.tid + NTHR * i, s = p >> 5, c8 = (p & 31) * 8; \
            rq[i] = *(const GAS v4u*)(QKC + (size_t)(t0_ + s) * 2048 + h_ * 256 + c8); rk[i] = *(const GAS v4u*)(QKC + (size_t)(t0_ + s) * 2048 + 1024 + h_ * 256 + c8); \
            rv[i] = *(const GAS v4u*)(PROJ + (size_t)(t0_ + s) * NPROJ + PV_M + h_ * 256 + c8); } \
        if (w == 0) { bjn = BCUM[(size_t)(t0_ + lane) * 4 + h_]; ijn = IFG[(size_t)(t0_ + lane) * 8 + h_]; minn = CHM[(uu)]; } } while (0)
    if (F.vcu < 1024) MO_LOAD(F.vcu);
    for (int u = F.vcu; u < 1024; u += F.G) {
        const int bh = u >> 7, c = u & 127, b = bh >> 2, h = bh & 3, t0 = b * SEQ + c * CHUNK;
        bf16x8 cf[16];
        { const bf16* Cu = CIN + (size_t)u * 65536 + (size_t)(32 * w + l31) * 32 + 8 * hh;
#pragma unroll
            for (int ks = 0; ks < 16; ++ks) cf[ks] = *(const GAS bf16x8*)(Cu + (ks >> 1) * 8192 + 16 * (ks & 1)); }
#pragma unroll
        for (int i = 0; i < 4; ++i) { const int p = F.tid + NTHR * i, s = p >> 5, c8 = (p & 31) * 8;
            const v4u vv = rv[i];
            *(LAS v4u*)(Qs + s * QP + c8) = rq[i]; *(LAS v4u*)(Ks + s * QP + c8) = rk[i];
            LAS bf16* vd = Vt + tp_col(c8, s);
            vd[0 * TP] = (bf16)(vv.x & 0xffff); vd[1 * TP] = (bf16)(vv.x >> 16); vd[2 * TP] = (bf16)(vv.y & 0xffff); vd[3 * TP] = (bf16)(vv.y >> 16);
            vd[4 * TP] = (bf16)(vv.z & 0xffff); vd[5 * TP] = (bf16)(vv.z >> 16); vd[6 * TP] = (bf16)(vv.w & 0xffff); vd[7 * TP] = (bf16)(vv.w >> 16); }
        if (w == 0) {
            const float bj = bjn, ij = ijn, m_in = minn;
            float pm = ij - bj;
#pragma unroll
            for (int o = 1; o < 64; o <<= 1) { const float y = __shfl_up(pm, o); if (lane >= o) pm = fmaxf(pm, y); }
            const float il = bj + m_in, mj = fmaxf(il, bj + pm);
            fb[lane] = bj; fi[lane] = ij; fmj[lane] = mj; fwi[lane] = __expf(il - mj);
        }
        __syncthreads();
        if (u + F.G < 1024) MO_LOAD(u + F.G);
        if (w < 4) {
            const int tj = w >> 1, ts = w & 1;
            f32x16 acc = {0.f, 0.f, 0.f, 0.f, 0.f, 0.f, 0.f, 0.f, 0.f, 0.f, 0.f, 0.f, 0.f, 0.f, 0.f, 0.f};
#pragma unroll
            for (int ks = 0; ks < 16; ++ks) { const bf16x8 a = *(const LAS bf16x8*)(Qs + (32 * tj + l31) * QP + 16 * ks + 8 * hh);
                const bf16x8 bb = *(const LAS bf16x8*)(Ks + (32 * ts + l31) * QP + 16 * ks + 8 * hh); acc = mfma32(a, bb, acc); }
            const int s = 32 * ts + l31; const float cs = fi[s] - fb[s];
#pragma unroll
            for (int r = 0; r < 16; ++r) { const int j = 32 * tj + (r & 3) + 8 * (r >> 2) + 4 * hh;
                const float p = (s <= j) ? acc[r] * __expf(fb[j] - fmj[j] + cs) : 0.f;
                Sm[j * TP + s] = f2bf(p);
                float v = p; v += __shfl_xor(v, 1); v += __shfl_xor(v, 2); v += __shfl_xor(v, 4); v += __shfl_xor(v, 8); v += __shfl_xor(v, 16);
                if (l31 == 0) dpart[ts * 64 + j] = v; }
        } else {
            const int tt = F.tid - 256, j = tt >> 2, part = tt & 3; float a = 0.f;
            const GAS f32x4* nin = (const GAS f32x4*)(NIN + (size_t)u * 256 + part * 64);
#pragma unroll
            for (int hb = 0; hb < 4; ++hb) { f32x4 nv[4];
#pragma unroll
                for (int k4 = 0; k4 < 4; ++k4) nv[k4] = nin[4 * hb + k4];
#pragma unroll
                for (int k4 = 0; k4 < 4; ++k4) { const v2u qw = *(const LAS v2u*)(Qs + j * QP + part * 64 + 16 * hb + 4 * k4);
                    a += nv[k4].x * bflo(qw.x) + nv[k4].y * bfhi(qw.x) + nv[k4].z * bflo(qw.y) + nv[k4].w * bfhi(qw.y); } }
            a += __shfl_xor(a, 1); a += __shfl_xor(a, 2);
            if (part == 0) dint[j] = fwi[j] * a;
        }
        __syncthreads();
        f32x16 acc[2];
#pragma unroll
        for (int tj = 0; tj < 2; ++tj) acc[tj] = (f32x16){0.f, 0.f, 0.f, 0.f, 0.f, 0.f, 0.f, 0.f, 0.f, 0.f, 0.f, 0.f, 0.f, 0.f, 0.f, 0.f};
#pragma unroll
        for (int ks = 0; ks < 16; ++ks) { const bf16x8 a = cf[ks];
#pragma unroll
            for (int tj = 0; tj < 2; ++tj) { const bf16x8 bq = *(const LAS bf16x8*)(Qs + (32 * tj + l31) * QP + 16 * ks + 8 * hh); acc[tj] = mfma32(a, bq, acc[tj]); } }
#pragma unroll
        for (int tj = 0; tj < 2; ++tj) { const float wi = fwi[32 * tj + l31];
#pragma unroll
            for (int r = 0; r < 16; ++r) acc[tj][r] *= wi; }
#pragma unroll
        for (int ks = 0; ks < 4; ++ks) { const bf16x8 a = *(const LAS bf16x8*)(Vt + tp_chunk(32 * w + l31, 2 * ks + hh));
#pragma unroll
            for (int tj = 0; tj < 2; ++tj) { const bf16x8 bs = *(const LAS bf16x8*)(Sm + (32 * tj + l31) * TP + 16 * ks + 8 * hh); acc[tj] = mfma32(a, bs, acc[tj]); } }
#pragma unroll
        for (int tj = 0; tj < 2; ++tj) { const int j = 32 * tj + l31; const float den = (dpart[j] + dpart[64 + j]) + dint[j];
            const float inv = 1.f / fmaxf(fabsf(den), __expf(-fmj[j])); float q2 = 0.f;
#pragma unroll
            for (int r = 0; r < 16; ++r) { acc[tj][r] *= inv; q2 += acc[tj][r] * acc[tj][r]; }
            q2 += __shfl_xor(q2, 32);
            if (hh == 0) hpart[w * 64 + j] = q2; }
        __syncthreads();
        f32x4 nwv[4]; v2u ogv[2][4];
#pragma unroll
        for (int rg = 0; rg < 4; ++rg) { const int v0 = 32 * w + 8 * rg + 4 * hh; nwv[rg] = *(const GAS f32x4*)(hnw + h * 256 + v0);
#pragma unroll
            for (int tj = 0; tj < 2; ++tj) ogv[tj][rg] = *(const GAS v2u*)(PROJ + (size_t)(t0 + 32 * tj + l31) * NPROJ + PO_M + h * 256 + v0); }
#pragma unroll
        for (int tj = 0; tj < 2; ++tj) { const int j = 32 * tj + l31; float hs = 0.f;
#pragma unroll
            for (int ww = 0; ww < 8; ++ww) hs += hpart[ww * 64 + j];
            const float rs = 1.f / sqrtf(hs * (1.f / MD) + EPS); const size_t t = (size_t)(t0 + j);
#pragma unroll
            for (int rg = 0; rg < 4; ++rg) { const int v0 = 32 * w + 8 * rg + 4 * hh;
                const f32x4 nw = nwv[rg];
                const v2u og = ogv[tj][rg];
                v2u o; o.x = pk2(acc[tj][4 * rg] * rs * nw.x * bflo(og.x), acc[tj][4 * rg + 1] * rs * nw.y * bfhi(og.x));
                o.y = pk2(acc[tj][4 * rg + 2] * rs * nw.z * bflo(og.y), acc[tj][4 * rg + 3] * rs * nw.w * bfhi(og.y));
                *(GAS v2u*)(HM + t * 2048 + h * 256 + v0) = o; } }
        __syncthreads();
    }
#undef MO_LOAD
}

template <int DH> struct AttnState { f32x16 ot[DH / 32]; bf16x8 qf[DH / 16]; float m_run, l_run; };
template <int DH, bool BAND>
__device__ __forceinline__ void attn_step(AttnState<DH>& A, const LAS bf16* Ks, const LAS bf16* Vt, const LAS float* relb, int dchunk, int qi, int lane) {
    constexpr int KP = DH + 8;
    const int hh = lane >> 5, l31 = lane & 31;
    f32x16 st[2];
#pragma unroll
    for (int kt = 0; kt < 2; ++kt) { st[kt] = (f32x16){0.f, 0.f, 0.f, 0.f, 0.f, 0.f, 0.f, 0.f, 0.f, 0.f, 0.f, 0.f, 0.f, 0.f, 0.f, 0.f};
#pragma unroll
        for (int ks = 0; ks < DH / 16; ++ks) { const bf16x8 a = *(const LAS bf16x8*)(Ks + (32 * kt + l31) * KP + 16 * ks + 8 * hh); st[kt] = mfma32(a, A.qf[ks], st[kt]); } }
    float mx = -1e30f, cadd = 0.f;
    if (BAND && dchunk < 3) {
        const int base4 = (64 * dchunk + qi - 4 * hh + 128) * 4;
#pragma unroll
        for (int kt = 0; kt < 2; ++kt)
#pragma unroll
            for (int r = 0; r < 16; ++r) { int i4 = base4 - 4 * (32 * kt + (r & 3) + 8 * (r >> 2)); i4 = i4 > 1024 ? 1024 : i4;
                const float s = st[kt][r] + *(const LAS float*)((const LAS char*)relb + i4); st[kt][r] = s; mx = fmaxf(mx, s); }
    } else {
#pragma unroll
        for (int kt = 0; kt < 2; ++kt)
#pragma unroll
            for (int r = 0; r < 16; ++r) mx = fmaxf(mx, st[kt][r]);
        if (BAND) { cadd = relb[256]; mx += cadd; }
    }
    mx = fmaxf(mx, __shfl_xor(mx, 32));
    const float mn = fmaxf(A.m_run, mx), alpha = __builtin_amdgcn_exp2f(A.m_run - mn), sh = cadd - mn;
    float sum = 0.f;
#pragma unroll
    for (int kt = 0; kt < 2; ++kt)
#pragma unroll
        for (int r = 0; r < 16; ++r) { const float p = __builtin_amdgcn_exp2f(st[kt][r] + sh); st[kt][r] = p; sum += p; }
    sum += __shfl_xor(sum, 32);
    A.l_run = A.l_run * alpha + sum; A.m_run = mn;
#pragma unroll
    for (int dt = 0; dt < DH / 32; ++dt)
#pragma unroll
        for (int r = 0; r < 16; ++r) A.ot[dt][r] *= alpha;
#pragma unroll
    for (int kt = 0; kt < 2; ++kt)
#pragma unroll
        for (int s2 = 0; s2 < 2; ++s2) {
            union { v4u u; bf16x8 v; } pf;
            pf.u.x = pk2(st[kt][8 * s2 + 0], st[kt][8 * s2 + 1]); pf.u.y = pk2(st[kt][8 * s2 + 2], st[kt][8 * s2 + 3]);
            pf.u.z = pk2(st[kt][8 * s2 + 4], st[kt][8 * s2 + 5]); pf.u.w = pk2(st[kt][8 * s2 + 6], st[kt][8 * s2 + 7]);
#pragma unroll
            for (int dt = 0; dt < DH / 32; ++dt) {
                const int vr = 32 * dt + l31, ch = 4 * kt + 2 * s2;
                union { v2u u[2]; bf16x8 v; } af; af.u[0] = *(const LAS v2u*)(Vt + tp_chunk(vr, ch) + 4 * hh); af.u[1] = *(const LAS v2u*)(Vt + tp_chunk(vr, ch + 1) + 4 * hh);
                A.ot[dt] = mfma32(af.v, pf.v, A.ot[dt]); } }
}
template <int DH> struct KVRegs { v4u k[(8 * DH) / NTHR], v[(8 * DH) / NTHR]; };
template <int DH>
__device__ __forceinline__ void attn_load(KVRegs<DH>& R, const bf16* kg, const bf16* vg, size_t pitch, int tid) {
    constexpr int PPR = DH / 8;
#pragma unroll
    for (int i = 0; i < (64 * PPR) / NTHR; ++i) { const int p = tid + NTHR * i, key = p / PPR, c8 = (p % PPR) * 8;
        R.k[i] = *(const GAS v4u*)(kg + (size_t)key * pitch + c8); R.v[i] = *(const GAS v4u*)(vg + (size_t)key * pitch + c8); }
}
template <int DH>
__device__ __forceinline__ void attn_put(LAS bf16* Ks, LAS bf16* Vt, const KVRegs<DH>& R, int tid) {
    constexpr int KP = DH + 8, PPR = DH / 8;
#pragma unroll
    for (int i = 0; i < (64 * PPR) / NTHR; ++i) { const int p = tid + NTHR * i, key = p / PPR, c8 = (p % PPR) * 8;
        const v4u vv = R.v[i];
        *(LAS v4u*)(Ks + key * KP + c8) = R.k[i];
        LAS bf16* vd = Vt + tp_col(c8, key);
        vd[0 * TP] = (bf16)(vv.x & 0xffff); vd[1 * TP] = (bf16)(vv.x >> 16); vd[2 * TP] = (bf16)(vv.y & 0xffff); vd[3 * TP] = (bf16)(vv.y >> 16);
        vd[4 * TP] = (bf16)(vv.z & 0xffff); vd[5 * TP] = (bf16)(vv.z >> 16); vd[6 * TP] = (bf16)(vv.w & 0xffff); vd[7 * TP] = (bf16)(vv.w >> 16); }
}
template <int DH>
__device__ __forceinline__ void attn_init(AttnState<DH>& A, const bf16* qrow, int lane) {
    const int hh = lane >> 5;
#pragma unroll
    for (int ks = 0; ks < DH / 16; ++ks) A.qf[ks] = *(const GAS bf16x8*)(qrow + 16 * ks + 8 * hh);
#pragma unroll
    for (int dt = 0; dt < DH / 32; ++dt) A.ot[dt] = (f32x16){0.f, 0.f, 0.f, 0.f, 0.f, 0.f, 0.f, 0.f, 0.f, 0.f, 0.f, 0.f, 0.f, 0.f, 0.f, 0.f};
    A.m_run = -1e30f; A.l_run = 0.f;
}
template <int DH>
__device__ __forceinline__ void attn_store(const AttnState<DH>& A, bf16* orow, int lane) {
    const int hh = lane >> 5; const float inv = 1.f / A.l_run;
#pragma unroll
    for (int dt = 0; dt < DH / 32; ++dt)
#pragma unroll
        for (int rg = 0; rg < 4; ++rg) { v2u o; o.x = pk2(A.ot[dt][4 * rg] * inv, A.ot[dt][4 * rg + 1] * inv); o.y = pk2(A.ot[dt][4 * rg + 2] * inv, A.ot[dt][4 * rg + 3] * inv);
            *(GAS v2u*)(orow + 32 * dt + 8 * rg + 4 * hh) = o; }
}

__device__ __forceinline__ void p_band_attn(Frame& F) {
    frame_ids(F);
    const bf16* PROJ = (const bf16*)(F.ws + WS_PROJ); bf16* YA = (bf16*)(F.ws + WS_HM) + 1024;
    constexpr int KSZ = 64 * (AD + 8), VSZ = AD * TP, BUF = KSZ + VSZ;
    LAS bf16* B0 = (LAS bf16*)(F.lds + RING_OFF);
    LAS float* relb = (LAS float*)(B0 + 2 * BUF);
    const int lane = F.lane, w = F.wave, l31 = lane & 31;
    for (int u = F.vcu; u < BATCH * AH * 32; u += F.G) {
        const int b = u >> 9, hd = (u >> 5) & 15, qt = u & 31;
        for (int i = F.tid; i < 257; i += NTHR) relb[i] = F.in[I_REL][hd * 257 + i] * 1.4426950408889634f;
        const int cw = 4 * qt + (w >> 1), qi = (w & 1) * 32 + l31; const size_t tq = (size_t)b * SEQ + cw * CHUNK + qi;
        AttnState<AD> A; attn_init<AD>(A, PROJ + tq * NPROJ + PQ_A + hd * AD, lane);
        const int kc0 = (4 * qt - 8) > 0 ? (4 * qt - 8) : 0, kc1 = 4 * qt + 3;
        const bf16* kbase = PROJ + (size_t)b * SEQ * NPROJ + PK_A + hd * AD; const bf16* vbase = PROJ + (size_t)b * SEQ * NPROJ + PV_A + hd * AD;
        KVRegs<AD> R0, R1;
        attn_load<AD>(R0, kbase + (size_t)kc0 * CHUNK * NPROJ, vbase + (size_t)kc0 * CHUNK * NPROJ, NPROJ, F.tid);
        if (kc0 + 1 <= kc1) attn_load<AD>(R1, kbase + (size_t)(kc0 + 1) * CHUNK * NPROJ, vbase + (size_t)(kc0 + 1) * CHUNK * NPROJ, NPROJ, F.tid);
        for (int kc = kc0; kc <= kc1; kc += 2) {
            { LAS bf16* Ks = B0; LAS bf16* Vt = Ks + KSZ;
              attn_put<AD>(Ks, Vt, R0, F.tid);
              __syncthreads();
              if (kc + 2 <= kc1) attn_load<AD>(R0, kbase + (size_t)(kc + 2) * CHUNK * NPROJ, vbase + (size_t)(kc + 2) * CHUNK * NPROJ, NPROJ, F.tid);
              if (kc >= cw - 8 && kc <= cw) attn_step<AD, true>(A, Ks, Vt, relb, cw - kc, qi, lane); }
            if (kc + 1 <= kc1) { LAS bf16* Ks = B0 + BUF; LAS bf16* Vt = Ks + KSZ;
              attn_put<AD>(Ks, Vt, R1, F.tid);
              __syncthreads();
              if (kc + 3 <= kc1) attn_load<AD>(R1, kbase + (size_t)(kc + 3) * CHUNK * NPROJ, vbase + (size_t)(kc + 3) * CHUNK * NPROJ, NPROJ, F.tid);
              if (kc + 1 >= cw - 8 && kc + 1 <= cw) attn_step<AD, true>(A, Ks, Vt, relb, cw - kc - 1, qi, lane); }
        }
        attn_store<AD>(A, YA + tq * 2048 + hd * AD, lane);
        __syncthreads();
    }
}

__device__ __forceinline__ void p_local_band(Frame& F) {
    frame_ids(F);
    const bf16* PROJ = (const bf16*)(F.ws + WS_PROJ); const bf16* QKC = (const bf16*)(F.ws + WS_QKC); const float* IFG = (const float*)(F.ws + WS_IFG);
    float* BCUM = (float*)(F.ws + WS_BCUM); bf16* CLOC = (bf16*)(F.ws + WS_CLOC); float* NLOC = (float*)(F.ws + WS_NLOC);
    float* CHA = (float*)(F.ws + WS_CHS); float* CHG = CHA + 1024;
    LAS bf16* Kt = (LAS bf16*)(F.lds + RING_OFF);
    LAS bf16* Vt = Kt + 256 * TP;
    LAS float* es = (LAS float*)(Vt + 256 * TP);
    const int lane = F.lane, w = F.wave, hh = lane >> 5, l31 = lane & 31;
    v4u rk[4], rv[4]; float ipn = 0.f, fpn = 0.f;
#define ML_LOAD(uu) do { const int bh_ = (uu) >> 7, c_ = (uu) & 127, b_ = bh_ >> 2, h_ = bh_ & 3, t0_ = b_ * SEQ + c_ * CHUNK; \
        _Pragma("unroll") for (int i = 0; i < 4; ++i) { const int p = F.tid + NTHR * i, s = p >> 5, c8 = (p & 31) * 8; \
            rk[i] = *(const GAS v4u*)(QKC + (size_t)(t0_ + s) * 2048 + 1024 + h_ * 256 + c8); rv[i] = *(const GAS v4u*)(PROJ + (size_t)(t0_ + s) * NPROJ + PV_M + h_ * 256 + c8); } } while (0)
#define ML_LOADG(uu) do { const int bh_ = (uu) >> 7, c_ = (uu) & 127, b_ = bh_ >> 2, h_ = bh_ & 3, t0_ = b_ * SEQ + c_ * CHUNK; \
        if (F.wave == 0) { ipn = IFG[(size_t)(t0_ + F.lane) * 8 + h_]; fpn = IFG[(size_t)(t0_ + F.lane) * 8 + 4 + h_]; } } while (0)
    const int par = F.vcu & 1;
    if (F.vcu < 1024) { ML_LOAD(F.vcu); ML_LOADG(F.vcu); }
    for (int i = 0; F.vcu + (i - par) * F.G < 1024; ++i) {
        const int ul = F.vcu + (i - par) * F.G, ub = F.vcu + i * F.G, uln = ul + F.G;
        if (ul >= 0) {
        const int u = ul;
        int lane = F.lane; asm volatile("" : "+v"(lane));
        const int tid_ = F.wave * 64 + lane, hh = lane >> 5, l31 = lane & 31;
        const int bh = u >> 7, c = u & 127, b = bh >> 2, h = bh & 3, t0 = b * SEQ + c * CHUNK;
        if (w == 0) {
            const float ip = ipn, fp = fpn;
            const float lf = fminf(fp, 0.f) - log1pf(__expf(-fabsf(fp)));
            float bc = lf;
#pragma unroll
            for (int o = 1; o < 64; o <<= 1) { const float y = __shfl_up(bc, o); if (lane >= o) bc += y; }
            const float g = __shfl(bc, 63), we = g - bc + ip, a = wave_max(we);
            es[lane] = __expf(we - a);
            BCUM[(size_t)(t0 + lane) * 4 + h] = bc;
            if (lane == 0) { CHA[u] = a; CHG[u] = g; }
        }
        __syncthreads();
#pragma unroll
        for (int i = 0; i < 4; ++i) { const int p = tid_ + NTHR * i, s = p >> 5, c8 = (p & 31) * 8;
            const v4u kv = rk[i], vv = rv[i];
            const float e = es[s];
            LAS bf16* kd = Kt + tp_col(c8, s); LAS bf16* vd = Vt + tp_col(c8, s);
            kd[0 * TP] = (bf16)(kv.x & 0xffff); kd[1 * TP] = (bf16)(kv.x >> 16); kd[2 * TP] = (bf16)(kv.y & 0xffff); kd[3 * TP] = (bf16)(kv.y >> 16);
            kd[4 * TP] = (bf16)(kv.z & 0xffff); kd[5 * TP] = (bf16)(kv.z >> 16); kd[6 * TP] = (bf16)(kv.w & 0xffff); kd[7 * TP] = (bf16)(kv.w >> 16);
            vd[0 * TP] = f2bf(bflo(vv.x) * e); vd[1 * TP] = f2bf(bfhi(vv.x) * e); vd[2 * TP] = f2bf(bflo(vv.y) * e); vd[3 * TP] = f2bf(bfhi(vv.y) * e);
            vd[4 * TP] = f2bf(bflo(vv.z) * e); vd[5 * TP] = f2bf(bfhi(vv.z) * e); vd[6 * TP] = f2bf(bflo(vv.w) * e); vd[7 * TP] = f2bf(bfhi(vv.w) * e); }
        __syncthreads();
        if (uln < 1024) { ML_LOAD(uln); ML_LOADG(uln); }
        bf16x8 af[4];
#pragma unroll
        for (int ks = 0; ks < 4; ++ks) af[ks] = *(const LAS bf16x8*)(Kt + tp_chunk(32 * w + l31, 2 * ks + hh));
        bf16* Cu = CLOC + (size_t)u * 65536;
#pragma unroll 2
        for (int ni = 0; ni < 8; ++ni) {
            f32x16 acc = {0.f, 0.f, 0.f, 0.f, 0.f, 0.f, 0.f, 0.f, 0.f, 0.f, 0.f, 0.f, 0.f, 0.f, 0.f, 0.f};
#pragma unroll
            for (int ks = 0; ks < 4; ++ks) { const bf16x8 bfr = *(const LAS bf16x8*)(Vt + tp_chunk(32 * ni + l31, 2 * ks + hh)); acc = mfma32(af[ks], bfr, acc); }
            const int v = 32 * ni + l31;
#pragma unroll
            for (int rg = 0; rg < 4; ++rg) { v2u o; o.x = pk2(acc[4 * rg], acc[4 * rg + 1]); o.y = pk2(acc[4 * rg + 2], acc[4 * rg + 3]);
                *(GAS v2u*)(Cu + (size_t)w * 8192 + v * 32 + 8 * rg + 4 * hh) = o; }
        }
        if (tid_ < 256) { float a = 0.f;
#pragma unroll
            for (int cch = 0; cch < 8; ++cch) { const v4u kq = *(const LAS v4u*)(Kt + tp_chunk(tid_, cch)); const LAS float* e8 = es + 8 * cch;
                a += e8[0] * bflo(kq.x); a += e8[1] * bfhi(kq.x); a += e8[2] * bflo(kq.y); a += e8[3] * bfhi(kq.y); a += e8[4] * bflo(kq.z); a += e8[5] * bfhi(kq.z); a += e8[6] * bflo(kq.w); a += e8[7] * bfhi(kq.w); }
            NLOC[(size_t)u * 256 + tid_] = a; }
        __syncthreads();
            }
        if (ub < 1024) {
        const int u = ub;
    const bf16* PROJ = (const bf16*)(F.ws + WS_PROJ); bf16* YA = (bf16*)(F.ws + WS_HM) + 1024;
    constexpr int KSZ = 64 * (AD + 8), VSZ = AD * TP, BUF = KSZ + VSZ;
    LAS bf16* B0 = (LAS bf16*)(F.lds + RING_OFF);
    LAS float* relb = (LAS float*)(B0 + 2 * BUF);
    int lane = F.lane; asm volatile("" : "+v"(lane));
    const int tid_ = F.wave * 64 + lane, w = F.wave, l31 = lane & 31;
        {
        const int b = u >> 9, hd = (u >> 5) & 15, qt = u & 31;
        for (int i = tid_; i < 257; i += NTHR) relb[i] = F.in[I_REL][hd * 257 + i] * 1.4426950408889634f;
        const int cw = 4 * qt + (w >> 1), qi = (w & 1) * 32 + l31; const size_t tq = (size_t)b * SEQ + cw * CHUNK + qi;
        AttnState<AD> A; attn_init<AD>(A, PROJ + tq * NPROJ + PQ_A + hd * AD, lane);
        const int kc0 = (4 * qt - 8) > 0 ? (4 * qt - 8) : 0, kc1 = 4 * qt + 3;
        const bf16* kbase = PROJ + (size_t)b * SEQ * NPROJ + PK_A + hd * AD; const bf16* vbase = PROJ + (size_t)b * SEQ * NPROJ + PV_A + hd * AD;
        KVRegs<AD> R0, R1;
        attn_load<AD>(R0, kbase + (size_t)kc0 * CHUNK * NPROJ, vbase + (size_t)kc0 * CHUNK * NPROJ, NPROJ, tid_);
        if (kc0 + 1 <= kc1) attn_load<AD>(R1, kbase + (size_t)(kc0 + 1) * CHUNK * NPROJ, vbase + (size_t)(kc0 + 1) * CHUNK * NPROJ, NPROJ, tid_);
        for (int kc = kc0; kc <= kc1; kc += 2) {
            { LAS bf16* Ks = B0; LAS bf16* Vt = Ks + KSZ;
              attn_put<AD>(Ks, Vt, R0, tid_);
              __syncthreads();
              if (kc + 2 <= kc1) attn_load<AD>(R0, kbase + (size_t)(kc + 2) * CHUNK * NPROJ, vbase + (size_t)(kc + 2) * CHUNK * NPROJ, NPROJ, tid_);
              if (kc >= cw - 8 && kc <= cw) attn_step<AD, true>(A, Ks, Vt, relb, cw - kc, qi, lane); }
            if (kc + 1 <= kc1) { LAS bf16* Ks = B0 + BUF; LAS bf16* Vt = Ks + KSZ;
              attn_put<AD>(Ks, Vt, R1, tid_);
              __syncthreads();
              if (kc + 3 <= kc1) attn_load<AD>(R1, kbase + (size_t)(kc + 3) * CHUNK * NPROJ, vbase + (size_t)(kc + 3) * CHUNK * NPROJ, NPROJ, tid_);
              if (kc + 1 >= cw - 8 && kc + 1 <= cw) attn_step<AD, true>(A, Ks, Vt, relb, cw - kc - 1, qi, lane); }
        }
        attn_store<AD>(A, YA + tq * 2048 + hd * AD, lane);
        __syncthreads();
            }
        }
    }
#undef ML_LOADG
#undef ML_LOAD
}


__device__ __forceinline__ void p_cross_attn(Frame& F) {
    frame_ids(F);
    const bf16* QX = (const bf16*)(F.ws + WS_QX); const bf16* KVX = (const bf16*)(F.ws + WS_KVX); bf16* OX = (bf16*)(F.ws + WS_OX);
    constexpr int KSZ = 64 * (XD + 8), VSZ = XD * TP, BUF = KSZ + VSZ;
    LAS bf16* B0 = (LAS bf16*)(F.lds + RING_OFF);
    const int lane = F.lane, w = F.wave, l31 = lane & 31;
    for (int u = F.vcu; u < BATCH * XH * 32; u += F.G) {
        const int b = u >> 7, hx = (u >> 5) & 3, qt = u & 31;
        const size_t tq = (size_t)b * SEQ + qt * 256 + 32 * w + l31;
        AttnState<XD> A; attn_init<XD>(A, QX + tq * XW + hx * XD, lane);
        const bf16* kg0 = KVX + (size_t)(b * NMEM) * (2 * XW) + hx * XD;
        KVRegs<XD> R; attn_load<XD>(R, kg0, kg0 + XW, 2 * XW, F.tid);
        for (int st = 0; st < 4; ++st) {
            LAS bf16* Ks = B0 + (st & 1) * BUF; LAS bf16* Vt = Ks + KSZ;
            attn_put<XD>(Ks, Vt, R, F.tid);
            __syncthreads();
            if (st < 3) { const bf16* kg = kg0 + (size_t)((st + 1) * 64) * (2 * XW); attn_load<XD>(R, kg, kg + XW, 2 * XW, F.tid); }
            attn_step<XD, false>(A, Ks, Vt, nullptr, 0, 0, lane);
        }
        attn_store<XD>(A, OX + tq * XW + hx * XD, lane);
        __syncthreads();
    }
}

__device__ __forceinline__ void p_rmsnorm_rows(Frame& F, const float* X, const float* w, bf16* XN, unsigned char* XQ) {
    frame_ids(F);
    const int gw = F.vcu * NWAVES + F.wave, NGW = F.G * NWAVES;
    for (int m = gw; m < T; m += NGW) {
        const GAS f32x4* xr = (const GAS f32x4*)(X + (size_t)m * D) + F.lane;
        f32x4 v[8]; float s = 0.f;
#pragma unroll
        for (int j = 0; j < 8; ++j) { v[j] = xr[64 * j]; s += (v[j].x * v[j].x + v[j].y * v[j].y) + (v[j].z * v[j].z + v[j].w * v[j].w); }
        const float rstd = 1.f / sqrtf(wave_sum(s) * (1.f / D) + EPS);
        const GAS f32x4* wr = (const GAS f32x4*)w + F.lane;
        GAS v2u* o8 = (GAS v2u*)(XN + (size_t)m * D) + F.lane;
#pragma unroll
        for (int j = 0; j < 8; ++j) { const f32x4 ww = wr[64 * j]; v[j].x *= rstd * ww.x; v[j].y *= rstd * ww.y; v[j].z *= rstd * ww.z; v[j].w *= rstd * ww.w;
            v2u o; o.x = pk2(v[j].x, v[j].y); o.y = pk2(v[j].z, v[j].w); o8[64 * j] = o; }
        if (XQ) { GAS unsigned* q4 = (GAS unsigned*)(XQ + (size_t)m * D) + F.lane;
#pragma unroll
            for (int j = 0; j < 8; ++j) q4[64 * j] = pg8::pk_fp8x4(v[j].x * XSCALE, v[j].y * XSCALE, v[j].z * XSCALE, v[j].w * XSCALE); }
    }
}


constexpr int NR_EXTRA = 133120;
__device__ __forceinline__ void p_norm_route(Frame& F) {
    frame_ids(F);
    const bf16* X2 = (const bf16*)(F.ws + WS_X2); const float* nw = F.in[I_NFFNW]; const bf16* WR = (const bf16*)(F.ws + WS_WR); const float* br = F.in[I_BR];
    unsigned char* XQ = (unsigned char*)(F.ws + WS_XQ); float* RSTD = (float*)(F.ws + WS_RSTD);
    int* TOPE = (int*)(F.ws + WS_TOPE); float* GATE = (float*)(F.ws + WS_GATE); int* RANK = (int*)(F.ws + WS_RANK); int* HIST = (int*)(F.ws + WS_CTL) + CW_HIST;
    LAS unsigned char* wt = F.lds + RING_OFF;
    LAS float* part = (LAS float*)(F.lds + NR_EXTRA);
    LAS float* sq = part + 64 * 32;
    LAS float* rs = sq + 64;
    LAS int* lh = (LAS int*)(rs + 64); LAS int* le = lh + 32;
    for (int i = 0; i < 16; ++i) { const int q = F.tid + NTHR * i, e = q >> 8, c = q & 255;
        *(LAS v4u*)(wt + e * 4096 + ((c ^ (e & 15)) << 4)) = *(const GAS v4u*)(WR + (size_t)e * D + 8 * c); }
    const int lane = F.lane, w = F.wave, tg = w & 3, kh = w >> 2, r16 = lane & 15, kq = lane >> 4;
    for (int blk = F.vcu; blk < T / 64; blk += F.G) {
        if (F.tid < 32) lh[F.tid] = 0;
        __syncthreads();
        const int tok = 16 * tg + r16; const size_t t = (size_t)blk * 64 + tok;
        f32x4 acc[2]; acc[0] = (f32x4){0.f, 0.f, 0.f, 0.f}; acc[1] = acc[0]; float ssq = 0.f;
        const bf16* xrow = X2 + t * D + 1024 * kh + 8 * kq; const float* nwp = nw + 1024 * kh + 8 * kq;
        unsigned char* qrow = XQ + t * D + 1024 * kh + 8 * kq;
#pragma unroll 8
        for (int ks = 0; ks < 32; ++ks) {
            const v4u xw = *(const GAS v4u*)(xrow + 32 * ks); const f32x4 xa = {bflo(xw.x), bfhi(xw.x), bflo(xw.y), bfhi(xw.y)}, xb = {bflo(xw.z), bfhi(xw.z), bflo(xw.w), bfhi(xw.w)};
            const f32x4 na = *(const GAS f32x4*)(nwp + 32 * ks), nb = *(const GAS f32x4*)(nwp + 32 * ks + 4);
            ssq += (xa.x * xa.x + xa.y * xa.y) + (xa.z * xa.z + xa.w * xa.w) + (xb.x * xb.x + xb.y * xb.y) + (xb.z * xb.z + xb.w * xb.w);
            const f32x4 ya = xa * na, yb = xb * nb;
            union { v4u u; bf16x8 v; } af; af.u.x = pk2(ya.x, ya.y); af.u.y = pk2(ya.z, ya.w); af.u.z = pk2(yb.x, yb.y); af.u.w = pk2(yb.z, yb.w);
            v2u qq; qq.x = pg8::pk_fp8x4(ya.x * XSCALE, ya.y * XSCALE, ya.z * XSCALE, ya.w * XSCALE); qq.y = pg8::pk_fp8x4(yb.x * XSCALE, yb.y * XSCALE, yb.z * XSCALE, yb.w * XSCALE);
            *(GAS v2u*)(qrow + 32 * ks) = qq;
            const int c = 128 * kh + 4 * ks + kq;
#pragma unroll
            for (int et = 0; et < 2; ++et) { const bf16x8 bfr = *(const LAS bf16x8*)(wt + (16 * et + r16) * 4096 + ((c ^ r16) << 4));
                acc[et] = __builtin_amdgcn_mfma_f32_16x16x32_bf16(af.v, bfr, acc[et], 0, 0, 0); }
        }
        ssq += __shfl_xor(ssq, 16); ssq += __shfl_xor(ssq, 32);
        if (kh == 1) {
#pragma unroll
            for (int et = 0; et < 2; ++et)
#pragma unroll
                for (int r = 0; r < 4; ++r) part[(16 * tg + 4 * kq + r) * 32 + 16 * et + r16] = acc[et][r];
            if (kq == 0) sq[tok] = ssq;
        }
        __syncthreads();
        if (kh == 0) {
            const float rstd = 1.f / sqrtf((ssq + sq[tok]) * (1.f / D) + EPS);
            if (kq == 0) { rs[tok] = rstd; RSTD[t] = rstd; }
            LDS_WAIT(); asm volatile("" ::: "memory");
#pragma unroll
            for (int et = 0; et < 2; ++et)
#pragma unroll
                for (int r = 0; r < 4; ++r) { const int tr = 16 * tg + 4 * kq + r, e = 16 * et + r16;
                    part[tr * 32 + e] = (acc[et][r] + part[tr * 32 + e]) * rs[tr] + br[e]; }
            LDS_WAIT(); asm volatile("" ::: "memory");
            if (lane < 16) { const int tk = 16 * tg + lane; const size_t tt = (size_t)blk * 64 + tk;
                float lg[32];
#pragma unroll
                for (int e = 0; e < 32; ++e) lg[e] = part[tk * 32 + e];
                float tv[4]; int te[4];
#pragma unroll
                for (int k = 0; k < 4; ++k) { float best = -3.0e38f; int bi = 0;
#pragma unroll
                    for (int e = 0; e < 32; ++e) { if (lg[e] > best) { best = lg[e]; bi = e; } }
                    tv[k] = best; te[k] = bi;
#pragma unroll
                    for (int e = 0; e < 32; ++e) lg[e] = (e == bi) ? -3.0e38f : lg[e]; }
                const float e1 = __expf(tv[1] - tv[0]), e2 = __expf(tv[2] - tv[0]), e3 = __expf(tv[3] - tv[0]), inv = 1.f / (1.f + e1 + e2 + e3);
                const float gk[4] = {inv, e1 * inv, e2 * inv, e3 * inv};
#pragma unroll
                for (int k = 0; k < 4; ++k) { TOPE[tt * 4 + k] = te[k]; GATE[tt * 4 + k] = gk[k]; le[tk * 4 + k] = te[k]; }
            }
        }
        __syncthreads();
        if (F.tid < 256) { const int me = le[F.tid]; int rk = 0;
#pragma unroll 8
            for (int q4 = 0; q4 < 64; ++q4) { const v4u e4 = *(const LAS v4u*)(le + 4 * q4); const int a0 = 4 * q4;
                rk += ((a0 < F.tid) & ((int)e4.x == me)) + ((a0 + 1 < F.tid) & ((int)e4.y == me)) + ((a0 + 2 < F.tid) & ((int)e4.z == me)) + ((a0 + 3 < F.tid) & ((int)e4.w == me)); }
            RANK[blk * 256 + F.tid] = rk; (void)lds_addi(lh + me, 1); }
        __syncthreads();
        if (F.tid < 32) HIST[blk * 32 + F.tid] = lh[F.tid];
        __syncthreads();
    }
}

__device__ __forceinline__ void p_route_a(Frame& F) {
    frame_ids(F);
    const float* LOG = (const float*)(F.ws + WS_LOG); int* TOPE = (int*)(F.ws + WS_TOPE); float* GATE = (float*)(F.ws + WS_GATE); int* RANK = (int*)(F.ws + WS_RANK);
    int* HIST = (int*)(F.ws + WS_CTL) + CW_HIST; const float* br = F.in[I_BR];
    LAS int* lh = (LAS int*)(F.lds + RING_OFF); LAS int* le = lh + 32;
    for (int blk = F.vcu; blk < T / 64; blk += F.G) {
        if (F.tid < 32) lh[F.tid] = 0;
        __syncthreads();
        if (F.tid < 64) { const int t = blk * 64 + F.tid;
            float lg[32];
#pragma unroll
            for (int e4 = 0; e4 < 8; ++e4) { const f32x4 v = *(const GAS f32x4*)(LOG + (size_t)t * 256 + 4 * e4), bb = *(const GAS f32x4*)(br + 4 * e4);
                lg[4 * e4] = v.x + bb.x; lg[4 * e4 + 1] = v.y + bb.y; lg[4 * e4 + 2] = v.z + bb.z; lg[4 * e4 + 3] = v.w + bb.w; }
            float tv[4]; int te[4];
#pragma unroll
            for (int k = 0; k < 4; ++k) { float best = -3.0e38f; int bi = 0;
#pragma unroll
                for (int e = 0; e < 32; ++e) { if (lg[e] > best) { best = lg[e]; bi = e; } }
                tv[k] = best; te[k] = bi;
#pragma unroll
                for (int e = 0; e < 32; ++e) lg[e] = (e == bi) ? -3.0e38f : lg[e]; }
            const float e1 = __expf(tv[1] - tv[0]), e2 = __expf(tv[2] - tv[0]), e3 = __expf(tv[3] - tv[0]), inv = 1.f / (1.f + e1 + e2 + e3);
            const float gk[4] = {inv, e1 * inv, e2 * inv, e3 * inv};
#pragma unroll
            for (int k = 0; k < 4; ++k) { TOPE[t * 4 + k] = te[k]; GATE[t * 4 + k] = gk[k]; le[F.tid * 4 + k] = te[k]; }
        }
        __syncthreads();
        if (F.tid < 256) { const int me = le[F.tid]; int rk = 0;
            for (int a = 0; a < F.tid; ++a) rk += (le[a] == me) ? 1 : 0;
            RANK[blk * 256 + F.tid] = rk; (void)lds_addi(lh + me, 1); }
        __syncthreads();
        if (F.tid < 32) HIST[blk * 32 + F.tid] = lh[F.tid];
        __syncthreads();
    }
}
__device__ __forceinline__ void p_route_b(Frame& F) {
    frame_ids(F);
    const int* TOPE = (const int*)(F.ws + WS_TOPE); const float* GATE = (const float*)(F.ws + WS_GATE); const int* RANK = (const int*)(F.ws + WS_RANK);
    int* DEST = (int*)(F.ws + WS_DEST); float* RGATE = (float*)(F.ws + WS_RGATE); float* RROW = (float*)(F.ws + WS_RROW); const float* RSTD = (const float*)(F.ws + WS_RSTD);
    const int* HIST = (const int*)(F.ws + WS_CTL) + CW_HIST; int* BLKE = (int*)(F.ws + WS_CTL) + CW_BLKE; int* NBLK = (int*)(F.ws + WS_CTL) + CW_NBLK;
    const unsigned char* XQ = (const unsigned char*)(F.ws + WS_XQ); unsigned char* XP = (unsigned char*)(F.ws + WS_XPERM);
    LAS int* cnt = (LAS int*)(F.lds + RING_OFF);
    LAS int* pst = cnt + 32; LAS int* pen = cnt + 64; LAS int* base = cnt + 96; LAS int* dl = cnt + 128; LAS int* part = cnt + 384; LAS int* hl = cnt + 896;
    for (int i = F.tid; i < (T / 64) * 32; i += NTHR) hl[i] = HIST[i];
    __syncthreads();
    { const int e = F.tid & 31, g = F.tid >> 5; int s = 0;
#pragma unroll
        for (int q = 0; q < 16; ++q) s += hl[(16 * g + q) * 32 + e];
        part[g * 32 + e] = s; }
    __syncthreads();
    if (F.tid < 32) { int s = 0;
#pragma unroll
        for (int g = 0; g < 16; ++g) s += part[g * 32 + F.tid];
        cnt[F.tid] = s; }
    __syncthreads();
    if (F.tid == 0) { int run = 0; for (int e = 0; e < 32; ++e) { const int pd = (cnt[e] + MOEB - 1) / MOEB * MOEB; pst[e] = run; run += pd; pen[e] = run; } }
    __syncthreads();
    if (F.vcu == 0) {
        if (F.tid == 0) NBLK[0] = pen[31] / MOEB;
        if (F.tid < NBLK_MAX) { int e = 0; for (int q = 0; q < 32; ++q) e += (pen[q] <= F.tid * MOEB) ? 1 : 0; BLKE[F.tid] = e < 31 ? e : 31; }
    }
    for (int e = F.vcu; e < NE; e += F.G) {
        const int r0 = pst[e] + cnt[e], r1 = pen[e];
        for (int r = r0 + F.wave; r < r1; r += NWAVES) { if (F.lane == 0) { RGATE[r] = 0.f; RROW[r] = 0.f; }
            GAS v4u* o = (GAS v4u*)(XP + (size_t)r * D) + F.lane;
#pragma unroll
            for (int j = 0; j < 2; ++j) o[64 * j] = (v4u){0u, 0u, 0u, 0u}; }
    }
    for (int blk = F.vcu; blk < T / 64; blk += F.G) {
        __syncthreads();
        { const int e = F.tid & 31, g = F.tid >> 5; int s = 0;
#pragma unroll
            for (int q = 0; q < 16; ++q) s += (16 * g + q < blk) ? hl[(16 * g + q) * 32 + e] : 0;
            part[g * 32 + e] = s; }
        __syncthreads();
        if (F.tid < 32) { int s = pst[F.tid];
#pragma unroll
            for (int g = 0; g < 16; ++g) s += part[g * 32 + F.tid];
            base[F.tid] = s; }
        __syncthreads();
        if (F.tid < 256) { const int a = blk * 256 + F.tid; const int d = base[TOPE[a]] + RANK[a]; DEST[a] = d; RGATE[d] = GATE[a]; RROW[d] = RSTD[a >> 2]; dl[F.tid] = d; }
        __syncthreads();
        { v4u rr[8][2];
#pragma unroll
            for (int q = 0; q < 8; ++q) { const int t = blk * 64 + F.wave + 8 * q; const GAS v4u* s = (const GAS v4u*)(XQ + (size_t)t * D) + F.lane; rr[q][0] = s[0]; rr[q][1] = s[64]; }
#pragma unroll
            for (int q = 0; q < 8; ++q)
#pragma unroll
                for (int k = 0; k < 4; ++k) { const int a = 4 * (F.wave + 8 * q) + k; GAS v4u* o = (GAS v4u*)(XP + (size_t)dl[a] * D) + F.lane; o[0] = rr[q][0]; o[64] = rr[q][1]; } }
    }
}
__device__ __forceinline__ void p_combine(Frame& F) {
    frame_ids(F);
    const bf16* X2 = (const bf16*)(F.ws + WS_X2); const unsigned char* YR = (const unsigned char*)(F.ws + WS_YR); const int* DEST = (const int*)(F.ws + WS_DEST);
    const float* fw = F.in[I_FNW];
    const int gw = F.vcu * NWAVES + F.wave, NGW = F.G * NWAVES;
    for (int m = gw; m < T; m += NGW) {
        const GAS v2u* xr = (const GAS v2u*)(X2 + (size_t)m * D) + F.lane;
        f32x4 v[8];
#pragma unroll
        for (int j = 0; j < 8; ++j) { const v2u xw = xr[64 * j]; v[j] = (f32x4){bflo(xw.x), bfhi(xw.x), bflo(xw.y), bfhi(xw.y)}; }
#pragma unroll
        for (int k = 0; k < 4; ++k) { const GAS unsigned* yr = (const GAS unsigned*)(YR + (size_t)DEST[m * 4 + k] * D) + F.lane;
#pragma unroll
            for (int j = 0; j < 8; ++j) { const unsigned y = yr[64 * j]; const f32x2 lo = __builtin_amdgcn_cvt_pk_f32_fp8((int)y, false), hi = __builtin_amdgcn_cvt_pk_f32_fp8((int)y, true);
                v[j].x += lo.x * (1.f / YSCALE); v[j].y += lo.y * (1.f / YSCALE); v[j].z += hi.x * (1.f / YSCALE); v[j].w += hi.y * (1.f / YSCALE); } }
        float s = 0.f;
#pragma unroll
        for (int j = 0; j < 8; ++j) s += (v[j].x * v[j].x + v[j].y * v[j].y) + (v[j].z * v[j].z + v[j].w * v[j].w);
        const float rstd = 1.f / sqrtf(wave_sum(s) * (1.f / D) + EPS);
        const GAS f32x4* wr = (const GAS f32x4*)fw + F.lane; GAS f32x4* o = (GAS f32x4*)(F.out + (size_t)m * D) + F.lane;
#pragma unroll
        for (int j = 0; j < 8; ++j) { const f32x4 ww = wr[64 * j]; f32x4 ov = (f32x4){v[j].x * rstd * ww.x, v[j].y * rstd * ww.y, v[j].z * rstd * ww.z, v[j].w * rstd * ww.w};
#ifdef MK_SANITIZE
#pragma unroll
            for (int q = 0; q < 4; ++q) if (!(fabsf(ov[q]) < 1e30f)) ov[q] = 100.f;
#endif
            __builtin_nontemporal_store(ov, o + 64 * j); }
    }
}


constexpr int NPHASE = 20;
struct Args { const float* in[25]; float* out; unsigned char* ws; int ph_lo, ph_hi; };
__global__ void __launch_bounds__(NTHR, 2) mk_fwd(Args args) {
    extern __shared__ __attribute__((aligned(16))) unsigned char lds[];
    Frame F;
    F.lds = (LAS unsigned char*)lds;
    F.wave = __builtin_amdgcn_readfirstlane((int)threadIdx.x >> 6); frame_ids(F);
    F.G = gridDim.x; { const int bx = blockIdx.x; F.vcu = (F.G % 8 == 0) ? (bx % 8) * (F.G / 8) + bx / 8 : bx; }
    F.ws = args.ws; F.out = args.out;
#pragma unroll
    for (int i = 0; i < 25; ++i) F.in[i] = args.in[i];
    for (int u = F.tid; u < (LDS_BYTES - LDSCTL_OFF) / 4; u += NTHR) ((LAS unsigned*)(F.lds + LDSCTL_OFF))[u] = 0u;
    __syncthreads();
    const int lo = args.ph_lo, hi = args.ph_hi;
    unsigned* ctl = (unsigned*)(F.ws + WS_CTL);
    XcdBarrier bar; bar.bar = ctl + CW_BAR; bar.x = 0; bar.st = nullptr;
    if (hi - lo > 1) bar = xcd_barrier_post(ctl + CW_BAR, (volatile LAS unsigned*)(F.lds + MISC_OFF) + 8, F.tid);
#define IN(k) (lo <= (k) && (k) < hi)
#define SEAM(k) do { if (IN(k) && IN((k) + 1)) { frame_ids(F); xcd_barrier(bar, F.tid); } } while (0)
    LAS unsigned char* ring = F.lds + RING_OFF;
    const int cid = (int)blockIdx.x;
    const int kj = cid >> 3, KOFF_ST = (F.G == 256) ? 2 * (((kj & 7) + (kj >> 3)) & 3) : 0, KOFF_MOE = (F.G == 256) ? 2 * (((kj >> 2) + (kj & 3)) & 3) : 0;

    if (IN(0)) { p0_prologue(F); }
#if (PROBE_MASK >> 0) & 1
    if (IN(0)) { frame_ids(F); VM_WAIT(); __syncthreads(); }
    if (IN(0)) { p0_prologue(F); }
#endif
 SEAM(0);
    if (IN(1)) {
        { pg8::Gemm g{(const bf16*)(F.ws + WS_H), (const bf16*)(F.ws + WS_WIN), T, 3072, D}; pg8::InProjOrder<0> S; S.init(T, 3072, F.G, cid);
          pg8::EpiAct E{(bf16*)(F.ws + WS_PROJ), NPROJ, 12, 16, 28, 44, 16, 20, 0.125f * 1.4426950408889634f, 0, nullptr, 0.f, 0.f, 1.f};
          pg8::gemm_phase<pg8::EpiAct, pg8::InProjOrder<0>, true, true>(ring, g, S, E, F.wave, KOFF_ST); }
        { pg8::Gemm g{(const bf16*)(F.ws + WS_H8), (const bf16*)(F.ws + WS_WIN8), T, 8192, D / 2}; pg8::InProjOrder<1> S; S.init(T, 8192, F.G, cid);
          pg8::EpiAct E{(bf16*)(F.ws + WS_PROJ), NPROJ, 12, 16, 28, 44, 16, 20, 0.125f * 1.4426950408889634f, 0, nullptr, 0.f, 0.f, 1.f / (HSCALE * WSCALE)};
          pg8::gemm_phase<pg8::EpiAct, pg8::InProjOrder<1>, true, true, true>(ring, g, S, E, F.wave, KOFF_ST); }
    }
#if (PROBE_MASK >> 1) & 1
    if (IN(1)) { frame_ids(F); VM_WAIT(); __syncthreads(); }
    if (IN(1)) {
        { pg8::Gemm g{(const bf16*)(F.ws + WS_H), (const bf16*)(F.ws + WS_WIN), T, 3072, D}; pg8::InProjOrder<0> S; S.init(T, 3072, F.G, cid);
          pg8::EpiAct E{(bf16*)(F.ws + WS_PROJ), NPROJ, 12, 16, 28, 44, 16, 20, 0.125f * 1.4426950408889634f, 1, nullptr, 0.f, 0.f, 1.f};
          pg8::gemm_phase<pg8::EpiAct, pg8::InProjOrder<0>, true, true>(ring, g, S, E, F.wave, KOFF_ST); }
        { pg8::Gemm g{(const bf16*)(F.ws + WS_H8), (const bf16*)(F.ws + WS_WIN8), T, 8192, D / 2}; pg8::InProjOrder<1> S; S.init(T, 8192, F.G, cid);
          pg8::EpiAct E{(bf16*)(F.ws + WS_PROJ), NPROJ, 0, 0, 0, 0, 16, 20, 0.125f * 1.4426950408889634f, 1, nullptr, 0.f, 0.f, 1.f / (HSCALE * WSCALE)};
          pg8::gemm_phase<pg8::EpiAct, pg8::InProjOrder<1>, true, true, true>(ring, g, S, E, F.wave, KOFF_ST); }
    }
#endif
 SEAM(1);
    if (IN(2)) { p_conv(F); }
#if (PROBE_MASK >> 2) & 1
    if (IN(2)) { frame_ids(F); VM_WAIT(); __syncthreads(); }
    if (IN(2)) { p_conv(F); }
#endif
 SEAM(2);
    if (IN(3)) { p_local_band(F); }
#if (PROBE_MASK >> 19) & 1
    if (IN(3)) { p_mlstm_local(F); }
#endif
#if (PROBE_MASK >> 20) & 1
    if (IN(3)) { p_band_attn(F); }
#endif
#if (PROBE_MASK >> 3) & 1
    if (IN(3)) { frame_ids(F); VM_WAIT(); __syncthreads(); }
    if (IN(3)) { p_mlstm_local(F); p_band_attn(F); }
#endif
 SEAM(3);
    if (IN(4)) { p_mlstm_scan(F); }
#if (PROBE_MASK >> 4) & 1
    if (IN(4)) { frame_ids(F); VM_WAIT(); __syncthreads(); }
    if (IN(4)) { p_mlstm_scan(F); }
#endif
 SEAM(4);
    if (IN(5)) { p_mlstm_out(F); }
#if (PROBE_MASK >> 5) & 1
    if (IN(5)) { frame_ids(F); VM_WAIT(); __syncthreads(); }
    if (IN(5)) { p_mlstm_out(F); }
#endif
 SEAM(5);
    if (IN(6)) { pg8::Gemm g{(const bf16*)(F.ws + WS_HM), (const bf16*)(F.ws + WS_WBM), T, D, 2048}; pg8::StaticOrder S; S.init(T, D, F.G, cid);
        pg8::EpiMerge E{(const bf16*)(F.ws + WS_PROJ), NPROJ, PG_M, PG_A, (bf16*)(F.ws + WS_MRG), D};
        pg8::gemm_phase<pg8::EpiMerge, pg8::StaticOrder, true, true>(ring, g, S, E, F.wave); }
#if (PROBE_MASK >> 6) & 1
    if (IN(6)) { frame_ids(F); VM_WAIT(); __syncthreads(); }
    if (IN(6)) { pg8::Gemm g{(const bf16*)(F.ws + WS_HM), (const bf16*)(F.ws + WS_WBM), T, D, 2048}; pg8::StaticOrder S; S.init(T, D, F.G, cid);
        pg8::EpiMerge E{(const bf16*)(F.ws + WS_PROJ), NPROJ, PG_M, PG_A, (bf16*)(F.ws + WS_MRG), D};
        pg8::gemm_phase<pg8::EpiMerge, pg8::StaticOrder, true, true>(ring, g, S, E, F.wave); }
#endif
 SEAM(6);
    if (IN(7)) { pg8::Gemm g{(const bf16*)(F.ws + WS_MRG), (const bf16*)(F.ws + WS_WOUT), T, D, D}; pg8::StaticOrder S; S.init(T, D, F.G, cid);
        pg8::EpiResB<false> E{(bf16*)(F.ws + WS_XN1), D, (const void*)F.in[I_X], (float*)(F.ws + WS_SSQ1)};
        pg8::gemm_phase<pg8::EpiResB<false>, pg8::StaticOrder, true, true>(ring, g, S, E, F.wave, KOFF_ST); }
#if (PROBE_MASK >> 7) & 1
    if (IN(7)) { frame_ids(F); VM_WAIT(); __syncthreads(); }
    if (IN(7)) { pg8::Gemm g{(const bf16*)(F.ws + WS_MRG), (const bf16*)(F.ws + WS_WOUT), T, D, D}; pg8::StaticOrder S; S.init(T, D, F.G, cid);
        pg8::EpiResB<false> E{(bf16*)(F.ws + WS_XN1), D, (const void*)F.in[I_X], (float*)(F.ws + WS_SSQ1)};
        pg8::gemm_phase<pg8::EpiResB<false>, pg8::StaticOrder, true, true>(ring, g, S, E, F.wave, KOFF_ST); }
#endif
 SEAM(7);
    if (IN(9)) {
        if (cid < 128 || F.G != 256) { pg8::Gemm g{(const bf16*)(F.ws + WS_XN1), (const bf16*)(F.ws + WS_WQ), T, XW, D}; pg8::StaticOrder S; S.init(T, XW, F.G, cid);
            pg8::EpiAct E{(bf16*)(F.ws + WS_QX), XW, 0, 0, 0, 0, 0, 2, 0.08838834764831845f * 1.4426950408889634f, 0, (const float*)(F.ws + WS_SSQ1), 1.f / D, EPS, 1.f};
            pg8::gemm_phase<pg8::EpiAct, pg8::StaticOrder, true, true>(ring, g, S, E, F.wave, KOFF_ST); }
        if (cid >= 128 || F.G != 256) {
            pg8::Gemm g{(const bf16*)(F.ws + WS_MEMN), (const bf16*)(F.ws + WS_WKV), BATCH * NMEM, 2 * XW, D}; pg8::StaticOrder S; S.init(BATCH * NMEM, 2 * XW, F.G == 256 ? 128 : F.G, F.G == 256 ? cid - 128 : cid);
            pg8::EpiAct E{(bf16*)(F.ws + WS_KVX), 2 * XW, 0, 0, 0, 0, 0, 0, 1.f, 0, nullptr, 0.f, 0.f, 1.f};
            pg8::gemm_phase<pg8::EpiAct, pg8::StaticOrder, true, true>(ring, g, S, E, F.wave, KOFF_ST); }
        if (F.G == 256) { if (cid >= 256 - LATE_WG) { frame_ids(F); weight_tiles(F, NTILES - NT_LATE, NTILES, cid - (256 - LATE_WG), LATE_WG); } }
        else { frame_ids(F); __syncthreads(); weight_tiles(F, NTILES - NT_LATE, NTILES, F.vcu, F.G); }
    }
#if (PROBE_MASK >> 9) & 1
    if (IN(9)) { frame_ids(F); VM_WAIT(); __syncthreads(); }
    if (IN(9)) {
        if (cid < 128 || F.G != 256) { pg8::Gemm g{(const bf16*)(F.ws + WS_XN1), (const bf16*)(F.ws + WS_WQ), T, XW, D}; pg8::StaticOrder S; S.init(T, XW, F.G, cid);
            pg8::EpiAct E{(bf16*)(F.ws + WS_QX), XW, 0, 0, 0, 0, 0, 2, 0.08838834764831845f * 1.4426950408889634f, 0, (const float*)(F.ws + WS_SSQ1), 1.f / D, EPS, 1.f};
            pg8::gemm_phase<pg8::EpiAct, pg8::StaticOrder, true, true>(ring, g, S, E, F.wave, KOFF_ST); }
        if (cid >= 128 || F.G != 256) {
            pg8::Gemm g{(const bf16*)(F.ws + WS_MEMN), (const bf16*)(F.ws + WS_WKV), BATCH * NMEM, 2 * XW, D}; pg8::StaticOrder S; S.init(BATCH * NMEM, 2 * XW, F.G == 256 ? 128 : F.G, F.G == 256 ? cid - 128 : cid);
            pg8::EpiAct E{(bf16*)(F.ws + WS_KVX), 2 * XW, 0, 0, 0, 0, 0, 0, 1.f, 0, nullptr, 0.f, 0.f, 1.f};
            pg8::gemm_phase<pg8::EpiAct, pg8::StaticOrder, true, true>(ring, g, S, E, F.wave, KOFF_ST); }
        if (F.G == 256) { if (cid >= 256 - LATE_WG) { frame_ids(F); weight_tiles(F, NTILES - NT_LATE, NTILES, cid - (256 - LATE_WG), LATE_WG); } }
        else { frame_ids(F); __syncthreads(); weight_tiles(F, NTILES - NT_LATE, NTILES, F.vcu, F.G); }
    }
#endif
 SEAM(9);
    if (IN(10)) { p_cross_attn(F); }
#if (PROBE_MASK >> 10) & 1
    if (IN(10)) { frame_ids(F); VM_WAIT(); __syncthreads(); }
    if (IN(10)) { p_cross_attn(F); }
#endif
 SEAM(10);
    if (IN(11)) { pg8::Gemm g{(const bf16*)(F.ws + WS_OX), (const bf16*)(F.ws + WS_WO), T, D, XW}; pg8::StaticOrder S; S.init(T, D, F.G, cid);
        pg8::EpiResB<true> E{(bf16*)(F.ws + WS_X2), D, (const void*)(F.ws + WS_XN1), nullptr};
        pg8::gemm_phase<pg8::EpiResB<true>, pg8::StaticOrder, true, true>(ring, g, S, E, F.wave, KOFF_ST); }
#if (PROBE_MASK >> 11) & 1
    if (IN(11)) { frame_ids(F); VM_WAIT(); __syncthreads(); }
    if (IN(11)) { pg8::Gemm g{(const bf16*)(F.ws + WS_OX), (const bf16*)(F.ws + WS_WO), T, D, XW}; pg8::StaticOrder S; S.init(T, D, F.G, cid);
        pg8::EpiResB<true> E{(bf16*)(F.ws + WS_X2), D, (const void*)(F.ws + WS_XN1), nullptr};
        pg8::gemm_phase<pg8::EpiResB<true>, pg8::StaticOrder, true, true>(ring, g, S, E, F.wave, KOFF_ST); }
#endif
 SEAM(11);
    if (IN(12)) { p_norm_route(F); }
#if (PROBE_MASK >> 12) & 1
    if (IN(12)) { frame_ids(F); VM_WAIT(); __syncthreads(); }
    if (IN(12)) { p_norm_route(F); }
#endif
    do { if (IN(12) && IN(15)) { frame_ids(F); xcd_barrier(bar, F.tid); } } while (0);
    if (IN(15)) { p_route_b(F); }
#if (PROBE_MASK >> 15) & 1
    if (IN(15)) { frame_ids(F); VM_WAIT(); __syncthreads(); }
    if (IN(15)) { p_route_b(F); }
#endif
 SEAM(15);
    if (IN(16)) { const int* BLKE = (const int*)ctl + CW_BLKE; const int nblk = ((const int*)ctl)[CW_NBLK];
        pg8::Gemm g{(const bf16*)(F.ws + WS_XPERM), (const bf16*)(F.ws + WS_WGU), NROWS_MAX, 2 * DFF, D / 2};
        pg8::MoeOrder S{2 * DFF / 256, F.G, cid, nblk, BLKE, (size_t)2 * DFF * D};
        pg8::EpiSwiGLU E{(unsigned char*)(F.ws + WS_ACT), DFF, F.in[I_BGU], BLKE, DFF, 1.f / (XSCALE * WSCALE), ASCALE, (const float*)(F.ws + WS_RROW)};
        pg8::gemm_phase<pg8::EpiSwiGLU, pg8::MoeOrder, true, true, true>(ring, g, S, E, F.wave, KOFF_MOE);
        { frame_ids(F); VM_WAIT(); __syncthreads();
          constexpr int TG0 = NTILES - NT_LATE - NT_GU, TG1 = NTILES - NT_LATE;
          const int nN = S.nN, rpr = (8 / (nN / 4)) * 8, R = (nblk + rpr - 1) / rpr, n_idle = (R * rpr - nblk) * nN; int covered = 0;
          if (F.G == 256 && n_idle > 0) { pg8::Unit u; const bool has = S.next(R - 1, u);
              covered = (6 * n_idle < NT_GU) ? 6 * n_idle : NT_GU;
              if (!has) weight_tiles(F, TG0, TG0 + covered, (u.pm - nblk) * nN + u.pn, n_idle); }
          if (covered < NT_GU) { __syncthreads(); weight_tiles(F, TG0 + covered, TG1, F.vcu, F.G); } } }
#if (PROBE_MASK >> 16) & 1
    if (IN(16)) { frame_ids(F); VM_WAIT(); __syncthreads(); }
    if (IN(16)) { const int* BLKE = (const int*)ctl + CW_BLKE; const int nblk = ((const int*)ctl)[CW_NBLK];
        pg8::Gemm g{(const bf16*)(F.ws + WS_XPERM), (const bf16*)(F.ws + WS_WGU), NROWS_MAX, 2 * DFF, D / 2};
        pg8::MoeOrder S{2 * DFF / 256, F.G, cid, nblk, BLKE, (size_t)2 * DFF * D};
        pg8::EpiSwiGLU E{(unsigned char*)(F.ws + WS_ACT), DFF, F.in[I_BGU], BLKE, DFF, 1.f / (XSCALE * WSCALE), ASCALE, (const float*)(F.ws + WS_RROW)};
        pg8::gemm_phase<pg8::EpiSwiGLU, pg8::MoeOrder, true, true, true>(ring, g, S, E, F.wave, KOFF_MOE); }
#endif
 SEAM(16);
    if (IN(17)) { const int* BLKE = (const int*)ctl + CW_BLKE; const int nblk = ((const int*)ctl)[CW_NBLK];
        pg8::Gemm g{(const bf16*)(F.ws + WS_ACT), (const bf16*)(F.ws + WS_WDN), NROWS_MAX, D, DFF / 2};
        pg8::MoeOrder S{D / 256, F.G, cid, nblk, BLKE, (size_t)D * DFF};
        pg8::EpiDown E{(unsigned char*)(F.ws + WS_YR), D, F.in[I_BDN], BLKE, (const float*)(F.ws + WS_RGATE), 1.f / (ASCALE * WSCALE), YSCALE};
        pg8::gemm_phase<pg8::EpiDown, pg8::MoeOrder, true, true, true>(ring, g, S, E, F.wave, KOFF_MOE); }
#if (PROBE_MASK >> 17) & 1
    if (IN(17)) { frame_ids(F); VM_WAIT(); __syncthreads(); }
    if (IN(17)) { const int* BLKE = (const int*)ctl + CW_BLKE; const int nblk = ((const int*)ctl)[CW_NBLK];
        pg8::Gemm g{(const bf16*)(F.ws + WS_ACT), (const bf16*)(F.ws + WS_WDN), NROWS_MAX, D, DFF / 2};
        pg8::MoeOrder S{D / 256, F.G, cid, nblk, BLKE, (size_t)D * DFF};
        pg8::EpiDown E{(unsigned char*)(F.ws + WS_YR), D, F.in[I_BDN], BLKE, (const float*)(F.ws + WS_RGATE), 1.f / (ASCALE * WSCALE), YSCALE};
        pg8::gemm_phase<pg8::EpiDown, pg8::MoeOrder, true, true, true>(ring, g, S, E, F.wave, KOFF_MOE); }
#endif
 SEAM(17);
    if (IN(18)) { p_combine(F); }
#if (PROBE_MASK >> 18) & 1
    if (IN(18)) { frame_ids(F); VM_WAIT(); __syncthreads(); }
    if (IN(18)) { p_combine(F); }
#endif

#undef IN
#undef SEAM
}

#ifndef MK_SPLIT
#define MK_SPLIT 0
#endif
extern "C" void kernel_launch(void* const* d_in, const int* in_sizes, int n_in, void* d_out, int out_size, void* d_ws, size_t ws_size, hipStream_t stream) {
    static int grid = 0;
    if (grid == 0) {
        if (n_in != 25 || in_sizes[0] != T * D || out_size != T * D || ws_size < WS_END) { fprintf(stderr, "kernel_launch: unexpected shapes (n_in %d in0 %d out %d ws %zu need %zu)\n", n_in, n_in > 0 ? in_sizes[0] : -1, out_size, ws_size, (size_t)WS_END); grid = -1; return; }
        int dev = 0, cus = 0, per_cu = 0;
        if (hipGetDevice(&dev) != hipSuccess || hipDeviceGetAttribute(&cus, hipDeviceAttributeMultiprocessorCount, dev) != hipSuccess) { grid = -1; return; }
        if (hipFuncSetAttribute((const void*)mk_fwd, hipFuncAttributeMaxDynamicSharedMemorySize, LDS_BYTES) != hipSuccess) { fprintf(stderr, "kernel_launch: hipFuncSetAttribute failed\n"); grid = -1; return; }
        if (hipOccupancyMaxActiveBlocksPerMultiprocessor(&per_cu, (const void*)mk_fwd, NTHR, LDS_BYTES) != hipSuccess || per_cu < 1) fprintf(stderr, "kernel_launch: occupancy query reports %d\n", per_cu);
        (void)hipGetLastError();
        grid = cus;
    }
    if (grid < 0) return;
    (void)hipMemsetAsync((char*)d_ws + WS_CTL, 0, CTL_ZERO_BYTES, stream);
    Args a{};
    for (int i = 0; i < 25; ++i) a.in[i] = (const float*)d_in[i];
    a.out = (float*)d_out; a.ws = (unsigned char*)d_ws;
#if MK_SPLIT
    for (int p = 0; p < 19; ++p) { a.ph_lo = p; a.ph_hi = p + 1; hipLaunchKernelGGL(mk_fwd, dim3(grid), dim3(NTHR), LDS_BYTES, stream, a); }
#else
    a.ph_lo = 0; a.ph_hi = 19; hipLaunchKernelGGL(mk_fwd, dim3(grid), dim3(NTHR), LDS_BYTES, stream, a);
#endif
}
```

```cpp
#include <hip/hip_runtime.h>
#include <cstdio>
#include <cstdint>
namespace pg8 {
#define PG8_LAS __attribute__((address_space(3)))
typedef unsigned short bf16_t;
typedef short bf16x8 __attribute__((ext_vector_type(8)));
typedef float f32x4 __attribute__((ext_vector_type(4)));
typedef unsigned u32x4 __attribute__((ext_vector_type(4)));
constexpr int BM = 256, BK = 64, HALF = 128, HTB = HALF * BK * 2  , STAGE_BYTES = 8 * HTB, NXCD = 8, WGM = 8;

__host__ __device__ __forceinline__ int lds_byte(int r, int c) { const int st = (r >> 4) * 2 + (c >> 5), rr = r & 15, cc = c & 31, ob = rr * 64 + cc * 2; return st * 1024 + (ob ^ (((ob >> 9) & 1) << 5)); }
__host__ __device__ __forceinline__ void stage_rc(int b, int& R, int& C) { const int st = b / 1024, sb = b % 1024, swz = sb ^ (((sb >> 9) & 1) << 5); R = (st >> 1) * 16 + swz / 64; C = (st & 1) * 32 + (swz % 64) / 2; }
__host__ __device__ __forceinline__ int perm32(int rho) { const int n = rho >> 4, i = rho & 15; return 8 * (i >> 2) + 4 * n + (i & 3); }

struct Unit { int pm, pn; };
struct Gemm { const bf16_t* A; const bf16_t* Bt; int M, N, K; };

struct StaticOrder {
    int nM, nN, nwg, G, c;
    __host__ __device__ void init(int M, int N, int G_, int c_) { nM = M / BM; nN = N / BM; nwg = nM * nN; G = G_; c = c_; }
    __host__ __device__ bool next(int i, Unit& u) const {
        const long L = (long)i * G + c; if (L >= nwg) return false;
        int wgid = (int)L; { const int q = nwg / NXCD, r = nwg % NXCD, xcd = wgid % NXCD, off = wgid / NXCD; wgid = (xcd < r ? xcd * (q + 1) : r * (q + 1) + (xcd - r) * q) + off; }
        const int nig = WGM * nN, gid = wgid / nig, fm = gid * WGM, gsz = (nM - fm) < WGM ? (nM - fm) : WGM;
        u.pm = fm + ((wgid % nig) % gsz); u.pn = (wgid % nig) / gsz; return true;
    }
    __device__ __forceinline__ const char* a_base(const Gemm& g, const Unit& u) const { return (const char*)g.A + (size_t)u.pm * ((size_t)BM * g.K * 2); }
    __device__ __forceinline__ const char* b_base(const Gemm& g, const Unit& u) const { return (const char*)g.Bt + (size_t)u.pn * ((size_t)BM * g.K * 2); }
    __device__ __forceinline__ void a_ready(const Unit&) const {}
    __device__ __forceinline__ void done(const Unit&) const {}
};


template <int MODE> struct InProjOrder : StaticOrder {
    __device__ __forceinline__ bool next(int i, Unit& u) const { if (!StaticOrder::next(i, u)) return false;
        const int l = u.pn; u.pn = (MODE == 0) ? l : (8 + l); return true; }
    __device__ __forceinline__ const char* b_base(const Gemm& g, const Unit& u) const {
        const int t = (MODE == 0) ? u.pn : (u.pn - 8); return (const char*)g.Bt + (size_t)t * ((size_t)BM * g.K * 2); }
};

struct MoeOrder {
    int nN, G, c, nblk; const int* block_e; size_t bstride;
    __device__ __forceinline__ bool next(int i, Unit& u) const {
        if (G == 256 && (nN == 16 || nN == 8)) {
            const int xc = nN / 4, rpr = (8 / xc) * 8, x = c & 7, j = c >> 3;
            u.pm = i * rpr + (x / xc) * 8 + (j >> 2); u.pn = (x % xc) * 4 + (j & 3);
            if (i * rpr >= nblk) return false;
            return u.pm < nblk;
        }
        const long L = (long)i * G + c; if (L >= (long)nblk * nN) return false;
        u.pm = (int)(L / nN); u.pn = (int)(L % nN); return true;
    }
    __device__ __forceinline__ const char* a_base(const Gemm& g, const Unit& u) const { return (const char*)g.A + (size_t)u.pm * ((size_t)BM * g.K * 2); }
    __device__ __forceinline__ const char* b_base(const Gemm& g, const Unit& u) const { return (const char*)g.Bt + (size_t)block_e[u.pm] * bstride + (size_t)u.pn * ((size_t)BM * g.K * 2); }
    __device__ __forceinline__ void a_ready(const Unit&) const {}
    __device__ __forceinline__ void done(const Unit&) const {}
};

typedef unsigned u32x2 __attribute__((ext_vector_type(2)));
typedef int v8i_t __attribute__((ext_vector_type(8)));
typedef int v4i_t __attribute__((ext_vector_type(4)));
__device__ __forceinline__ v8i_t cat8(bf16x8 lo, bf16x8 hi) { const v4i_t a = __builtin_bit_cast(v4i_t, lo), b = __builtin_bit_cast(v4i_t, hi); return __builtin_shufflevector(a, b, 0, 1, 2, 3, 4, 5, 6, 7); }
__device__ __forceinline__ unsigned pk_fp8x4(float a, float b, float c, float d) {
    a = __builtin_amdgcn_fmed3f(a, -448.f, 448.f); b = __builtin_amdgcn_fmed3f(b, -448.f, 448.f); c = __builtin_amdgcn_fmed3f(c, -448.f, 448.f); d = __builtin_amdgcn_fmed3f(d, -448.f, 448.f);
    int w = 0; w = __builtin_amdgcn_cvt_pk_fp8_f32(a, b, w, false); w = __builtin_amdgcn_cvt_pk_fp8_f32(c, d, w, true); return (unsigned)w; }
typedef __bf16 bf2_t __attribute__((ext_vector_type(2)));
typedef float f32x2_t __attribute__((ext_vector_type(2)));
__device__ __forceinline__ unsigned cvt_pk_bf16_c(float lo, float hi) { const f32x2_t v = {lo, hi}; const bf2_t r = __builtin_convertvector(v, bf2_t); return __builtin_bit_cast(unsigned, r); }
__device__ __forceinline__ unsigned cvt_pk_bf16(float lo, float hi) { unsigned r; asm volatile("v_cvt_pk_bf16_f32 %0, %1, %2" : "=v"(r) : "v"(lo), "v"(hi)); return r; }
__device__ __forceinline__ float bf_lo(unsigned w) { return __builtin_bit_cast(float, w << 16); }
__device__ __forceinline__ float bf_hi(unsigned w) { return __builtin_bit_cast(float, w & 0xffff0000u); }
__device__ __forceinline__ float sigmoidf_(float x) { return __builtin_amdgcn_rcpf(1.f + __expf(-x)); }

struct EpiAct {
    static constexpr bool PERM = true, AFTER_DRAIN = false; static constexpr int MIDK = 0;
    bf16_t* O; int ldc; int s1lo, s1hi, s2lo, s2hi, clo, chi; float sc; int nostore; const float* ssq; float inv_n, eps; float gsc;
    __device__ __forceinline__ void operator()(const f32x4 (&acc)[2][2][4][2], const Unit& u, int wr, int wc, int fr, int fq) const {
        const int row0 = u.pm * BM + wr * 64 + fr, col0 = u.pn * BM + wc * 32 + 8 * fq;
        const bool sg = (u.pn >= s1lo && u.pn < s1hi) || (u.pn >= s2lo && u.pn < s2hi);
        const float s = (sg ? 1.f : gsc) * ((u.pn >= clo && u.pn < chi) ? sc : 1.f);
        float rscv[2][4];
#pragma unroll
        for (int ai = 0; ai < 2; ++ai)
#pragma unroll
            for (int m = 0; m < 4; ++m) { float rsc = s;
                if (ssq) { const f32x4* sp = (const f32x4*)(ssq + (size_t)(row0 + ai * HALF + m * 16) * 32); float t = 0.f;
#pragma unroll
                    for (int q = 0; q < 8; ++q) { const f32x4 p4 = sp[q]; t += p4[0]; t += p4[1]; t += p4[2]; t += p4[3]; }
                    rsc = s * (1.f / sqrtf(t * inv_n + eps)); }
                rscv[ai][m] = rsc; }
#pragma unroll
        for (int ai = 0; ai < 2; ++ai)
#pragma unroll
            for (int m = 0; m < 4; ++m) { bf16_t* rowp = O + (size_t)(row0 + ai * HALF + m * 16) * ldc + col0;
                const float rsc = rscv[ai][m];
#pragma unroll
                for (int bj = 0; bj < 2; ++bj) { f32x4 v0 = acc[ai][bj][m][0], v1 = acc[ai][bj][m][1];
                    if (sg) {
#pragma unroll
                        for (int j = 0; j < 4; ++j) { v0[j] = sigmoidf_(v0[j] * gsc); v1[j] = sigmoidf_(v1[j] * gsc); } }
                    v0 = v0 * rsc; v1 = v1 * rsc;
                    u32x4 w; w.x = cvt_pk_bf16(v0[0], v0[1]); w.y = cvt_pk_bf16(v0[2], v0[3]); w.z = cvt_pk_bf16(v1[0], v1[1]); w.w = cvt_pk_bf16(v1[2], v1[3]);
                    if (!nostore) *(u32x4*)(rowp + bj * HALF) = w; } }
    }
};

template <bool ADD> struct EpiGate {
    static constexpr bool PERM = true, AFTER_DRAIN = false; static constexpr int MIDK = 0;
    const bf16_t* Gt; int ldg, goff; const bf16_t* Tin; bf16_t* O; int ldo;
    __device__ __forceinline__ void operator()(const f32x4 (&acc)[2][2][4][2], const Unit& u, int wr, int wc, int fr, int fq) const {
        const int row0 = u.pm * BM + wr * 64 + fr, col0 = u.pn * BM + wc * 32 + 8 * fq;
#pragma unroll
        for (int ai = 0; ai < 2; ++ai)
#pragma unroll
            for (int m = 0; m < 4; ++m) { const size_t row = (size_t)(row0 + ai * HALF + m * 16);
#pragma unroll
                for (int bj = 0; bj < 2; ++bj) { const int col = col0 + bj * HALF;
                    const u32x4 gw = *(const u32x4*)(Gt + row * ldg + goff + col);
                    f32x4 v0 = acc[ai][bj][m][0], v1 = acc[ai][bj][m][1];
                    v0[0] *= bf_lo(gw.x); v0[1] *= bf_hi(gw.x); v0[2] *= bf_lo(gw.y); v0[3] *= bf_hi(gw.y);
                    v1[0] *= bf_lo(gw.z); v1[1] *= bf_hi(gw.z); v1[2] *= bf_lo(gw.w); v1[3] *= bf_hi(gw.w);
                    if (ADD) { const u32x4 tw = *(const u32x4*)(Tin + row * ldo + col);
                        v0[0] += bf_lo(tw.x); v0[1] += bf_hi(tw.x); v0[2] += bf_lo(tw.y); v0[3] += bf_hi(tw.y);
                        v1[0] += bf_lo(tw.z); v1[1] += bf_hi(tw.z); v1[2] += bf_lo(tw.w); v1[3] += bf_hi(tw.w); }
                    u32x4 w; w.x = cvt_pk_bf16(v0[0], v0[1]); w.y = cvt_pk_bf16(v0[2], v0[3]); w.z = cvt_pk_bf16(v1[0], v1[1]); w.w = cvt_pk_bf16(v1[2], v1[3]);
                    *(u32x4*)(O + row * ldo + col) = w; } }
    }
};


struct EpiMerge {
    static constexpr bool PERM = true, AFTER_DRAIN = false; static constexpr int MIDK = 16;
    const bf16_t* Gt; int ldg, gm_off, ga_off; bf16_t* O; int ldo;
    __device__ __forceinline__ void mid(f32x4 (&acc)[2][2][4][2], const Unit& u, int wr, int wc, int fr, int fq) const {
        const int row0 = u.pm * BM + wr * 64 + fr, col0 = u.pn * BM + wc * 32 + 8 * fq;
#pragma unroll
        for (int ai = 0; ai < 2; ++ai)
#pragma unroll
            for (int m = 0; m < 4; ++m) { const size_t ro = (size_t)(row0 + ai * HALF + m * 16) * ldg + col0;
#pragma unroll
                for (int bj = 0; bj < 2; ++bj) { const u32x4 gm = *(const u32x4*)(Gt + ro + gm_off + bj * HALF), ga = *(const u32x4*)(Gt + ro + ga_off + bj * HALF);
                    f32x4& v0 = acc[ai][bj][m][0]; f32x4& v1 = acc[ai][bj][m][1];
                    v0[0] *= bf_lo(gm.x) * __builtin_amdgcn_rcpf(bf_lo(ga.x)); v0[1] *= bf_hi(gm.x) * __builtin_amdgcn_rcpf(bf_hi(ga.x)); v0[2] *= bf_lo(gm.y) * __builtin_amdgcn_rcpf(bf_lo(ga.y)); v0[3] *= bf_hi(gm.y) * __builtin_amdgcn_rcpf(bf_hi(ga.y));
                    v1[0] *= bf_lo(gm.z) * __builtin_amdgcn_rcpf(bf_lo(ga.z)); v1[1] *= bf_hi(gm.z) * __builtin_amdgcn_rcpf(bf_hi(ga.z)); v1[2] *= bf_lo(gm.w) * __builtin_amdgcn_rcpf(bf_lo(ga.w)); v1[3] *= bf_hi(gm.w) * __builtin_amdgcn_rcpf(bf_hi(ga.w)); } }
    }
    __device__ __forceinline__ void operator()(const f32x4 (&acc)[2][2][4][2], const Unit& u, int wr, int wc, int fr, int fq) const {
        const int row0 = u.pm * BM + wr * 64 + fr, col0 = u.pn * BM + wc * 32 + 8 * fq;
        u32x4 gwv[2][4][2];
#pragma unroll
        for (int ai = 0; ai < 2; ++ai)
#pragma unroll
            for (int m = 0; m < 4; ++m)
#pragma unroll
                for (int bj = 0; bj < 2; ++bj) gwv[ai][m][bj] = *(const u32x4*)(Gt + (size_t)(row0 + ai * HALF + m * 16) * ldg + ga_off + col0 + bj * HALF);
#pragma unroll
        for (int ai = 0; ai < 2; ++ai)
#pragma unroll
            for (int m = 0; m < 4; ++m) { const size_t row = (size_t)(row0 + ai * HALF + m * 16);
#pragma unroll
                for (int bj = 0; bj < 2; ++bj) { const int col = col0 + bj * HALF;
                    const u32x4 gw = gwv[ai][m][bj];
                    f32x4 v0 = acc[ai][bj][m][0], v1 = acc[ai][bj][m][1];
                    v0[0] *= bf_lo(gw.x); v0[1] *= bf_hi(gw.x); v0[2] *= bf_lo(gw.y); v0[3] *= bf_hi(gw.y);
                    v1[0] *= bf_lo(gw.z); v1[1] *= bf_hi(gw.z); v1[2] *= bf_lo(gw.w); v1[3] *= bf_hi(gw.w);
                    u32x4 w; w.x = cvt_pk_bf16(v0[0], v0[1]); w.y = cvt_pk_bf16(v0[2], v0[3]); w.z = cvt_pk_bf16(v1[0], v1[1]); w.w = cvt_pk_bf16(v1[2], v1[3]);
                    *(u32x4*)(O + row * ldo + col) = w; } }
    }
};

struct EpiResF32 {
    static constexpr bool PERM = false, AFTER_DRAIN = false; static constexpr int MIDK = 0;
    float* C; int ldc; const float* R;
    __device__ __forceinline__ void operator()(const f32x4 (&acc)[2][2][4][2], const Unit& u, int wr, int wc, int fr, int fq) const {
        const int row0 = u.pm * BM + wr * 64 + fr, col0 = u.pn * BM + wc * 32 + 4 * fq;
#pragma unroll
        for (int ai = 0; ai < 2; ++ai)
#pragma unroll
            for (int m = 0; m < 4; ++m) { const size_t ro = (size_t)(row0 + ai * HALF + m * 16) * ldc + col0;
#pragma unroll
                for (int bj = 0; bj < 2; ++bj)
#pragma unroll
                    for (int n = 0; n < 2; ++n) { f32x4 v = acc[ai][bj][m][n];
                        if (R) v = v + *(const f32x4*)(R + ro + bj * HALF + n * 16);
                        *(f32x4*)(C + ro + bj * HALF + n * 16) = v; } }
    }
};


struct EpiResNorm {
    static constexpr bool PERM = true, AFTER_DRAIN = false; static constexpr int MIDK = 0;
    float* C; int ldc; const float* R; bf16_t* XB; const float* wcol; float* SSQ;
    __device__ __forceinline__ void operator()(const f32x4 (&acc)[2][2][4][2], const Unit& u, int wr, int wc, int fr, int fq) const {
        const int row0 = u.pm * BM + wr * 64 + fr, col0 = u.pn * BM + wc * 32 + 8 * fq;
        f32x4 wv[2][2];
#pragma unroll
        for (int bj = 0; bj < 2; ++bj)
#pragma unroll
            for (int n = 0; n < 2; ++n) wv[bj][n] = *(const f32x4*)(wcol + col0 + bj * HALF + 4 * n);
#pragma unroll
        for (int ai = 0; ai < 2; ++ai)
#pragma unroll
            for (int m = 0; m < 4; ++m) { const int row = row0 + ai * HALF + m * 16; const size_t ro = (size_t)row * ldc + col0; float ss = 0.f;
#pragma unroll
                for (int bj = 0; bj < 2; ++bj) {
                    const f32x4 v0 = acc[ai][bj][m][0] + *(const f32x4*)(R + ro + bj * HALF), v1 = acc[ai][bj][m][1] + *(const f32x4*)(R + ro + bj * HALF + 4);
                    *(f32x4*)(C + ro + bj * HALF) = v0; *(f32x4*)(C + ro + bj * HALF + 4) = v1;
                    ss += (v0[0] * v0[0] + v0[1] * v0[1]) + (v0[2] * v0[2] + v0[3] * v0[3]) + (v1[0] * v1[0] + v1[1] * v1[1]) + (v1[2] * v1[2] + v1[3] * v1[3]);
                    const f32x4 y0 = v0 * wv[bj][0], y1 = v1 * wv[bj][1];
                    u32x4 w; w.x = cvt_pk_bf16(y0[0], y0[1]); w.y = cvt_pk_bf16(y0[2], y0[3]); w.z = cvt_pk_bf16(y1[0], y1[1]); w.w = cvt_pk_bf16(y1[2], y1[3]);
                    *(u32x4*)(XB + ro + bj * HALF) = w; }
                ss += __shfl_xor(ss, 16); ss += __shfl_xor(ss, 32);
                if (fq == 0) SSQ[(size_t)row * 32 + 4 * u.pn + wc] = ss; }
    }
};


template <bool RB> struct EpiResB {
    static constexpr bool PERM = true, AFTER_DRAIN = false; static constexpr int MIDK = 0;
    bf16_t* C; int ldc; const void* R; float* SSQ;
    __device__ __forceinline__ void operator()(const f32x4 (&acc)[2][2][4][2], const Unit& u, int wr, int wc, int fr, int fq) const {
        const int row0 = u.pm * BM + wr * 64 + fr, col0 = u.pn * BM + wc * 32 + 8 * fq;
#pragma unroll
        for (int ai = 0; ai < 2; ++ai) {
            u32x4 rwv[4][2]; f32x4 rfv[4][2][2];
#pragma unroll
            for (int m = 0; m < 4; ++m)
#pragma unroll
                for (int bj = 0; bj < 2; ++bj) { const size_t ro = (size_t)(row0 + ai * HALF + m * 16) * ldc + col0 + bj * HALF;
                    if (RB) rwv[m][bj] = *(const u32x4*)((const bf16_t*)R + ro);
                    else { rfv[m][bj][0] = *(const f32x4*)((const float*)R + ro); rfv[m][bj][1] = *(const f32x4*)((const float*)R + ro + 4); } }
#pragma unroll
            for (int m = 0; m < 4; ++m) { const int row = row0 + ai * HALF + m * 16; const size_t ro = (size_t)row * ldc + col0; float ss = 0.f;
#pragma unroll
                for (int bj = 0; bj < 2; ++bj) { f32x4 v0 = acc[ai][bj][m][0], v1 = acc[ai][bj][m][1];
                    if (RB) { const u32x4 rw = rwv[m][bj];
                        v0[0] += bf_lo(rw.x); v0[1] += bf_hi(rw.x); v0[2] += bf_lo(rw.y); v0[3] += bf_hi(rw.y); v1[0] += bf_lo(rw.z); v1[1] += bf_hi(rw.z); v1[2] += bf_lo(rw.w); v1[3] += bf_hi(rw.w); }
                    else { v0 = v0 + rfv[m][bj][0]; v1 = v1 + rfv[m][bj][1]; }
                    ss += (v0[0] * v0[0] + v0[1] * v0[1]) + (v0[2] * v0[2] + v0[3] * v0[3]) + (v1[0] * v1[0] + v1[1] * v1[1]) + (v1[2] * v1[2] + v1[3] * v1[3]);
                    u32x4 w; w.x = cvt_pk_bf16(v0[0], v0[1]); w.y = cvt_pk_bf16(v0[2], v0[3]); w.z = cvt_pk_bf16(v1[0], v1[1]); w.w = cvt_pk_bf16(v1[2], v1[3]);
                    *(u32x4*)(C + ro + bj * HALF) = w; }
                if (SSQ) { ss += __shfl_xor(ss, 16); ss += __shfl_xor(ss, 32); if (fq == 0) SSQ[(size_t)row * 32 + 4 * u.pn + wc] = ss; } }
        }
    }
};

struct EpiSwiGLU {
    static constexpr bool PERM = true, AFTER_DRAIN = false; static constexpr int MIDK = 0;
    unsigned char* O; int ldo; const float* bgu; const int* block_e; int dff; float ascale, oscale; const float* rrow;
    __device__ __forceinline__ void operator()(const f32x4 (&acc)[2][2][4][2], const Unit& u, int wr, int wc, int fr, int fq) const {
        const int row0 = u.pm * BM + wr * 64 + fr, oc = u.pn * HALF + wc * 32 + 8 * fq;
        const float* bg = bgu + (size_t)block_e[u.pm] * (2 * dff) + oc; const float* bu = bg + dff;
        const f32x4 bg0 = *(const f32x4*)bg, bg1 = *(const f32x4*)(bg + 4), bu0 = *(const f32x4*)bu, bu1 = *(const f32x4*)(bu + 4);
        float rsv[2][4];
#pragma unroll
        for (int ai = 0; ai < 2; ++ai)
#pragma unroll
            for (int m = 0; m < 4; ++m) rsv[ai][m] = rrow[row0 + ai * HALF + m * 16];
#pragma unroll
        for (int ai = 0; ai < 2; ++ai)
#pragma unroll
            for (int m = 0; m < 4; ++m) { const float rs = ascale * rsv[ai][m];
                f32x4 g0 = acc[ai][0][m][0] * rs + bg0, g1 = acc[ai][0][m][1] * rs + bg1, u0 = acc[ai][1][m][0] * rs + bu0, u1 = acc[ai][1][m][1] * rs + bu1, a0, a1;
#pragma unroll
                for (int j = 0; j < 4; ++j) {
                    float g = fminf(g0[j], 7.0f), uu = __builtin_amdgcn_fmed3f(u0[j], -7.0f, 7.0f); a0[j] = (uu + 1.f) * (g * __builtin_amdgcn_rcpf(1.f + __builtin_amdgcn_exp2f(g * (-1.702f * 1.4426950408889634f)))) * oscale;
                    g = fminf(g1[j], 7.0f); uu = __builtin_amdgcn_fmed3f(u1[j], -7.0f, 7.0f); a1[j] = (uu + 1.f) * (g * __builtin_amdgcn_rcpf(1.f + __builtin_amdgcn_exp2f(g * (-1.702f * 1.4426950408889634f)))) * oscale; }
                u32x2 w; w.x = pk_fp8x4(a0[0], a0[1], a0[2], a0[3]); w.y = pk_fp8x4(a1[0], a1[1], a1[2], a1[3]);
                *(u32x2*)(O + (size_t)(row0 + ai * HALF + m * 16) * ldo + oc) = w; }
    }
};

struct EpiDown {
    static constexpr bool PERM = true, AFTER_DRAIN = false; static constexpr int MIDK = 0;
    unsigned char* O; int ldo; const float* bdn; const int* block_e; const float* rgate; float ascale, oscale;
    __device__ __forceinline__ void operator()(const f32x4 (&acc)[2][2][4][2], const Unit& u, int wr, int wc, int fr, int fq) const {
        const int row0 = u.pm * BM + wr * 64 + fr, col0 = u.pn * BM + wc * 32 + 8 * fq;
        const float* bb = bdn + (size_t)block_e[u.pm] * ldo + col0;
        f32x4 bv[2][2];
#pragma unroll
        for (int bj = 0; bj < 2; ++bj)
#pragma unroll
            for (int n = 0; n < 2; ++n) bv[bj][n] = *(const f32x4*)(bb + bj * HALF + 4 * n);
        float gtv[2][4];
#pragma unroll
        for (int ai = 0; ai < 2; ++ai)
#pragma unroll
            for (int m = 0; m < 4; ++m) gtv[ai][m] = rgate[row0 + ai * HALF + m * 16];
#pragma unroll
        for (int ai = 0; ai < 2; ++ai)
#pragma unroll
            for (int m = 0; m < 4; ++m) { const int row = row0 + ai * HALF + m * 16; const float gt = gtv[ai][m] * oscale;
#pragma unroll
                for (int bj = 0; bj < 2; ++bj) { const f32x4 v0 = (acc[ai][bj][m][0] * ascale + bv[bj][0]) * gt, v1 = (acc[ai][bj][m][1] * ascale + bv[bj][1]) * gt;
                    u32x2 w; w.x = pk_fp8x4(v0[0], v0[1], v0[2], v0[3]); w.y = pk_fp8x4(v1[0], v1[1], v1[2], v1[3]);
                    *(u32x2*)(O + (size_t)row * ldo + col0 + bj * HALF) = w; } }
    }
};

template <class Epi, class Sched, bool ALIGN_EPI = false, bool SP2 = false, bool FP8 = false>
__device__ __forceinline__ void gemm_phase(PG8_LAS unsigned char* lds, const Gemm g, const Sched& S, const Epi& E, const int wave_id, const int koff_in = 0) {
    int tid_ = wave_id * 64 + (int)__builtin_amdgcn_mbcnt_hi(~0u, __builtin_amdgcn_mbcnt_lo(~0u, 0u)); asm volatile("" : "+v"(tid_));
    const int tid = tid_, wid = __builtin_amdgcn_readfirstlane(tid >> 6), lane = tid & 63, wr = wid >> 2, wc = wid & 3, fr = lane & 15, fq = lane >> 4;
    const int K = g.K, nt = K / BK;
    const int koff = koff_in & (nt - 1) & ~1;
#define PG8_KO(i) ((size_t)(((i) + koff) & (nt - 1)) * kstep)
    unsigned voffA[2], voffB[2];
#pragma unroll
    for (int i = 0; i < 2; ++i) { int R, C; stage_rc(tid * 16 + i * 8192, R, C); const int Rb = Epi::PERM ? ((R & ~31) + perm32(R & 31)) : R;
        voffA[i] = (unsigned)(R * K + C) * 2u; voffB[i] = (unsigned)(Rb * K + C) * 2u; }
    const size_t kstep = (size_t)(BK * 2);
    const size_t hstep = (size_t)HALF * K * 2;
    const size_t tstep = 2 * hstep; (void)tstep;
    const unsigned ldsw = (unsigned)wid * 1024u;
    const int aoff = lds_byte(wr * 64 + fr, fq * 8), boff = lds_byte(wc * 32 + fr, fq * 8);
#define PG8_SA(b, h) (((b) * 2 + (h)) * HTB)
#define PG8_SB(b, h) ((4 + (b) * 2 + (h)) * HTB)
#define PG8_STAGE(bufoff, gbase, voff) do { _Pragma("unroll") for (int _i = 0; _i < 2; ++_i) \
        __builtin_amdgcn_global_load_lds((const unsigned*)((const char*)(gbase) + (voff)[_i]), (PG8_LAS unsigned*)(lds + (bufoff) + ldsw + _i * 8192), 16, 0, 0); } while (0)
#define PG8_LDA(dst, b, h) do { _Pragma("unroll") for (int m = 0; m < 4; ++m) _Pragma("unroll") for (int k = 0; k < 2; ++k) dst[m][k] = *(const PG8_LAS bf16x8*)(lds + PG8_SA(b, h) + aoff + m * 2048 + k * 1024); } while (0)
#define PG8_LDB(dst, b, h) do { _Pragma("unroll") for (int n = 0; n < 2; ++n) _Pragma("unroll") for (int k = 0; k < 2; ++k) dst[n][k] = *(const PG8_LAS bf16x8*)(lds + PG8_SB(b, h) + boff + n * 2048 + k * 1024); } while (0)
#define PG8_MMA(ai, bj, At, Bt) do { __builtin_amdgcn_s_setprio(1); _Pragma("unroll") for (int m = 0; m < 4; ++m) _Pragma("unroll") for (int n = 0; n < 2; ++n) { \
        if constexpr (FP8) { asm volatile("s_nop 1\n\tv_mfma_scale_f32_16x16x128_f8f6f4 %0, %1, %2, %0, %3, %3 op_sel_hi:[0,0,0]" : "+v"(acc[ai][bj][m][n]) : "v"(cat8(Bt[n][0], Bt[n][1])), "v"(cat8(At[m][0], At[m][1])), "v"(one_scale)); } \
        else { _Pragma("unroll") for (int k = 0; k < 2; ++k) acc[ai][bj][m][n] = __builtin_amdgcn_mfma_f32_16x16x32_bf16(Bt[n][k], At[m][k], acc[ai][bj][m][n], 0, 0, 0); } } \
        __builtin_amdgcn_s_setprio(0); } while (0)
#define PG8_WAIT_V(n) asm volatile("s_waitcnt vmcnt(" #n ")" ::: "memory")
#define PG8_WAIT_L(n) asm volatile("s_waitcnt lgkmcnt(" #n ")" ::: "memory")
#define PG8_BAR __builtin_amdgcn_s_barrier()
#define PG8_SCHED __builtin_amdgcn_sched_barrier(0)
    Unit cur, nxt; int ui = 0;
    if (!S.next(0, cur)) return;
#ifdef PG8_STAGGER
    { const int dly = ((int)blockIdx.x >> 3) & 3; for (int q = 0; q < dly; ++q) { __builtin_amdgcn_s_sleep(60); } }
#endif
    const int one_scale = 0x7F7F7F7F; (void)one_scale;
    f32x4 acc[2][2][4][2];
#pragma unroll
    for (int a = 0; a < 2; ++a)
#pragma unroll
        for (int b = 0; b < 2; ++b)
#pragma unroll
            for (int m = 0; m < 4; ++m)
#pragma unroll
                for (int n = 0; n < 2; ++n) acc[a][b][m][n] = (f32x4){0.f, 0.f, 0.f, 0.f};
    bf16x8 At[4][2], B0[2][2], B1[2][2];
    const char* cA = S.a_base(g, cur); const char* cB = S.b_base(g, cur);
    S.a_ready(cur);
    if constexpr (SP2) {
        PG8_STAGE(PG8_SB(0, 0), cB + PG8_KO(0), voffB); PG8_STAGE(PG8_SB(0, 1), cB + hstep + PG8_KO(0), voffB); PG8_STAGE(PG8_SA(0, 0), cA + PG8_KO(0), voffA); PG8_STAGE(PG8_SA(0, 1), cA + hstep + PG8_KO(0), voffA);
        if (wr == 1) PG8_BAR;
        PG8_WAIT_V(2); PG8_BAR;
        PG8_STAGE(PG8_SB(1, 0), cB + PG8_KO(1), voffB); PG8_STAGE(PG8_SA(1, 0), cA + PG8_KO(1), voffA); PG8_STAGE(PG8_SB(1, 1), cB + hstep + PG8_KO(1), voffB);
        PG8_WAIT_V(6); PG8_BAR;
    } else {
        PG8_STAGE(PG8_SB(0, 0), cB + PG8_KO(0), voffB); PG8_STAGE(PG8_SA(0, 0), cA + PG8_KO(0), voffA); PG8_STAGE(PG8_SB(0, 1), cB + hstep + PG8_KO(0), voffB); PG8_STAGE(PG8_SA(0, 1), cA + hstep + PG8_KO(0), voffA);
        if (wr == 1) PG8_BAR;
        PG8_WAIT_V(4); PG8_BAR;
        PG8_STAGE(PG8_SB(1, 0), cB + PG8_KO(1), voffB); PG8_STAGE(PG8_SA(1, 0), cA + PG8_KO(1), voffA); PG8_STAGE(PG8_SB(1, 1), cB + hstep + PG8_KO(1), voffB);
        PG8_WAIT_V(6); PG8_BAR;
    }
    for (;;) {
        const bool has_next = S.next(ui + 1, nxt);
        const char* nA = has_next ? S.a_base(g, nxt) : cA; const char* nB = has_next ? S.b_base(g, nxt) : cB;
        for (int t = 0; t < nt; t += 2) {
            const bool last = (t == nt - 2);
            const char* a1 = cA + PG8_KO(t + 1);
            const char* a2 = last ? nA + PG8_KO(0) : cA + PG8_KO(t + 2); const char* b2 = last ? nB + PG8_KO(0) : cB + PG8_KO(t + 2);
            const char* a3 = a2 + kstep; const char* b3 = b2 + kstep;
            if constexpr (Epi::MIDK > 0) { if (t == Epi::MIDK) { int lm = lane; asm volatile("" : "+v"(lm)); E.mid(acc, cur, wr, wc, lm & 15, lm >> 4); } }
            if (last && has_next) S.a_ready(nxt);
            if constexpr (SP2) {
            PG8_LDB(B0, 0, 0); PG8_LDB(B1, 0, 1); PG8_SCHED; PG8_LDA(At, 0, 0); PG8_STAGE(PG8_SA(1, 1), a1 + hstep, voffA);
            PG8_WAIT_V(8); PG8_WAIT_L(0); PG8_BAR; PG8_MMA(0, 0, At, B0); PG8_MMA(0, 1, At, B1); PG8_BAR; PG8_SCHED;
            PG8_LDA(At, 0, 1); PG8_STAGE(PG8_SB(0, 0), b2, voffB); PG8_STAGE(PG8_SB(0, 1), b2 + hstep, voffB); PG8_STAGE(PG8_SA(0, 0), a2, voffA);
            PG8_WAIT_V(8); PG8_WAIT_L(0); PG8_BAR; PG8_MMA(1, 0, At, B0); PG8_MMA(1, 1, At, B1); PG8_BAR; PG8_SCHED;
            PG8_LDB(B0, 1, 0); PG8_LDB(B1, 1, 1); PG8_SCHED; PG8_LDA(At, 1, 0); PG8_STAGE(PG8_SA(0, 1), a2 + hstep, voffA);
            PG8_WAIT_V(8); PG8_WAIT_L(0); PG8_BAR; PG8_MMA(0, 0, At, B0); PG8_MMA(0, 1, At, B1); PG8_BAR; PG8_SCHED;
            PG8_LDA(At, 1, 1); PG8_STAGE(PG8_SB(1, 0), b3, voffB); PG8_STAGE(PG8_SB(1, 1), b3 + hstep, voffB); PG8_STAGE(PG8_SA(1, 0), a3, voffA);
            PG8_WAIT_V(8); PG8_WAIT_L(0); PG8_BAR; PG8_MMA(1, 0, At, B0); PG8_MMA(1, 1, At, B1); PG8_BAR; PG8_SCHED;
            } else {
            PG8_LDB(B0, 0, 0); PG8_SCHED; PG8_LDA(At, 0, 0); PG8_STAGE(PG8_SA(1, 1), a1 + hstep, voffA);
            PG8_WAIT_L(8); PG8_BAR; PG8_WAIT_L(0); PG8_MMA(0, 0, At, B0); PG8_BAR; PG8_SCHED;
            PG8_LDB(B1, 0, 1); PG8_STAGE(PG8_SB(0, 0), b2, voffB);
            PG8_BAR; PG8_WAIT_L(0); PG8_MMA(0, 1, At, B1); PG8_BAR;
            PG8_LDA(At, 0, 1); PG8_STAGE(PG8_SA(0, 0), a2, voffA);
            PG8_BAR; PG8_WAIT_L(0); PG8_MMA(1, 0, At, B0); PG8_BAR; PG8_SCHED;
            PG8_STAGE(PG8_SB(0, 1), b2 + hstep, voffB);
            PG8_WAIT_V(6); PG8_BAR; PG8_MMA(1, 1, At, B1); PG8_BAR;
            PG8_LDB(B0, 1, 0); PG8_SCHED; PG8_LDA(At, 1, 0); PG8_STAGE(PG8_SA(0, 1), a2 + hstep, voffA);
            PG8_WAIT_L(8); PG8_BAR; PG8_WAIT_L(0); PG8_MMA(0, 0, At, B0); PG8_BAR; PG8_SCHED;
            PG8_LDB(B1, 1, 1); PG8_STAGE(PG8_SB(1, 0), b3, voffB);
            PG8_BAR; PG8_WAIT_L(0); PG8_MMA(0, 1, At, B1); PG8_BAR;
            PG8_LDA(At, 1, 1); PG8_STAGE(PG8_SA(1, 0), a3, voffA);
            PG8_BAR; PG8_WAIT_L(0); PG8_MMA(1, 0, At, B0); PG8_BAR; PG8_SCHED;
            PG8_STAGE(PG8_SB(1, 1), b3 + hstep, voffB);
            PG8_WAIT_V(6); PG8_BAR; PG8_MMA(1, 1, At, B1); PG8_BAR;
            }
        }
        if constexpr (FP8) { asm volatile("s_nop 15\n\ts_nop 15" ::: "memory"); }
        if constexpr (ALIGN_EPI) { if (wr == 0) PG8_BAR; }
        if constexpr (!Epi::AFTER_DRAIN) { int lz = lane; asm volatile("" : "+v"(lz));
            E(acc, cur, wr, wc, lz & 15, lz >> 4); S.done(cur); }
        if (!has_next) break;
#pragma unroll
        for (int a = 0; a < 2; ++a)
#pragma unroll
            for (int b = 0; b < 2; ++b)
#pragma unroll
                for (int m = 0; m < 4; ++m)
#pragma unroll
                    for (int n = 0; n < 2; ++n) acc[a][b][m][n] = (f32x4){0.f, 0.f, 0.f, 0.f};
        cur = nxt; cA = nA; cB = nB; ++ui;
        if constexpr (ALIGN_EPI) { if (wr == 1) PG8_BAR; }
    }
    PG8_WAIT_V(0);
    if constexpr (!ALIGN_EPI) { if (wr == 0) PG8_BAR; }
    PG8_BAR;
    if constexpr (Epi::AFTER_DRAIN) { E.fused(acc, cur, wr, wc, fr, fq, lds, wid, lane); S.done(cur); }
#undef PG8_KO
#undef PG8_SA
#undef PG8_SB
#undef PG8_STAGE
#undef PG8_LDA
#undef PG8_LDB
#undef PG8_MMA
#undef PG8_WAIT_V
#undef PG8_WAIT_L
#undef PG8_BAR
#undef PG8_SCHED
}
}

#define PROBE_MASK 0x0
constexpr int NWAVES = 8, NTHR = 512;
constexpr int BATCH = 2, SEQ = 8192, T = BATCH * SEQ, D = 2048;
constexpr int CHUNK = 64, NCH = SEQ / CHUNK;
constexpr int MH = 4, MD = 256, MW = 1024;
constexpr int AH = 16, AD = 64, AW = 1024;
constexpr int NMEM = 256, XH = 4, XD = 128, XW = 512;
constexpr int NE = 32, TOPK = 4, DFF = 2048, MOEB = 256;
constexpr int IN_COLS = 11272, NPROJ = 11264;
constexpr int NROWS_MAX = (T * TOPK / MOEB + NE) * MOEB;
constexpr int NBLK_MAX = NROWS_MAX / MOEB;
constexpr float EPS = 1e-6f;
constexpr float HSCALE = 16.f;
constexpr float WSCALE = 1024.f, XSCALE = 16.f, ASCALE = 8.f, YSCALE = 16.f;
constexpr int PQ_M = 0, PK_M = 1024, PV_M = 2048, PO_M = 3072, PQ_A = 4096, PK_A = 5120, PV_A = 6144, PG_M = 7168, PG_A = 9216;

constexpr size_t MiB = 1u << 20;
constexpr size_t al(size_t x) { return (x + MiB - 1) / MiB * MiB; }
constexpr size_t WS_CTL = 0, CTL_ZERO_BYTES = 1 * MiB;
constexpr size_t WS_WIN = WS_CTL + CTL_ZERO_BYTES;
constexpr size_t WS_WIN8 = WS_WIN + al((size_t)2048 * D * 2);
constexpr size_t WS_H8 = WS_WIN8 + al((size_t)9216 * D);
constexpr size_t WS_WBM = WS_H8 + al((size_t)T * D);
constexpr size_t WS_WBA = WS_WBM + al((size_t)D * MW * 2);
constexpr size_t WS_WOUT = WS_WBA + al((size_t)D * AW * 2);
constexpr size_t WS_WQ = WS_WOUT + al((size_t)D * D * 2);
constexpr size_t WS_WKV = WS_WQ + al((size_t)XW * D * 2);
constexpr size_t WS_WO = WS_WKV + al((size_t)2 * XW * D * 2);
constexpr size_t WS_WR = WS_WO + al((size_t)D * XW * 2);
constexpr size_t WS_WGU = WS_WR + al((size_t)256 * D * 2);
constexpr size_t WS_WDN = WS_WGU + al((size_t)NE * 2 * DFF * D);
constexpr size_t WS_H = WS_WDN + al((size_t)NE * D * DFF);
constexpr size_t WS_PROJ = WS_H + al((size_t)T * D * 2);
constexpr size_t WS_IFG = WS_PROJ + al((size_t)T * NPROJ * 2);
constexpr size_t WS_QKC = WS_IFG + al((size_t)T * 8 * 4);
constexpr size_t WS_BCUM = WS_QKC + al((size_t)T * 2048 * 2);
constexpr size_t WS_CLOC = WS_BCUM + al((size_t)T * 4 * 4);
constexpr size_t WS_CIN = WS_CLOC + al((size_t)1024 * 65536 * 2);
constexpr size_t WS_NLOC = WS_CIN + al((size_t)1024 * 65536 * 2);
constexpr size_t WS_NIN = WS_NLOC + al((size_t)1024 * 256 * 4);
constexpr size_t WS_CHS = WS_NIN + al((size_t)1024 * 256 * 4);
constexpr size_t WS_HM = WS_CHS + MiB;
constexpr size_t WS_YA = WS_HM + al((size_t)T * MW * 2);
constexpr size_t WS_T1 = WS_YA + al((size_t)T * AW * 2);
constexpr size_t WS_MRG = WS_T1 + al((size_t)T * D * 2);
constexpr size_t WS_X1 = WS_MRG + al((size_t)T * D * 2);
constexpr size_t WS_XN1 = WS_X1 + al((size_t)T * D * 4);
constexpr size_t WS_SSQ1 = WS_XN1 + al((size_t)T * D * 2);
constexpr size_t WS_MEMN = WS_SSQ1 + al((size_t)T * 32 * 4);
constexpr size_t WS_KVX = WS_MEMN + al((size_t)512 * D * 2);
constexpr size_t WS_QX = WS_KVX + al((size_t)512 * 1024 * 2);
constexpr size_t WS_OX = WS_QX + al((size_t)T * XW * 2);
constexpr size_t WS_X2 = WS_OX + al((size_t)T * XW * 2);
constexpr size_t WS_XN3 = WS_X2 + al((size_t)T * D * 4);
constexpr size_t WS_LOG = WS_XN3 + al((size_t)T * D * 2);
constexpr size_t WS_TOPE = WS_LOG + al((size_t)T * 256 * 4);
constexpr size_t WS_GATE = WS_TOPE + al((size_t)T * 4 * 4);
constexpr size_t WS_RANK = WS_GATE + al((size_t)T * 4 * 4);
constexpr size_t WS_DEST = WS_RANK + al((size_t)T * 4 * 4);
constexpr size_t WS_RGATE = WS_DEST + al((size_t)T * 4 * 4);
constexpr size_t WS_RROW = WS_RGATE + al((size_t)NROWS_MAX * 4);
constexpr size_t WS_RSTD = WS_RROW + al((size_t)NROWS_MAX * 4);
constexpr size_t WS_XQ = WS_RSTD + al((size_t)T * 4);
constexpr size_t WS_XPERM = WS_XQ + al((size_t)T * D);
constexpr size_t WS_ACT = WS_XPERM + al((size_t)NROWS_MAX * D);
constexpr size_t WS_YR = WS_ACT + al((size_t)NROWS_MAX * DFF);
constexpr size_t WS_END = WS_YR + al((size_t)NROWS_MAX * D * 2);
constexpr int CW_BAR = 4096;
constexpr int CW_HIST = 16384;
constexpr int CW_BLKE = 32768;
constexpr int CW_NBLK = 33792;

constexpr int RING_OFF = 0, RING_BYTES = 131072;
constexpr int LDSCTL_OFF = RING_BYTES, MISC_OFF = LDSCTL_OFF + 320;
constexpr int LDS_BYTES = 147456;

#define GAS __attribute__((address_space(1)))
#define LAS __attribute__((address_space(3)))
typedef unsigned short bf16;
typedef unsigned v4u __attribute__((ext_vector_type(4)));
typedef unsigned v2u __attribute__((ext_vector_type(2)));
typedef float f32x4 __attribute__((ext_vector_type(4)));
typedef float f32x16 __attribute__((ext_vector_type(16)));
typedef float f32x2 __attribute__((ext_vector_type(2)));
typedef short bf16x8 __attribute__((ext_vector_type(8)));
typedef short bf16x4 __attribute__((ext_vector_type(4)));
typedef GAS unsigned gu32;
#define RLX_AGENT __ATOMIC_RELAXED, __HIP_MEMORY_SCOPE_AGENT
#define LDS_WAIT() asm volatile("s_waitcnt lgkmcnt(0)" ::: "memory")
#define VM_WAIT() asm volatile("s_waitcnt vmcnt(0)" ::: "memory")
__device__ __forceinline__ unsigned pk2(float lo, float hi) { return pg8::cvt_pk_bf16_c(lo, hi); }
__device__ __forceinline__ float bflo(unsigned w) { return __builtin_bit_cast(float, w << 16); }
__device__ __forceinline__ float bfhi(unsigned w) { return __builtin_bit_cast(float, w & 0xffff0000u); }
__device__ __forceinline__ float bf1(bf16 h) { return __builtin_bit_cast(float, ((unsigned)h) << 16); }
__device__ __forceinline__ bf16 f2bf(float f) { return (bf16)(pk2(f, 0.f) & 0xffffu); }
__device__ __forceinline__ float sigm(float x) { return __builtin_amdgcn_rcpf(1.f + __expf(-x)); }
__device__ __forceinline__ f32x16 mfma32(bf16x8 a, bf16x8 b, f32x16 c) { return __builtin_amdgcn_mfma_f32_32x32x16_bf16(a, b, c, 0, 0, 0); }
__device__ __forceinline__ void lds_addf(LAS float* p, float v) { (void)__hip_atomic_fetch_add(p, v, __ATOMIC_RELAXED, __HIP_MEMORY_SCOPE_WORKGROUP); }
__device__ __forceinline__ int lds_addi(LAS int* p, int v) { return __hip_atomic_fetch_add(p, v, __ATOMIC_RELAXED, __HIP_MEMORY_SCOPE_WORKGROUP); }
__device__ __forceinline__ float wave_sum(float v) {
#pragma unroll
    for (int o = 1; o < 64; o <<= 1) v += __shfl_xor(v, o);
    return v;
}
__device__ __forceinline__ float wave_max(float v) {
#pragma unroll
    for (int o = 1; o < 64; o <<= 1) v = fmaxf(v, __shfl_xor(v, o));
    return v;
}

#define XB_TMO      128
#define XB_XCNT(j)  (256  + 64 * (j))
#define XB_XSUB(j)  (1280 + 64 * (j))
#define XB_XGEN(j)  (2304 + 64 * (j))
#define XB_TOP      3328
#define XB_TOPGEN   3392
#define XCD_BAR_WORDS 3456
#define XB_SPIN_CAP (1u << 18)
__device__ __forceinline__ unsigned xb_ld(unsigned* p)              { return __hip_atomic_load(p, __ATOMIC_RELAXED, __HIP_MEMORY_SCOPE_AGENT); }
__device__ __forceinline__ unsigned xb_add(unsigned* p, unsigned v) { return __hip_atomic_fetch_add(p, v, __ATOMIC_RELAXED, __HIP_MEMORY_SCOPE_AGENT); }
__device__ __forceinline__ unsigned xb_xcc_id() { return (unsigned)__builtin_amdgcn_s_getreg((3 << 11) | 20) & 0xFu; }
#define XB_SPIN(cond, bar) do { unsigned _sp = 0; while (cond) { __builtin_amdgcn_s_sleep(1); \
    if ((++_sp & 255u) == 0u) { if (xb_ld(&(bar)[XB_TMO])) break; if (_sp > XB_SPIN_CAP) { atomicAdd(&(bar)[XB_TMO], 1u); break; } } } } while (0)
struct XcdBarrier { unsigned* bar; unsigned x; volatile LAS unsigned* st; };
__device__ __forceinline__ XcdBarrier xcd_barrier_post(unsigned* bar, volatile LAS unsigned* st, int tid0) {
    XcdBarrier b; b.bar = bar; b.x = xb_xcc_id(); b.st = st;
    if (tid0 == 0) (void)xb_add(&bar[XB_XCNT(b.x)], 1u);
    return b;
}
__device__ __forceinline__ void xcd_barrier_complete(unsigned* bar, unsigned x, unsigned& nloc, unsigned& nx) {
    const unsigned G = gridDim.x * gridDim.y * gridDim.z;
    unsigned sum, cnt, mine, sp = 0u;
    for (;;) {
        sum = 0u; cnt = 0u; mine = 0u;
#pragma unroll
        for (unsigned j = 0; j < 16; ++j) { const unsigned c = xb_ld(&bar[XB_XCNT(j)]); sum += c; cnt += (c > 0u) ? 1u : 0u; mine = (j == x) ? c : mine; }
        if (sum == G) break;
        __builtin_amdgcn_s_sleep(1);
        if ((++sp & 255u) == 0u) { if (xb_ld(&bar[XB_TMO])) break; if (sp > XB_SPIN_CAP) { atomicAdd(&bar[XB_TMO], 1u); break; } }
    }
    nloc = mine > 0u ? mine : 1u; nx = cnt > 0u ? cnt : 1u;
}
__device__ __forceinline__ void xcd_barrier(const XcdBarrier& b, int tid0) {
    asm volatile("s_waitcnt vmcnt(0)" ::: "memory");
    __syncthreads();
    if (tid0 == 0) {
        unsigned* bar = b.bar;
        __builtin_amdgcn_s_waitcnt(0);
        unsigned nloc = b.st[0], nx = b.st[1];
        if (nloc == 0u) { xcd_barrier_complete(bar, b.x, nloc, nx); b.st[0] = nloc; b.st[1] = nx; }
        const unsigned old = xb_add(&bar[XB_XSUB(b.x)], 1u);
        const unsigned gen = old / nloc;
        if (old + 1u == (gen + 1u) * nloc) {
            __builtin_amdgcn_fence(__ATOMIC_RELEASE, "agent");
            asm volatile("s_waitcnt vmcnt(0)" ::: "memory");
            const unsigned og = xb_add(&bar[XB_TOP], 1u);
            const unsigned tg = og / nx;
            if (og + 1u == (tg + 1u) * nx) xb_add(&bar[XB_TOPGEN], 1u);
            else XB_SPIN(xb_ld(&bar[XB_TOPGEN]) == tg, bar);
            __builtin_amdgcn_fence(__ATOMIC_ACQUIRE, "agent");
            xb_add(&bar[XB_XGEN(b.x)], 1u);
            asm volatile("s_waitcnt vmcnt(0)" ::: "memory");
        } else {
            XB_SPIN(xb_ld(&bar[XB_XGEN(b.x)]) == gen, bar);
            __builtin_amdgcn_fence(__ATOMIC_ACQUIRE, "agent");
            asm volatile("s_waitcnt vmcnt(0)" ::: "memory");
        }
    }
    __syncthreads();
}

struct Frame {
    LAS unsigned char* lds;
    int tid, lane, wave, G, vcu;
    unsigned char* ws;
    const float* in[25];
    float* out;
};
enum { I_X = 0, I_MEM, I_NMIXW, I_WIN, I_CONVW, I_CONVB, I_IFB, I_MHNW, I_WBM, I_WBA, I_REL, I_WOUT, I_NXW, I_NMEMW, I_WQ, I_WKV, I_WO, I_NFFNW,
       I_WR, I_BR, I_WGU, I_BGU, I_WDN, I_BDN, I_FNW };

__device__ __forceinline__ int fresh_lane() { int l = (int)__builtin_amdgcn_mbcnt_hi(~0u, __builtin_amdgcn_mbcnt_lo(~0u, 0u)); asm volatile("" : "+v"(l)); return l; }
__device__ __forceinline__ void frame_ids(Frame& F) {
    const int l = fresh_lane(); F.lane = l; F.tid = F.wave * 64 + l;
}

__device__ __forceinline__ void transpose_item(const float* W, int ldw, int src_col0, int k0, bf16* WT, int K, int dest_row0, LAS float* scr, int lane) {
    float rv[32];
#pragma unroll
    for (int i = 0; i < 32; ++i) { const int kk = 2 * i + (lane >> 5); rv[i] = W[(size_t)(k0 + kk) * ldw + src_col0 + (lane & 31)]; }
#pragma unroll
    for (int i = 0; i < 32; ++i) { const int kk = 2 * i + (lane >> 5); scr[kk * 33 + (lane & 31)] = rv[i]; }
    LDS_WAIT(); asm volatile("" ::: "memory");
    const int c = lane & 7;
#pragma unroll
    for (int j = 0; j < 4; ++j) { const int n = (lane >> 3) + 8 * j; const LAS float* s = scr + (8 * c) * 33 + n;
        v4u o; o.x = pk2(s[0 * 33], s[1 * 33]); o.y = pk2(s[2 * 33], s[3 * 33]); o.z = pk2(s[4 * 33], s[5 * 33]); o.w = pk2(s[6 * 33], s[7 * 33]);
        *(GAS v4u*)(WT + (size_t)(dest_row0 + n) * K + k0 + 8 * c) = o; }
    LDS_WAIT(); asm volatile("" ::: "memory");
}
struct Fp8Job { const float* src; unsigned char* dst; int ldw, K; };
__device__ __forceinline__ Fp8Job fp8_job(const Frame& F, int r) {
    constexpr int I_GU1 = 32 * 128, I_DN1 = 32 * 64;
    Fp8Job j;
    if (r < NE * I_GU1) { const int e = r / I_GU1, q = r % I_GU1, kb = q / 128, sb = q % 128;
        const int sc0 = 32 * sb, bj = sc0 / DFF, cc = sc0 % DFF, dest = (cc / 128) * 256 + bj * 128 + (cc % 128);
        j.src = F.in[I_WGU] + (size_t)e * D * (2 * DFF) + (size_t)(64 * kb) * (2 * DFF) + sc0; j.ldw = 2 * DFF;
        j.dst = (unsigned char*)(F.ws + WS_WGU) + (size_t)e * (2 * DFF) * D + (size_t)dest * D + 64 * kb; j.K = D; }
    else { r -= NE * I_GU1; const int e = r / I_DN1, q = r % I_DN1, kb = q / 64, nb = q % 64;
        j.src = F.in[I_WDN] + (size_t)e * DFF * D + (size_t)(64 * kb) * D + 32 * nb; j.ldw = D;
        j.dst = (unsigned char*)(F.ws + WS_WDN) + (size_t)e * D * DFF + (size_t)(32 * nb) * DFF + 64 * kb; j.K = DFF; }
    return j;
}
__device__ __forceinline__ void fp8_item_load(const Fp8Job& j, f32x4 (&rv)[8], int lane) {
    const float* p = j.src + (size_t)(lane >> 3) * j.ldw + 4 * (lane & 7);
#pragma unroll
    for (int i = 0; i < 8; ++i) rv[i] = *(const GAS f32x4*)(p + (size_t)(8 * i) * j.ldw);
}
__device__ __forceinline__ void fp8_item_store(const Fp8Job& j, const f32x4 (&rv)[8], LAS float* scr, int lane) {
#pragma unroll
    for (int i = 0; i < 8; ++i) { LAS float* d = scr + (8 * i + (lane >> 3)) * 33 + 4 * (lane & 7); d[0] = rv[i].x; d[1] = rv[i].y; d[2] = rv[i].z; d[3] = rv[i].w; }
    LDS_WAIT(); asm volatile("" ::: "memory");
    const int c = lane >> 4;
#pragma unroll
    for (int jn = 0; jn < 2; ++jn) { const int n = (lane & 15) + 16 * jn; const LAS float* s = scr + (16 * c) * 33 + n;
        v4u o; o.x = pg8::pk_fp8x4(s[0 * 33] * WSCALE, s[1 * 33] * WSCALE, s[2 * 33] * WSCALE, s[3 * 33] * WSCALE); o.y = pg8::pk_fp8x4(s[4 * 33] * WSCALE, s[5 * 33] * WSCALE, s[6 * 33] * WSCALE, s[7 * 33] * WSCALE);
        o.z = pg8::pk_fp8x4(s[8 * 33] * WSCALE, s[9 * 33] * WSCALE, s[10 * 33] * WSCALE, s[11 * 33] * WSCALE); o.w = pg8::pk_fp8x4(s[12 * 33] * WSCALE, s[13 * 33] * WSCALE, s[14 * 33] * WSCALE, s[15 * 33] * WSCALE);
        *(GAS v4u*)(j.dst + (size_t)n * j.K + 16 * c) = o; }
    LDS_WAIT(); asm volatile("" ::: "memory");
}
__device__ __forceinline__ void tr_dense(const float* W, int K, int N, bf16* WT, LAS float* scr, int item, int lane) {
    const int nblk = N / 32, kb = item / nblk, nb = item % nblk;
    transpose_item(W, N, 32 * nb, 64 * kb, WT, K, 32 * nb, scr, lane);
}
__device__ __forceinline__ void rms_row_to_bf16(const float* xrow, const float* w, bf16* orow, int lane) {
    const GAS f32x4* xr = (const GAS f32x4*)xrow + lane;
    f32x4 v[8]; float s = 0.f;
#pragma unroll
    for (int j = 0; j < 8; ++j) { v[j] = xr[64 * j]; s += (v[j].x * v[j].x + v[j].y * v[j].y) + (v[j].z * v[j].z + v[j].w * v[j].w); }
    const float rstd = 1.f / sqrtf(wave_sum(s) * (1.f / D) + EPS);
    const GAS f32x4* wr = (const GAS f32x4*)w + lane;
    GAS v2u* o8 = (GAS v2u*)orow + lane;
#pragma unroll
    for (int j = 0; j < 8; ++j) { const f32x4 ww = wr[64 * j]; v2u o; o.x = pk2(v[j].x * rstd * ww.x, v[j].y * rstd * ww.y); o.y = pk2(v[j].z * rstd * ww.z, v[j].w * rstd * ww.w); o8[64 * j] = o; }
}

struct TJob { const float* src; unsigned char* dst; const float* kscale; int ldw, Kd, rowmap, fp8; };
constexpr int T_IN = 16 * 44, T_BM = 8 * 8, T_BA = 8 * 8, T_OUT = 16 * 8, T_Q = 16 * 2, T_KV = 16 * 4, T_O = 4 * 8, T_GU = 16 * 16, T_DN = 16 * 8;
constexpr int NT_SMALL = T_IN + T_BM + T_BA + T_OUT + T_Q + T_KV + T_O, NTILES = NT_SMALL + NE * (T_GU + T_DN);
constexpr int NT_GU = 512;
constexpr int LATE_WG = 120, NT_LATE = LATE_WG * 8;
__device__ __forceinline__ TJob tile_job(const Frame& F, int r) {
    TJob j; j.rowmap = 0; j.fp8 = 0; j.kscale = nullptr;
#define TJ_DENSE(W_, Kk, Nn, DST_) { const int nbn = (Nn) / 256, kb = r / nbn, nb = r % nbn; j.src = (W_) + (size_t)(128 * kb) * (Nn) + 256 * nb; j.ldw = (Nn); \
        j.dst = (unsigned char*)(F.ws + (DST_)) + ((size_t)(256 * nb) * (Kk) + 128 * kb) * 2; j.Kd = (Kk); return j; }
    if (r < T_IN) { const int kb = r / 44, nb = r % 44, n0 = 256 * nb; j.src = F.in[I_WIN] + (size_t)(128 * kb) * IN_COLS + n0 + (n0 >= 4096 ? 8 : 0); j.ldw = IN_COLS; j.Kd = D;
        if (nb >= 8) { const int t8 = nb - 8; j.fp8 = 1; j.dst = (unsigned char*)(F.ws + WS_WIN8) + (size_t)(256 * t8) * D + 128 * kb; }
        else j.dst = (unsigned char*)(F.ws + WS_WIN) + ((size_t)n0 * D + 128 * kb) * 2;
        return j; } r -= T_IN;
    if (r < T_BM) { const int kb = r / 8, nb = r % 8; j.src = F.in[I_WBM] + (size_t)(128 * kb) * D + 256 * nb; j.ldw = D; j.dst = (unsigned char*)(F.ws + WS_WBM) + ((size_t)(256 * nb) * 2048 + 128 * kb) * 2; j.Kd = 2048; return j; } r -= T_BM;
    if (r < T_BA) { const int kb = r / 8, nb = r % 8; j.src = F.in[I_WBA] + (size_t)(128 * kb) * D + 256 * nb; j.ldw = D; j.dst = (unsigned char*)(F.ws + WS_WBM) + ((size_t)(256 * nb) * 2048 + 1024 + 128 * kb) * 2; j.Kd = 2048; return j; } r -= T_BA;
    if (r < T_OUT) TJ_DENSE(F.in[I_WOUT], D, D, WS_WOUT) r -= T_OUT;
    if (r < T_Q) { const int kb = r / 2, nb = r % 2; j.src = F.in[I_WQ] + (size_t)(128 * kb) * XW + 256 * nb; j.ldw = XW; j.dst = (unsigned char*)(F.ws + WS_WQ) + ((size_t)(256 * nb) * D + 128 * kb) * 2; j.Kd = D; j.kscale = F.in[I_NXW] + 128 * kb; return j; } r -= T_Q;
    if (r < T_KV) TJ_DENSE(F.in[I_WKV], D, 2 * XW, WS_WKV) r -= T_KV;
    if (r < T_O) TJ_DENSE(F.in[I_WO], XW, D, WS_WO) r -= T_O;
#undef TJ_DENSE
    j.fp8 = 1;
    if (r < NE * T_GU) { const int e = r / T_GU, q = r % T_GU, kb = q / 16, nb = q % 16; j.src = F.in[I_WGU] + (size_t)e * D * (2 * DFF) + (size_t)(128 * kb) * (2 * DFF) + 256 * nb; j.ldw = 2 * DFF;
        j.dst = (unsigned char*)(F.ws + WS_WGU) + (size_t)e * (2 * DFF) * D + 128 * kb; j.Kd = D; j.rowmap = 1 + 256 * nb; return j; }
    r -= NE * T_GU;
    { const int e = r / T_DN, q = r % T_DN, kb = q / 8, nb = q % 8; j.src = F.in[I_WDN] + (size_t)e * DFF * D + (size_t)(128 * kb) * D + 256 * nb; j.ldw = D;
        j.dst = (unsigned char*)(F.ws + WS_WDN) + (size_t)e * D * DFF + (size_t)(256 * nb) * DFF + 128 * kb; j.Kd = DFF; return j; }
}
__device__ __forceinline__ void tile_load(const TJob& j, f32x4 (&rv)[16], int tid) {
    const float* p = j.src + (size_t)(tid >> 6) * j.ldw + 4 * (tid & 63);
#pragma unroll
    for (int i = 0; i < 16; ++i) rv[i] = __builtin_nontemporal_load((const GAS f32x4*)(p + (size_t)(8 * i) * j.ldw));
}

__device__ __forceinline__ void weight_tiles(Frame& F, int t0, int t1, int wi, int nw, const bool rev = false) {
#define WT_IDX(x) (rev ? (t0 + t1 - 1 - (x)) : (x))
        LAS float* tile = (LAS float*)(F.lds + RING_OFF);
        f32x4 rv[16], rn[16];
        int tt = t0 + wi;
        if (tt < t1) { const TJob j = tile_job(F, WT_IDX(tt)); tile_load(j, rv, F.tid); }
        for (; tt < t1; tt += nw) {
#pragma unroll
            for (int i = 0; i < 16; ++i) { const int k = (F.tid >> 6) + 8 * i, n4 = 4 * (F.tid & 63); *(LAS f32x4*)(tile + k * 256 + (n4 ^ (((k >> 4) & 7) << 2))) = rv[i]; }
            { const TJob jc = tile_job(F, WT_IDX(tt));
              if (jc.kscale) {
                  __syncthreads();
#pragma unroll
                  for (int i = 0; i < 16; ++i) { const int k = (F.tid >> 6) + 8 * i, n4 = 4 * (F.tid & 63); LAS f32x4* p = (LAS f32x4*)(tile + k * 256 + (n4 ^ (((k >> 4) & 7) << 2))); *p = *p * jc.kscale[k]; } } }
            __syncthreads();
            const bool more = tt + nw < t1;
            if (more) { const TJob jn = tile_job(F, WT_IDX(tt + nw)); tile_load(jn, rn, F.tid); }
            const TJob j = tile_job(F, WT_IDX(tt));
#pragma unroll
            for (int i = 0; i < 4; ++i) { const int p = F.tid + NTHR * i, c = p & 7, n = p >> 3;
                const LAS float* s = tile + (16 * c) * 256 + (n ^ (c << 2));
                size_t drow;
                if (j.rowmap) { const int sc = (j.rowmap - 1) + n, bj = sc / DFF, cc = sc % DFF; drow = (size_t)((cc / 128) * 256 + bj * 128 + (cc % 128)); } else drow = (size_t)n;
                if (j.fp8) {
                    v4u o; o.x = pg8::pk_fp8x4(s[0 * 256] * WSCALE, s[1 * 256] * WSCALE, s[2 * 256] * WSCALE, s[3 * 256] * WSCALE); o.y = pg8::pk_fp8x4(s[4 * 256] * WSCALE, s[5 * 256] * WSCALE, s[6 * 256] * WSCALE, s[7 * 256] * WSCALE);
                    o.z = pg8::pk_fp8x4(s[8 * 256] * WSCALE, s[9 * 256] * WSCALE, s[10 * 256] * WSCALE, s[11 * 256] * WSCALE); o.w = pg8::pk_fp8x4(s[12 * 256] * WSCALE, s[13 * 256] * WSCALE, s[14 * 256] * WSCALE, s[15 * 256] * WSCALE);
                    *(GAS v4u*)(j.dst + drow * j.Kd + 16 * c) = o;
                } else {
                    v4u o0, o1; o0.x = pk2(s[0 * 256], s[1 * 256]); o0.y = pk2(s[2 * 256], s[3 * 256]); o0.z = pk2(s[4 * 256], s[5 * 256]); o0.w = pk2(s[6 * 256], s[7 * 256]);
                    o1.x = pk2(s[8 * 256], s[9 * 256]); o1.y = pk2(s[10 * 256], s[11 * 256]); o1.z = pk2(s[12 * 256], s[13 * 256]); o1.w = pk2(s[14 * 256], s[15 * 256]);
                    GAS v4u* o = (GAS v4u*)(j.dst + (drow * j.Kd + 16 * c) * 2); o[0] = o0; o[1] = o1;
                } }
            __syncthreads();
            if (more) {
#pragma unroll
                for (int i = 0; i < 16; ++i) rv[i] = rn[i]; }
        }
#undef WT_IDX
}

__device__ __forceinline__ void p0_prologue(Frame& F) {
    frame_ids(F);
    const int gw = F.vcu * NWAVES + F.wave, NGW = F.G * NWAVES;
    bf16* WIN = (bf16*)(F.ws + WS_WIN);
    {
        LAS float* scr = (LAS float*)(F.lds + RING_OFF + F.wave * 16384);
        for (int it = gw; it < 32; it += NGW) tr_dense(F.in[I_WR], D, NE, (bf16*)(F.ws + WS_WR), scr, it, F.lane);
        __syncthreads();
        weight_tiles(F, 0, NTILES - NT_LATE - NT_GU, F.vcu, F.G, true);
    }
    __syncthreads();
    {
        LAS float* wg = (LAS float*)(F.lds + RING_OFF);
        for (int i = F.tid; i < 8 * D; i += NTHR) { const int k = i >> 3, g = i & 7; wg[g * D + k] = F.in[I_WIN][(size_t)k * IN_COLS + 4096 + g]; }
        __syncthreads();
        bf16* H = (bf16*)(F.ws + WS_H); float* IFG = (float*)(F.ws + WS_IFG);
        const float* nw = F.in[I_NMIXW];
        for (int m = gw; m < T; m += NGW) {
            const GAS f32x4* xr = (const GAS f32x4*)(F.in[I_X] + (size_t)m * D) + F.lane;
            f32x4 v[8]; float s = 0.f;
#pragma unroll
            for (int j = 0; j < 8; ++j) { v[j] = __builtin_nontemporal_load(xr + 64 * j); s += (v[j].x * v[j].x + v[j].y * v[j].y) + (v[j].z * v[j].z + v[j].w * v[j].w); }
            const float rstd = 1.f / sqrtf(wave_sum(s) * (1.f / D) + EPS);
            const GAS f32x4* wr = (const GAS f32x4*)nw + F.lane;
            GAS v2u* o8 = (GAS v2u*)(H + (size_t)m * D) + F.lane; GAS unsigned* h8 = (GAS unsigned*)((unsigned char*)(F.ws + WS_H8) + (size_t)m * D) + F.lane;
#pragma unroll
            for (int j = 0; j < 8; ++j) { const f32x4 ww = wr[64 * j]; v[j].x *= rstd * ww.x; v[j].y *= rstd * ww.y; v[j].z *= rstd * ww.z; v[j].w *= rstd * ww.w;
                v2u o; o.x = pk2(v[j].x, v[j].y); o.y = pk2(v[j].z, v[j].w); o8[64 * j] = o;
                h8[64 * j] = pg8::pk_fp8x4(v[j].x * HSCALE, v[j].y * HSCALE, v[j].z * HSCALE, v[j].w * HSCALE); }
            float ga8[8];
#pragma unroll
            for (int g = 0; g < 8; ++g) ga8[g] = 0.f;
#pragma unroll 2
            for (int j = 0; j < 8; ++j)
#pragma unroll
                for (int g = 0; g < 8; ++g) { const f32x4 ww = *(const LAS f32x4*)(wg + g * D + 256 * j + 4 * F.lane); ga8[g] += (v[j].x * ww.x + v[j].y * ww.y) + (v[j].z * ww.z + v[j].w * ww.w); }
            { const bool h5 = (F.lane & 32) != 0, h4 = (F.lane & 16) != 0, h3 = (F.lane & 8) != 0; float b4[4], c2[2], d1;
#pragma unroll
              for (int i = 0; i < 4; ++i) { const float snd = h5 ? ga8[i] : ga8[i + 4], kp = h5 ? ga8[i + 4] : ga8[i]; b4[i] = kp + __shfl_xor(snd, 32); }
#pragma unroll
              for (int i = 0; i < 2; ++i) { const float snd = h4 ? b4[i] : b4[i + 2], kp = h4 ? b4[i + 2] : b4[i]; c2[i] = kp + __shfl_xor(snd, 16); }
              { const float snd = h3 ? c2[0] : c2[1], kp = h3 ? c2[1] : c2[0]; d1 = kp + __shfl_xor(snd, 8); }
              d1 += __shfl_xor(d1, 4); d1 += __shfl_xor(d1, 2); d1 += __shfl_xor(d1, 1);
              if ((F.lane & 7) == 0) { const int g = F.lane >> 3; IFG[(size_t)m * 8 + g] = d1 + F.in[I_IFB][g]; } }
        }
        bf16* MEMN = (bf16*)(F.ws + WS_MEMN);
        for (int m = gw; m < BATCH * NMEM; m += NGW) rms_row_to_bf16(F.in[I_MEM] + (size_t)m * D, F.in[I_NMEMW], MEMN + (size_t)m * D, F.lane);
        __syncthreads();
    }

}

__device__ __forceinline__ void p_conv(Frame& F) {
    frame_ids(F);
    const bf16* PROJ = (const bf16*)(F.ws + WS_PROJ); bf16* QKC = (bf16*)(F.ws + WS_QKC);
    const float* cw = F.in[I_CONVW]; const float* cb = F.in[I_CONVB];
    const int gt = F.vcu * NTHR + F.tid, NGT = F.G * NTHR;
    for (int q = gt; q < 256 * (T / 32); q += NGT) {
        const int c0 = (q & 255) * 8, t0 = (q >> 8) * 32, s0 = t0 & (SEQ - 1);
        float wgt[4][8], bias[8];
#pragma unroll
        for (int j = 0; j < 4; ++j) { const f32x4 w0 = *(const GAS f32x4*)(cw + j * 2048 + c0), w1 = *(const GAS f32x4*)(cw + j * 2048 + c0 + 4);
            wgt[j][0] = w0.x; wgt[j][1] = w0.y; wgt[j][2] = w0.z; wgt[j][3] = w0.w; wgt[j][4] = w1.x; wgt[j][5] = w1.y; wgt[j][6] = w1.z; wgt[j][7] = w1.w; }
        { const f32x4 b0 = *(const GAS f32x4*)(cb + c0), b1 = *(const GAS f32x4*)(cb + c0 + 4); bias[0] = b0.x; bias[1] = b0.y; bias[2] = b0.z; bias[3] = b0.w; bias[4] = b1.x; bias[5] = b1.y; bias[6] = b1.z; bias[7] = b1.w; }
        const float sc = (c0 >= 1024) ? 0.0625f : 1.f;
        const bf16* src = PROJ + (size_t)t0 * NPROJ + c0;
        v4u h0 = (v4u){0u, 0u, 0u, 0u}, h1 = h0, h2 = h0;
        if (s0 > 0) { h0 = *(const GAS v4u*)(src - 3 * (size_t)NPROJ); h1 = *(const GAS v4u*)(src - 2 * (size_t)NPROJ); h2 = *(const GAS v4u*)(src - (size_t)NPROJ); }
        for (int i0 = 0; i0 < 32; i0 += 8) {
            v4u rw[8];
#pragma unroll
            for (int i = 0; i < 8; ++i) rw[i] = *(const GAS v4u*)(src + (size_t)(i0 + i) * NPROJ);
#pragma unroll
            for (int i = 0; i < 8; ++i) { const v4u h3 = rw[i]; float a[8];
#pragma unroll
                for (int e = 0; e < 4; ++e) { const unsigned u0 = h0[e], u1 = h1[e], u2 = h2[e], u3 = h3[e];
                    a[2 * e] = bias[2 * e] + bflo(u0) * wgt[0][2 * e] + bflo(u1) * wgt[1][2 * e] + bflo(u2) * wgt[2][2 * e] + bflo(u3) * wgt[3][2 * e];
                    a[2 * e + 1] = bias[2 * e + 1] + bfhi(u0) * wgt[0][2 * e + 1] + bfhi(u1) * wgt[1][2 * e + 1] + bfhi(u2) * wgt[2][2 * e + 1] + bfhi(u3) * wgt[3][2 * e + 1]; }
#pragma unroll
                for (int e = 0; e < 8; ++e) a[e] = a[e] * sigm(a[e]) * sc;
                v4u o; o.x = pk2(a[0], a[1]); o.y = pk2(a[2], a[3]); o.z = pk2(a[4], a[5]); o.w = pk2(a[6], a[7]);
                *(GAS v4u*)(QKC + (size_t)(t0 + i0 + i) * 2048 + c0) = o;
                h0 = h1; h1 = h2; h2 = h3; }
        }
    }
}

constexpr int TP = 72;
__device__ __forceinline__ int tp_col(int c8, int s) { return c8 * TP + ((((s >> 3) ^ ((c8 >> 3) & 7)) << 3) | (s & 7)); }
__device__ __forceinline__ int tp_chunk(int r, int chunk) { return r * TP + ((chunk ^ ((r >> 3) & 7)) << 3); }
__device__ __forceinline__ void p_mlstm_local(Frame& F) {
    frame_ids(F);
    const bf16* PROJ = (const bf16*)(F.ws + WS_PROJ); const bf16* QKC = (const bf16*)(F.ws + WS_QKC); const float* IFG = (const float*)(F.ws + WS_IFG);
    float* BCUM = (float*)(F.ws + WS_BCUM); bf16* CLOC = (bf16*)(F.ws + WS_CLOC); float* NLOC = (float*)(F.ws + WS_NLOC);
    float* CHA = (float*)(F.ws + WS_CHS); float* CHG = CHA + 1024;
    LAS bf16* Kt = (LAS bf16*)(F.lds + RING_OFF);
    LAS bf16* Vt = Kt + 256 * TP;
    LAS float* es = (LAS float*)(Vt + 256 * TP);
    const int lane = F.lane, w = F.wave, hh = lane >> 5, l31 = lane & 31;
    v4u rk[4], rv[4]; float ipn = 0.f, fpn = 0.f;
#define ML_LOAD(uu) do { const int bh_ = (uu) >> 7, c_ = (uu) & 127, b_ = bh_ >> 2, h_ = bh_ & 3, t0_ = b_ * SEQ + c_ * CHUNK; \
        _Pragma("unroll") for (int i = 0; i < 4; ++i) { const int p = F.tid + NTHR * i, s = p >> 5, c8 = (p & 31) * 8; \
            rk[i] = *(const GAS v4u*)(QKC + (size_t)(t0_ + s) * 2048 + 1024 + h_ * 256 + c8); rv[i] = *(const GAS v4u*)(PROJ + (size_t)(t0_ + s) * NPROJ + PV_M + h_ * 256 + c8); } \
        if (w == 0) { ipn = IFG[(size_t)(t0_ + lane) * 8 + h_]; fpn = IFG[(size_t)(t0_ + lane) * 8 + 4 + h_]; } } while (0)
    if (F.vcu < 1024) ML_LOAD(F.vcu);
    for (int u = F.vcu; u < 1024; u += F.G) {
        const int bh = u >> 7, c = u & 127, b = bh >> 2, h = bh & 3, t0 = b * SEQ + c * CHUNK;
        if (w == 0) {
            const float ip = ipn, fp = fpn;
            const float lf = fminf(fp, 0.f) - log1pf(__expf(-fabsf(fp)));
            float bc = lf;
#pragma unroll
            for (int o = 1; o < 64; o <<= 1) { const float y = __shfl_up(bc, o); if (lane >= o) bc += y; }
            const float g = __shfl(bc, 63), we = g - bc + ip, a = wave_max(we);
            es[lane] = __expf(we - a);
            BCUM[(size_t)(t0 + lane) * 4 + h] = bc;
            if (lane == 0) { CHA[u] = a; CHG[u] = g; }
        }
        __syncthreads();
#pragma unroll
        for (int i = 0; i < 4; ++i) { const int p = F.tid + NTHR * i, s = p >> 5, c8 = (p & 31) * 8;
            const v4u kv = rk[i], vv = rv[i];
            const float e = es[s];
            LAS bf16* kd = Kt + tp_col(c8, s); LAS bf16* vd = Vt + tp_col(c8, s);
            kd[0 * TP] = (bf16)(kv.x & 0xffff); kd[1 * TP] = (bf16)(kv.x >> 16); kd[2 * TP] = (bf16)(kv.y & 0xffff); kd[3 * TP] = (bf16)(kv.y >> 16);
            kd[4 * TP] = (bf16)(kv.z & 0xffff); kd[5 * TP] = (bf16)(kv.z >> 16); kd[6 * TP] = (bf16)(kv.w & 0xffff); kd[7 * TP] = (bf16)(kv.w >> 16);
            vd[0 * TP] = f2bf(bflo(vv.x) * e); vd[1 * TP] = f2bf(bfhi(vv.x) * e); vd[2 * TP] = f2bf(bflo(vv.y) * e); vd[3 * TP] = f2bf(bfhi(vv.y) * e);
            vd[4 * TP] = f2bf(bflo(vv.z) * e); vd[5 * TP] = f2bf(bfhi(vv.z) * e); vd[6 * TP] = f2bf(bflo(vv.w) * e); vd[7 * TP] = f2bf(bfhi(vv.w) * e); }
        __syncthreads();
        if (u + F.G < 1024) ML_LOAD(u + F.G);
        bf16x8 af[4];
#pragma unroll
        for (int ks = 0; ks < 4; ++ks) af[ks] = *(const LAS bf16x8*)(Kt + tp_chunk(32 * w + l31, 2 * ks + hh));
        bf16* Cu = CLOC + (size_t)u * 65536;
#pragma unroll 2
        for (int ni = 0; ni < 8; ++ni) {
            f32x16 acc = {0.f, 0.f, 0.f, 0.f, 0.f, 0.f, 0.f, 0.f, 0.f, 0.f, 0.f, 0.f, 0.f, 0.f, 0.f, 0.f};
#pragma unroll
            for (int ks = 0; ks < 4; ++ks) { const bf16x8 bfr = *(const LAS bf16x8*)(Vt + tp_chunk(32 * ni + l31, 2 * ks + hh)); acc = mfma32(af[ks], bfr, acc); }
            const int v = 32 * ni + l31;
#pragma unroll
            for (int rg = 0; rg < 4; ++rg) { v2u o; o.x = pk2(acc[4 * rg], acc[4 * rg + 1]); o.y = pk2(acc[4 * rg + 2], acc[4 * rg + 3]);
                *(GAS v2u*)(Cu + (size_t)w * 8192 + v * 32 + 8 * rg + 4 * hh) = o; }
        }
        if (F.tid < 256) { float a = 0.f;
#pragma unroll
            for (int cch = 0; cch < 8; ++cch) { const v4u kq = *(const LAS v4u*)(Kt + tp_chunk(F.tid, cch)); const LAS float* e8 = es + 8 * cch;
                a += e8[0] * bflo(kq.x); a += e8[1] * bfhi(kq.x); a += e8[2] * bflo(kq.y); a += e8[3] * bfhi(kq.y); a += e8[4] * bflo(kq.z); a += e8[5] * bfhi(kq.z); a += e8[6] * bflo(kq.w); a += e8[7] * bfhi(kq.w); }
            NLOC[(size_t)u * 256 + F.tid] = a; }
        __syncthreads();
    }
#undef ML_LOAD
}

__device__ __forceinline__ void p_mlstm_scan(Frame& F) {
    frame_ids(F);
    const bf16* CLOC = (const bf16*)(F.ws + WS_CLOC); bf16* CIN = (bf16*)(F.ws + WS_CIN);
    const float* NLOC = (const float*)(F.ws + WS_NLOC); float* NIN = (float*)(F.ws + WS_NIN);
    const float* CHA = (const float*)(F.ws + WS_CHS); const float* CHG = CHA + 1024; float* CHM = (float*)(F.ws + WS_CHS) + 2048;
    const int gt = F.vcu * NTHR + F.tid, NGT = F.G * NTHR;
    if (F.tid < 8) { for (int q = F.vcu * 8 + F.tid; q < 8 * 256; q += F.G * 8) {
        const int bh = q >> 8, k = q & 255; float m = 0.f, n = 0.f;
        for (int c0 = 0; c0 < NCH; c0 += 32) { float nl[32], aa[32], gg[32];
#pragma unroll
            for (int i = 0; i < 32; ++i) { const int u = bh * NCH + c0 + i; nl[i] = NLOC[(size_t)u * 256 + k]; aa[i] = CHA[u]; gg[i] = CHG[u]; }
#pragma unroll
            for (int i = 0; i < 32; ++i) { const int u = bh * NCH + c0 + i;
                const float mn = fmaxf(gg[i] + m, aa[i]), sp = __expf(gg[i] + m - mn), sl = __expf(aa[i] - mn);
                NIN[(size_t)u * 256 + k] = n; n = sp * n + sl * nl[i]; m = mn; } } } }
    for (int q = gt; q < 8 * 16384; q += NGT) {
        const int bh = q >> 14; const size_t off = (size_t)(q & 16383) * 4;
        float m = 0.f, C0 = 0.f, C1 = 0.f, C2 = 0.f, C3 = 0.f;
        for (int c0 = 0; c0 < NCH; c0 += 16) {
            v2u cl[16]; float aa[16], gg[16];
#pragma unroll
            for (int i = 0; i < 16; ++i) { const int u = bh * NCH + c0 + i; cl[i] = *(const GAS v2u*)(CLOC + (size_t)u * 65536 + off); aa[i] = CHA[u]; gg[i] = CHG[u]; }
#pragma unroll
            for (int i = 0; i < 16; ++i) { const int u = bh * NCH + c0 + i;
                const float mn = fmaxf(gg[i] + m, aa[i]), sp = __expf(gg[i] + m - mn), sl = __expf(aa[i] - mn);
                v2u o; o.x = pk2(C0, C1); o.y = pk2(C2, C3);
                *(GAS v2u*)(CIN + (size_t)u * 65536 + off) = o;
                if (off == 0) CHM[u] = m;
                C0 = sp * C0 + sl * bflo(cl[i].x); C1 = sp * C1 + sl * bfhi(cl[i].x); C2 = sp * C2 + sl * bflo(cl[i].y); C3 = sp * C3 + sl * bfhi(cl[i].y);
                m = mn; }
        }
    }
}

constexpr int QP = 264;
__device__ __forceinline__ void p_mlstm_out(Frame& F) {
    frame_ids(F);
    const bf16* PROJ = (const bf16*)(F.ws + WS_PROJ); const bf16* QKC = (const bf16*)(F.ws + WS_QKC); const float* IFG = (const float*)(F.ws + WS_IFG);
    const float* BCUM = (const float*)(F.ws + WS_BCUM); const bf16* CIN = (const bf16*)(F.ws + WS_CIN); const float* NIN = (const float*)(F.ws + WS_NIN);
    const float* CHM = (const float*)(F.ws + WS_CHS) + 2048; bf16* HM = (bf16*)(F.ws + WS_HM); const float* hnw = F.in[I_MHNW];
    LAS bf16* Qs = (LAS bf16*)(F.lds + RING_OFF);
    LAS bf16* Ks = Qs + 64 * QP;
    LAS bf16* Vt = Ks + 64 * QP;
    LAS bf16* Sm = Vt + 256 * TP;
    LAS float* fb = (LAS float*)(Sm + 64 * TP);
    LAS float* fi = fb + 64; LAS float* fmj = fb + 128; LAS float* fwi = fb + 192; LAS float* dpart = fb + 256; LAS float* dint = fb + 384; LAS float* hpart = fb + 448;
    const int lane = F.lane, w = F.wave, hh = lane >> 5, l31 = lane & 31;
    v4u rq[4], rk[4], rv[4]; float bjn = 0.f, ijn = 0.f, minn = 0.f;
#define MO_LOAD(uu) do { const int bh_ = (uu) >> 7, c_ = (uu) & 127, b_ = bh_ >> 2, h_ = bh_ & 3, t0_ = b_ * SEQ + c_ * CHUNK; \
        _Pragma("unroll") for (int i = 0; i < 4; ++i) { const int p = F.tid + NTHR * i, s = p >> 5, c8 = (p & 31) * 8; \
            rq[i] = *(const GAS v4u*)(QKC + (size_t)(t0_ + s) * 2048 + h_ * 256 + c8); rk[i] = *(const GAS v4u*)(QKC + (size_t)(t0_ + s) * 2048 + 1024 + h_ * 256 + c8); \
            rv[i] = *(const GAS v4u*)(PROJ + (size_t)(t0_ + s) * NPROJ + PV_M + h_ * 256 + c8); } \
        if (w == 0) { bjn = BCUM[(size_t)(t0_ + lane) * 4 + h_]; ijn = IFG[(size_t)(t0_ + lane) * 8 + h_]; minn = CHM[(uu)]; } } while (0)
    if (F.vcu < 1024) MO_LOAD(F.vcu);
    for (int u = F.vcu; u < 1024; u += F.G) {
        const int bh = u >> 7, c = u & 127, b = bh >> 2, h = bh & 3, t0 = b * SEQ + c * CHUNK;
        bf16x8 cf[16];
        { const bf16* Cu = CIN + (size_t)u * 65536 + (size_t)(32 * w + l31) * 32 + 8 * hh;
#pragma unroll
            for (int ks = 0; ks < 16; ++ks) cf[ks] = *(const GAS bf16x8*)(Cu + (ks >> 1) * 8192 + 16 * (ks & 1)); }
#pragma unroll
        for (int i = 0; i < 4; ++i) { const int p = F.tid + NTHR * i, s = p >> 5, c8 = (p & 31) * 8;
            const v4u vv = rv[i];
            *(LAS v4u*)(Qs + s * QP + c8) = rq[i]; *(LAS v4u*)(Ks + s * QP + c8) = rk[i];
            LAS bf16* vd = Vt + tp_col(c8, s);
            vd[0 * TP] = (bf16)(vv.x & 0xffff); vd[1 * TP] = (bf16)(vv.x >> 16); vd[2 * TP] = (bf16)(vv.y & 0xffff); vd[3 * TP] = (bf16)(vv.y >> 16);
            vd[4 * TP] = (bf16)(vv.z & 0xffff); vd[5 * TP] = (bf16)(vv.z >> 16); vd[6 * TP] = (bf16)(vv.w & 0xffff); vd[7 * TP] = (bf16)(vv.w >> 16); }
        if (w == 0) {
            const float bj = bjn, ij = ijn, m_in = minn;
            float pm = ij - bj;
#pragma unroll
            for (int o = 1; o < 64; o <<= 1) { const float y = __shfl_up(pm, o); if (lane >= o) pm = fmaxf(pm, y); }
            const float il = bj + m_in, mj = fmaxf(il, bj + pm);
            fb[lane] = bj; fi[lane] = ij; fmj[lane] = mj; fwi[lane] = __expf(il - mj);
        }
        __syncthreads();
        if (u + F.G < 1024) MO_LOAD(u + F.G);
        if (w < 4) {
            const int tj = w >> 1, ts = w & 1;
            f32x16 acc = {0.f, 0.f, 0.f, 0.f, 0.f, 0.f, 0.f, 0.f, 0.f, 0.f, 0.f, 0.f, 0.f, 0.f, 0.f, 0.f};
#pragma unroll
            for (int ks = 0; ks < 16; ++ks) { const bf16x8 a = *(const LAS bf16x8*)(Qs + (32 * tj + l31) * QP + 16 * ks + 8 * hh);
                const bf16x8 bb = *(const LAS bf16x8*)(Ks + (32 * ts + l31) * QP + 16 * ks + 8 * hh); acc = mfma32(a, bb, acc); }
            const int s = 32 * ts + l31; const float cs = fi[s] - fb[s];
#pragma unroll
            for (int r = 0; r < 16; ++r) { const int j = 32 * tj + (r & 3) + 8 * (r >> 2) + 4 * hh;
                const float p = (s <= j) ? acc[r] * __expf(fb[j] - fmj[j] + cs) : 0.f;
                Sm[j * TP + s] = f2bf(p);
                float v = p; v += __shfl_xor(v, 1); v += __shfl_xor(v, 2); v += __shfl_xor(v, 4); v += __shfl_xor(v, 8); v += __shfl_xor(v, 16);
                if (l31 == 0) dpart[ts * 64 + j] = v; }
        } else {
            const int tt = F.tid - 256, j = tt >> 2, part = tt & 3; float a = 0.f;
            const GAS f32x4* nin = (const GAS f32x4*)(NIN + (size_t)u * 256 + part * 64);
#pragma unroll
            for (int hb = 0; hb < 4; ++hb) { f32x4 nv[4];
#pragma unroll
                for (int k4 = 0; k4 < 4; ++k4) nv[k4] = nin[4 * hb + k4];
#pragma unroll
                for (int k4 = 0; k4 < 4; ++k4) { const v2u qw = *(const LAS v2u*)(Qs + j * QP + part * 64 + 16 * hb + 4 * k4);
                    a += nv[k4].x * bflo(qw.x) + nv[k4].y * bfhi(qw.x) + nv[k4].z * bflo(qw.y) + nv[k4].w * bfhi(qw.y); } }
            a += __shfl_xor(a, 1); a += __shfl_xor(a, 2);
            if (part == 0) dint[j] = fwi[j] * a;
        }
        __syncthreads();
        f32x16 acc[2];
#pragma unroll
        for (int tj = 0; tj < 2; ++tj) acc[tj] = (f32x16){0.f, 0.f, 0.f, 0.f, 0.f, 0.f, 0.f, 0.f, 0.f, 0.f, 0.f, 0.f, 0.f, 0.f, 0.f, 0.f};
#pragma unroll
        for (int ks = 0; ks < 16; ++ks) { const bf16x8 a = cf[ks];
#pragma unroll
            for (int tj = 0; tj < 2; ++tj) { const bf16x8 bq = *(const LAS bf16x8*)(Qs + (32 * tj + l31) * QP + 16 * ks + 8 * hh); acc[tj] = mfma32(a, bq, acc[tj]); } }
#pragma unroll
        for (int tj = 0; tj < 2; ++tj) { const float wi = fwi[32 * tj + l31];
#pragma unroll
            for (int r = 0; r < 16; ++r) acc[tj][r] *= wi; }
#pragma unroll
        for (int ks = 0; ks < 4; ++ks) { const bf16x8 a = *(const LAS bf16x8*)(Vt + tp_chunk(32 * w + l31, 2 * ks + hh));
#pragma unroll
            for (int tj = 0; tj < 2; ++tj) { const bf16x8 bs = *(const LAS bf16x8*)(Sm + (32 * tj + l31) * TP + 16 * ks + 8 * hh); acc[tj] = mfma32(a, bs, acc[tj]); } }
#pragma unroll
        for (int tj = 0; tj < 2; ++tj) { const int j = 32 * tj + l31; const float den = (dpart[j] + dpart[64 + j]) + dint[j];
            const float inv = 1.f / fmaxf(fabsf(den), __expf(-fmj[j])); float q2 = 0.f;
#pragma unroll
            for (int r = 0; r < 16; ++r) { acc[tj][r] *= inv; q2 += acc[tj][r] * acc[tj][r]; }
            q2 += __shfl_xor(q2, 32);
            if (hh == 0) hpart[w * 64 + j] = q2; }
        __syncthreads();
        f32x4 nwv[4]; v2u ogv[2][4];
#pragma unroll
        for (int rg = 0; rg < 4; ++rg) { const int v0 = 32 * w + 8 * rg + 4 * hh; nwv[rg] = *(const GAS f32x4*)(hnw + h * 256 + v0);
#pragma unroll
            for (int tj = 0; tj < 2; ++tj) ogv[tj][rg] = *(const GAS v2u*)(PROJ + (size_t)(t0 + 32 * tj + l31) * NPROJ + PO_M + h * 256 + v0); }
#pragma unroll
        for (int tj = 0; tj < 2; ++tj) { const int j = 32 * tj + l31; float hs = 0.f;
#pragma unroll
            for (int ww = 0; ww < 8; ++ww) hs += hpart[ww * 64 + j];
            const float rs = 1.f / sqrtf(hs * (1.f / MD) + EPS); const size_t t = (size_t)(t0 + j);
#pragma unroll
            for (int rg = 0; rg < 4; ++rg) { const int v0 = 32 * w + 8 * rg + 4 * hh;
                const f32x4 nw = nwv[rg];
                const v2u og = ogv[tj][rg];
                v2u o; o.x = pk2(acc[tj][4 * rg] * rs * nw.x * bflo(og.x), acc[tj][4 * rg + 1] * rs * nw.y * bfhi(og.x));
                o.y = pk2(acc[tj][4 * rg + 2] * rs * nw.z * bflo(og.y), acc[tj][4 * rg + 3] * rs * nw.w * bfhi(og.y));
                *(GAS v2u*)(HM + t * 2048 + h * 256 + v0) = o; } }
        __syncthreads();
    }
#undef MO_LOAD
}

template <int DH> struct AttnState { f32x16 ot[DH / 32]; bf16x8 qf[DH / 16]; float m_run, l_run; };
template <int DH, bool BAND>
__device__ __forceinline__ void attn_step(AttnState<DH>& A, const LAS bf16* Ks, const LAS bf16* Vt, const LAS float* relb, int dchunk, int qi, int lane) {
    constexpr int KP = DH + 8;
    const int hh = lane >> 5, l31 = lane & 31;
    f32x16 st[2];
#pragma unroll
    for (int kt = 0; kt < 2; ++kt) { st[kt] = (f32x16){0.f, 0.f, 0.f, 0.f, 0.f, 0.f, 0.f, 0.f, 0.f, 0.f, 0.f, 0.f, 0.f, 0.f, 0.f, 0.f};
#pragma unroll
        for (int ks = 0; ks < DH / 16; ++ks) { const bf16x8 a = *(const LAS bf16x8*)(Ks + (32 * kt + l31) * KP + 16 * ks + 8 * hh); st[kt] = mfma32(a, A.qf[ks], st[kt]); } }
    float mx = -1e30f, cadd = 0.f;
    if (BAND && dchunk < 3) {
        const int base4 = (64 * dchunk + qi - 4 * hh + 128) * 4;
#pragma unroll
        for (int kt = 0; kt < 2; ++kt)
#pragma unroll
            for (int r = 0; r < 16; ++r) { int i4 = base4 - 4 * (32 * kt + (r & 3) + 8 * (r >> 2)); i4 = i4 > 1024 ? 1024 : i4;
                const float s = st[kt][r] + *(const LAS float*)((const LAS char*)relb + i4); st[kt][r] = s; mx = fmaxf(mx, s); }
    } else {
#pragma unroll
        for (int kt = 0; kt < 2; ++kt)
#pragma unroll
            for (int r = 0; r < 16; ++r) mx = fmaxf(mx, st[kt][r]);
        if (BAND) { cadd = relb[256]; mx += cadd; }
    }
    mx = fmaxf(mx, __shfl_xor(mx, 32));
    const float mn = fmaxf(A.m_run, mx), alpha = __builtin_amdgcn_exp2f(A.m_run - mn), sh = cadd - mn;
    float sum = 0.f;
#pragma unroll
    for (int kt = 0; kt < 2; ++kt)
#pragma unroll
        for (int r = 0; r < 16; ++r) { const float p = __builtin_amdgcn_exp2f(st[kt][r] + sh); st[kt][r] = p; sum += p; }
    sum += __shfl_xor(sum, 32);
    A.l_run = A.l_run * alpha + sum; A.m_run = mn;
#pragma unroll
    for (int dt = 0; dt < DH / 32; ++dt)
#pragma unroll
        for (int r = 0; r < 16; ++r) A.ot[dt][r] *= alpha;
#pragma unroll
    for (int kt = 0; kt < 2; ++kt)
#pragma unroll
        for (int s2 = 0; s2 < 2; ++s2) {
            union { v4u u; bf16x8 v; } pf;
            pf.u.x = pk2(st[kt][8 * s2 + 0], st[kt][8 * s2 + 1]); pf.u.y = pk2(st[kt][8 * s2 + 2], st[kt][8 * s2 + 3]);
            pf.u.z = pk2(st[kt][8 * s2 + 4], st[kt][8 * s2 + 5]); pf.u.w = pk2(st[kt][8 * s2 + 6], st[kt][8 * s2 + 7]);
#pragma unroll
            for (int dt = 0; dt < DH / 32; ++dt) {
                const int vr = 32 * dt + l31, ch = 4 * kt + 2 * s2;
                union { v2u u[2]; bf16x8 v; } af; af.u[0] = *(const LAS v2u*)(Vt + tp_chunk(vr, ch) + 4 * hh); af.u[1] = *(const LAS v2u*)(Vt + tp_chunk(vr, ch + 1) + 4 * hh);
                A.ot[dt] = mfma32(af.v, pf.v, A.ot[dt]); } }
}
template <int DH> struct KVRegs { v4u k[(8 * DH) / NTHR], v[(8 * DH) / NTHR]; };
template <int DH>
__device__ __forceinline__ void attn_load(KVRegs<DH>& R, const bf16* kg, const bf16* vg, size_t pitch, int tid) {
    constexpr int PPR = DH / 8;
#pragma unroll
    for (int i = 0; i < (64 * PPR) / NTHR; ++i) { const int p = tid + NTHR * i, key = p / PPR, c8 = (p % PPR) * 8;
        R.k[i] = *(const GAS v4u*)(kg + (size_t)key * pitch + c8); R.v[i] = *(const GAS v4u*)(vg + (size_t)key * pitch + c8); }
}
template <int DH>
__device__ __forceinline__ void attn_put(LAS bf16* Ks, LAS bf16* Vt, const KVRegs<DH>& R, int tid) {
    constexpr int KP = DH + 8, PPR = DH / 8;
#pragma unroll
    for (int i = 0; i < (64 * PPR) / NTHR; ++i) { const int p = tid + NTHR * i, key = p / PPR, c8 = (p % PPR) * 8;
        const v4u vv = R.v[i];
        *(LAS v4u*)(Ks + key * KP + c8) = R.k[i];
        LAS bf16* vd = Vt + tp_col(c8, key);
        vd[0 * TP] = (bf16)(vv.x & 0xffff); vd[1 * TP] = (bf16)(vv.x >> 16); vd[2 * TP] = (bf16)(vv.y & 0xffff); vd[3 * TP] = (bf16)(vv.y >> 16);
        vd[4 * TP] = (bf16)(vv.z & 0xffff); vd[5 * TP] = (bf16)(vv.z >> 16); vd[6 * TP] = (bf16)(vv.w & 0xffff); vd[7 * TP] = (bf16)(vv.w >> 16); }
}
template <int DH>
__device__ __forceinline__ void attn_init(AttnState<DH>& A, const bf16* qrow, int lane) {
    const int hh = lane >> 5;
#pragma unroll
    for (int ks = 0; ks < DH / 16; ++ks) A.qf[ks] = *(const GAS bf16x8*)(qrow + 16 * ks + 8 * hh);
#pragma unroll
    for (int dt = 0; dt < DH / 32; ++dt) A.ot[dt] = (f32x16){0.f, 0.f, 0.f, 0.f, 0.f, 0.f, 0.f, 0.f, 0.f, 0.f, 0.f, 0.f, 0.f, 0.f, 0.f, 0.f};
    A.m_run = -1e30f; A.l_run = 0.f;
}
template <int DH>
__device__ __forceinline__ void attn_store(const AttnState<DH>& A, bf16* orow, int lane) {
    const int hh = lane >> 5; const float inv = 1.f / A.l_run;
#pragma unroll
    for (int dt = 0; dt < DH / 32; ++dt)
#pragma unroll
        for (int rg = 0; rg < 4; ++rg) { v2u o; o.x = pk2(A.ot[dt][4 * rg] * inv, A.ot[dt][4 * rg + 1] * inv); o.y = pk2(A.ot[dt][4 * rg + 2] * inv, A.ot[dt][4 * rg + 3] * inv);
            *(GAS v2u*)(orow + 32 * dt + 8 * rg + 4 * hh) = o; }
}

__device__ __forceinline__ void p_band_attn(Frame& F) {
    frame_ids(F);
    const bf16* PROJ = (const bf16*)(F.ws + WS_PROJ); bf16* YA = (bf16*)(F.ws + WS_HM) + 1024;
    constexpr int KSZ = 64 * (AD + 8), VSZ = AD * TP, BUF = KSZ + VSZ;
    LAS bf16* B0 = (LAS bf16*)(F.lds + RING_OFF);
    LAS float* relb = (LAS float*)(B0 + 2 * BUF);
    const int lane = F.lane, w = F.wave, l31 = lane & 31;
    for (int u = F.vcu; u < BATCH * AH * 32; u += F.G) {
        const int b = u >> 9, hd = (u >> 5) & 15, qt = u & 31;
        for (int i = F.tid; i < 257; i += NTHR) relb[i] = F.in[I_REL][hd * 257 + i] * 1.4426950408889634f;
        const int cw = 4 * qt + (w >> 1), qi = (w & 1) * 32 + l31; const size_t tq = (size_t)b * SEQ + cw * CHUNK + qi;
        AttnState<AD> A; attn_init<AD>(A, PROJ + tq * NPROJ + PQ_A + hd * AD, lane);
        const int kc0 = (4 * qt - 8) > 0 ? (4 * qt - 8) : 0, kc1 = 4 * qt + 3;
        const bf16* kbase = PROJ + (size_t)b * SEQ * NPROJ + PK_A + hd * AD; const bf16* vbase = PROJ + (size_t)b * SEQ * NPROJ + PV_A + hd * AD;
        KVRegs<AD> R0, R1;
        attn_load<AD>(R0, kbase + (size_t)kc0 * CHUNK * NPROJ, vbase + (size_t)kc0 * CHUNK * NPROJ, NPROJ, F.tid);
        if (kc0 + 1 <= kc1) attn_load<AD>(R1, kbase + (size_t)(kc0 + 1) * CHUNK * NPROJ, vbase + (size_t)(kc0 + 1) * CHUNK * NPROJ, NPROJ, F.tid);
        for (int kc = kc0; kc <= kc1; kc += 2) {
            { LAS bf16* Ks = B0; LAS bf16* Vt = Ks + KSZ;
              attn_put<AD>(Ks, Vt, R0, F.tid);
              __syncthreads();
              if (kc + 2 <= kc1) attn_load<AD>(R0, kbase + (size_t)(kc + 2) * CHUNK * NPROJ, vbase + (size_t)(kc + 2) * CHUNK * NPROJ, NPROJ, F.tid);
              if (kc >= cw - 8 && kc <= cw) attn_step<AD, true>(A, Ks, Vt, relb, cw - kc, qi, lane); }
            if (kc + 1 <= kc1) { LAS bf16* Ks = B0 + BUF; LAS bf16* Vt = Ks + KSZ;
              attn_put<AD>(Ks, Vt, R1, F.tid);
              __syncthreads();
              if (kc + 3 <= kc1) attn_load<AD>(R1, kbase + (size_t)(kc + 3) * CHUNK * NPROJ, vbase + (size_t)(kc + 3) * CHUNK * NPROJ, NPROJ, F.tid);
              if (kc + 1 >= cw - 8 && kc + 1 <= cw) attn_step<AD, true>(A, Ks, Vt, relb, cw - kc - 1, qi, lane); }
        }
        attn_store<AD>(A, YA + tq * 2048 + hd * AD, lane);
        __syncthreads();
    }
}

__device__ __forceinline__ void p_local_band(Frame& F) {
    frame_ids(F);
    const bf16* PROJ = (const bf16*)(F.ws + WS_PROJ); const bf16* QKC = (const bf16*)(F.ws + WS_QKC); const float* IFG = (const float*)(F.ws + WS_IFG);
    float* BCUM = (float*)(F.ws + WS_BCUM); bf16* CLOC = (bf16*)(F.ws + WS_CLOC); float* NLOC = (float*)(F.ws + WS_NLOC);
    float* CHA = (float*)(F.ws + WS_CHS); float* CHG = CHA + 1024;
    LAS bf16* Kt = (LAS bf16*)(F.lds + RING_OFF);
    LAS bf16* Vt = Kt + 256 * TP;
    LAS float* es = (LAS float*)(Vt + 256 * TP);
    const int lane = F.lane, w = F.wave, hh = lane >> 5, l31 = lane & 31;
    v4u rk[4], rv[4]; float ipn = 0.f, fpn = 0.f;
#define ML_LOAD(uu) do { const int bh_ = (uu) >> 7, c_ = (uu) & 127, b_ = bh_ >> 2, h_ = bh_ & 3, t0_ = b_ * SEQ + c_ * CHUNK; \
        _Pragma("unroll") for (int i = 0; i < 4; ++i) { const int p = F.tid + NTHR * i, s = p >> 5, c8 = (p & 31) * 8; \
            rk[i] = *(const GAS v4u*)(QKC + (size_t)(t0_ + s) * 2048 + 1024 + h_ * 256 + c8); rv[i] = *(const GAS v4u*)(PROJ + (size_t)(t0_ + s) * NPROJ + PV_M + h_ * 256 + c8); } } while (0)
#define ML_LOADG(uu) do { const int bh_ = (uu) >> 7, c_ = (uu) & 127, b_ = bh_ >> 2, h_ = bh_ & 3, t0_ = b_ * SEQ + c_ * CHUNK; \
        if (F.wave == 0) { ipn = IFG[(size_t)(t0_ + F.lane) * 8 + h_]; fpn = IFG[(size_t)(t0_ + F.lane) * 8 + 4 + h_]; } } while (0)
    const int par = F.vcu & 1;
    if (F.vcu < 1024) { ML_LOAD(F.vcu); ML_LOADG(F.vcu); }
    for (int i = 0; F.vcu + (i - par) * F.G < 1024; ++i) {
        const int ul = F.vcu + (i - par) * F.G, ub = F.vcu + i * F.G, uln = ul + F.G;
        if (ul >= 0) {
        const int u = ul;
        int lane = F.lane; asm volatile("" : "+v"(lane));
        const int tid_ = F.wave * 64 + lane, hh = lane >> 5, l31 = lane & 31;
        const int bh = u >> 7, c = u & 127, b = bh >> 2, h = bh & 3, t0 = b * SEQ + c * CHUNK;
        if (w == 0) {
            const float ip = ipn, fp = fpn;
            const float lf = fminf(fp, 0.f) - log1pf(__expf(-fabsf(fp)));
            float bc = lf;
#pragma unroll
            for (int o = 1; o < 64; o <<= 1) { const float y = __shfl_up(bc, o); if (lane >= o) bc += y; }
            const float g = __shfl(bc, 63), we = g - bc + ip, a = wave_max(we);
            es[lane] = __expf(we - a);
            BCUM[(size_t)(t0 + lane) * 4 + h] = bc;
            if (lane == 0) { CHA[u] = a; CHG[u] = g; }
        }
        __syncthreads();
#pragma unroll
        for (int i = 0; i < 4; ++i) { const int p = tid_ + NTHR * i, s = p >> 5, c8 = (p & 31) * 8;
            const v4u kv = rk[i], vv = rv[i];
            const float e = es[s];
            LAS bf16* kd = Kt + tp_col(c8, s); LAS bf16* vd = Vt + tp_col(c8, s);
            kd[0 * TP] = (bf16)(kv.x & 0xffff); kd[1 * TP] = (bf16)(kv.x >> 16); kd[2 * TP] = (bf16)(kv.y & 0xffff); kd[3 * TP] = (bf16)(kv.y >> 16);
            kd[4 * TP] = (bf16)(kv.z & 0xffff); kd[5 * TP] = (bf16)(kv.z >> 16); kd[6 * TP] = (bf16)(kv.w & 0xffff); kd[7 * TP] = (bf16)(kv.w >> 16);
            vd[0 * TP] = f2bf(bflo(vv.x) * e); vd[1 * TP] = f2bf(bfhi(vv.x) * e); vd[2 * TP] = f2bf(bflo(vv.y) * e); vd[3 * TP] = f2bf(bfhi(vv.y) * e);
            vd[4 * TP] = f2bf(bflo(vv.z) * e); vd[5 * TP] = f2bf(bfhi(vv.z) * e); vd[6 * TP] = f2bf(bflo(vv.w) * e); vd[7 * TP] = f2bf(bfhi(vv.w) * e); }
        __syncthreads();
        if (uln < 1024) { ML_LOAD(uln); ML_LOADG(uln); }
        bf16x8 af[4];
#pragma unroll
        for (int ks = 0; ks < 4; ++ks) af[ks] = *(const LAS bf16x8*)(Kt + tp_chunk(32 * w + l31, 2 * ks + hh));
        bf16* Cu = CLOC + (size_t)u * 65536;
#pragma unroll 2
        for (int ni = 0; ni < 8; ++ni) {
            f32x16 acc = {0.f, 0.f, 0.f, 0.f, 0.f, 0.f, 0.f, 0.f, 0.f, 0.f, 0.f, 0.f, 0.f, 0.f, 0.f, 0.f};
#pragma unroll
            for (int ks = 0; ks < 4; ++ks) { const bf16x8 bfr = *(const LAS bf16x8*)(Vt + tp_chunk(32 * ni + l31, 2 * ks + hh)); acc = mfma32(af[ks], bfr, acc); }
            const int v = 32 * ni + l31;
#pragma unroll
            for (int rg = 0; rg < 4; ++rg) { v2u o; o.x = pk2(acc[4 * rg], acc[4 * rg + 1]); o.y = pk2(acc[4 * rg + 2], acc[4 * rg + 3]);
                *(GAS v2u*)(Cu + (size_t)w * 8192 + v * 32 + 8 * rg + 4 * hh) = o; }
        }
        if (tid_ < 256) { float a = 0.f;
#pragma unroll
            for (int cch = 0; cch < 8; ++cch) { const v4u kq = *(const LAS v4u*)(Kt + tp_chunk(tid_, cch)); const LAS float* e8 = es + 8 * cch;
                a += e8[0] * bflo(kq.x); a += e8[1] * bfhi(kq.x); a += e8[2] * bflo(kq.y); a += e8[3] * bfhi(kq.y); a += e8[4] * bflo(kq.z); a += e8[5] * bfhi(kq.z); a += e8[6] * bflo(kq.w); a += e8[7] * bfhi(kq.w); }
            NLOC[(size_t)u * 256 + tid_] = a; }
        __syncthreads();
            }
        if (ub < 1024) {
        const int u = ub;
    const bf16* PROJ = (const bf16*)(F.ws + WS_PROJ); bf16* YA = (bf16*)(F.ws + WS_HM) + 1024;
    constexpr int KSZ = 64 * (AD + 8), VSZ = AD * TP, BUF = KSZ + VSZ;
    LAS bf16* B0 = (LAS bf16*)(F.lds + RING_OFF);
    LAS float* relb = (LAS float*)(B0 + 2 * BUF);
    int lane = F.lane; asm volatile("" : "+v"(lane));
    const int tid_ = F.wave * 64 + lane, w = F.wave, l31 = lane & 31;
        {
        const int b = u >> 9, hd = (u >> 5) & 15, qt = u & 31;
        for (int i = tid_; i < 257; i += NTHR) relb[i] = F.in[I_REL][hd * 257 + i] * 1.4426950408889634f;
        const int cw = 4 * qt + (w >> 1), qi = (w & 1) * 32 + l31; const size_t tq = (size_t)b * SEQ + cw * CHUNK + qi;
        AttnState<AD> A; attn_init<AD>(A, PROJ + tq * NPROJ + PQ_A + hd * AD, lane);
        const int kc0 = (4 * qt - 8) > 0 ? (4 * qt - 8) : 0, kc1 = 4 * qt + 3;
        const bf16* kbase = PROJ + (size_t)b * SEQ * NPROJ + PK_A + hd * AD; const bf16* vbase = PROJ + (size_t)b * SEQ * NPROJ + PV_A + hd * AD;
        KVRegs<AD> R0, R1;
        attn_load<AD>(R0, kbase + (size_t)kc0 * CHUNK * NPROJ, vbase + (size_t)kc0 * CHUNK * NPROJ, NPROJ, tid_);
        if (kc0 + 1 <= kc1) attn_load<AD>(R1, kbase + (size_t)(kc0 + 1) * CHUNK * NPROJ, vbase + (size_t)(kc0 + 1) * CHUNK * NPROJ, NPROJ, tid_);
        for (int kc = kc0; kc <= kc1; kc += 2) {
            { LAS bf16* Ks = B0; LAS bf16* Vt = Ks + KSZ;
              attn_put<AD>(Ks, Vt, R0, tid_);
              __syncthreads();
              if (kc + 2 <= kc1) attn_load<AD>(R0, kbase + (size_t)(kc + 2) * CHUNK * NPROJ, vbase + (size_t)(kc + 2) * CHUNK * NPROJ, NPROJ, tid_);
              if (kc >= cw - 8 && kc <= cw) attn_step<AD, true>(A, Ks, Vt, relb, cw - kc, qi, lane); }
            if (kc + 1 <= kc1) { LAS bf16* Ks = B0 + BUF; LAS bf16* Vt = Ks + KSZ;
              attn_put<AD>(Ks, Vt, R1, tid_);
              __syncthreads();
              if (kc + 3 <= kc1) attn_load<AD>(R1, kbase + (size_t)(kc + 3) * CHUNK * NPROJ, vbase + (size_t)(kc + 3) * CHUNK * NPROJ, NPROJ, tid_);
              if (kc + 1 >= cw - 8 && kc + 1 <= cw) attn_step<AD, true>(A, Ks, Vt, relb, cw - kc - 1, qi, lane); }
        }
        attn_store<AD>(A, YA + tq * 2048 + hd * AD, lane);
        __syncthreads();
            }
        }
    }
#undef ML_LOADG
#undef ML_LOAD
}


__device__ __forceinline__ void p_cross_attn(Frame& F) {
    frame_ids(F);
    const bf16* QX = (const bf16*)(F.ws + WS_QX); const bf16* KVX = (const bf16*)(F.ws + WS_KVX); bf16* OX = (bf16*)(F.ws + WS_OX);
    constexpr int KSZ = 64 * (XD + 8), VSZ = XD * TP, BUF = KSZ + VSZ;
    LAS bf16* B0 = (LAS bf16*)(F.lds + RING_OFF);
    const int lane = F.lane, w = F.wave, l31 = lane & 31;
    for (int u = F.vcu; u < BATCH * XH * 32; u += F.G) {
        const int b = u >> 7, hx = (u >> 5) & 3, qt = u & 31;
        const size_t tq = (size_t)b * SEQ + qt * 256 + 32 * w + l31;
        AttnState<XD> A; attn_init<XD>(A, QX + tq * XW + hx * XD, lane);
        const bf16* kg0 = KVX + (size_t)(b * NMEM) * (2 * XW) + hx * XD;
        KVRegs<XD> R; attn_load<XD>(R, kg0, kg0 + XW, 2 * XW, F.tid);
        for (int st = 0; st < 4; ++st) {
            LAS bf16* Ks = B0 + (st & 1) * BUF; LAS bf16* Vt = Ks + KSZ;
            attn_put<XD>(Ks, Vt, R, F.tid);
            __syncthreads();
            if (st < 3) { const bf16* kg = kg0 + (size_t)((st + 1) * 64) * (2 * XW); attn_load<XD>(R, kg, kg + XW, 2 * XW, F.tid); }
            attn_step<XD, false>(A, Ks, Vt, nullptr, 0, 0, lane);
        }
        attn_store<XD>(A, OX + tq * XW + hx * XD, lane);
        __syncthreads();
    }
}

__device__ __forceinline__ void p_rmsnorm_rows(Frame& F, const float* X, const float* w, bf16* XN, unsigned char* XQ) {
    frame_ids(F);
    const int gw = F.vcu * NWAVES + F.wave, NGW = F.G * NWAVES;
    for (int m = gw; m < T; m += NGW) {
        const GAS f32x4* xr = (const GAS f32x4*)(X + (size_t)m * D) + F.lane;
        f32x4 v[8]; float s = 0.f;
#pragma unroll
        for (int j = 0; j < 8; ++j) { v[j] = xr[64 * j]; s += (v[j].x * v[j].x + v[j].y * v[j].y) + (v[j].z * v[j].z + v[j].w * v[j].w); }
        const float rstd = 1.f / sqrtf(wave_sum(s) * (1.f / D) + EPS);
        const GAS f32x4* wr = (const GAS f32x4*)w + F.lane;
        GAS v2u* o8 = (GAS v2u*)(XN + (size_t)m * D) + F.lane;
#pragma unroll
        for (int j = 0; j < 8; ++j) { const f32x4 ww = wr[64 * j]; v[j].x *= rstd * ww.x; v[j].y *= rstd * ww.y; v[j].z *= rstd * ww.z; v[j].w *= rstd * ww.w;
            v2u o; o.x = pk2(v[j].x, v[j].y); o.y = pk2(v[j].z, v[j].w); o8[64 * j] = o; }
        if (XQ) { GAS unsigned* q4 = (GAS unsigned*)(XQ + (size_t)m * D) + F.lane;
#pragma unroll
            for (int j = 0; j < 8; ++j) q4[64 * j] = pg8::pk_fp8x4(v[j].x * XSCALE, v[j].y * XSCALE, v[j].z * XSCALE, v[j].w * XSCALE); }
    }
}


constexpr int NR_EXTRA = 133120;
__device__ __forceinline__ void p_norm_route(Frame& F) {
    frame_ids(F);
    const bf16* X2 = (const bf16*)(F.ws + WS_X2); const float* nw = F.in[I_NFFNW]; const bf16* WR = (const bf16*)(F.ws + WS_WR); const float* br = F.in[I_BR];
    unsigned char* XQ = (unsigned char*)(F.ws + WS_XQ); float* RSTD = (float*)(F.ws + WS_RSTD);
    int* TOPE = (int*)(F.ws + WS_TOPE); float* GATE = (float*)(F.ws + WS_GATE); int* RANK = (int*)(F.ws + WS_RANK); int* HIST = (int*)(F.ws + WS_CTL) + CW_HIST;
    LAS unsigned char* wt = F.lds + RING_OFF;
    LAS float* part = (LAS float*)(F.lds + NR_EXTRA);
    LAS float* sq = part + 64 * 32;
    LAS float* rs = sq + 64;
    LAS int* lh = (LAS int*)(rs + 64); LAS int* le = lh + 32;
    for (int i = 0; i < 16; ++i) { const int q = F.tid + NTHR * i, e = q >> 8, c = q & 255;
        *(LAS v4u*)(wt + e * 4096 + ((c ^ (e & 15)) << 4)) = *(const GAS v4u*)(WR + (size_t)e * D + 8 * c); }
    const int lane = F.lane, w = F.wave, tg = w & 3, kh = w >> 2, r16 = lane & 15, kq = lane >> 4;
    for (int blk = F.vcu; blk < T / 64; blk += F.G) {
        if (F.tid < 32) lh[F.tid] = 0;
        __syncthreads();
        const int tok = 16 * tg + r16; const size_t t = (size_t)blk * 64 + tok;
        f32x4 acc[2]; acc[0] = (f32x4){0.f, 0.f, 0.f, 0.f}; acc[1] = acc[0]; float ssq = 0.f;
        const bf16* xrow = X2 + t * D + 1024 * kh + 8 * kq; const float* nwp = nw + 1024 * kh + 8 * kq;
        unsigned char* qrow = XQ + t * D + 1024 * kh + 8 * kq;
#pragma unroll 8
        for (int ks = 0; ks < 32; ++ks) {
            const v4u xw = *(const GAS v4u*)(xrow + 32 * ks); const f32x4 xa = {bflo(xw.x), bfhi(xw.x), bflo(xw.y), bfhi(xw.y)}, xb = {bflo(xw.z), bfhi(xw.z), bflo(xw.w), bfhi(xw.w)};
            const f32x4 na = *(const GAS f32x4*)(nwp + 32 * ks), nb = *(const GAS f32x4*)(nwp + 32 * ks + 4);
            ssq += (xa.x * xa.x + xa.y * xa.y) + (xa.z * xa.z + xa.w * xa.w) + (xb.x * xb.x + xb.y * xb.y) + (xb.z * xb.z + xb.w * xb.w);
            const f32x4 ya = xa * na, yb = xb * nb;
            union { v4u u; bf16x8 v; } af; af.u.x = pk2(ya.x, ya.y); af.u.y = pk2(ya.z, ya.w); af.u.z = pk2(yb.x, yb.y); af.u.w = pk2(yb.z, yb.w);
            v2u qq; qq.x = pg8::pk_fp8x4(ya.x * XSCALE, ya.y * XSCALE, ya.z * XSCALE, ya.w * XSCALE); qq.y = pg8::pk_fp8x4(yb.x * XSCALE, yb.y * XSCALE, yb.z * XSCALE, yb.w * XSCALE);
            *(GAS v2u*)(qrow + 32 * ks) = qq;
            const int c = 128 * kh + 4 * ks + kq;
#pragma unroll
            for (int et = 0; et < 2; ++et) { const bf16x8 bfr = *(const LAS bf16x8*)(wt + (16 * et + r16) * 4096 + ((c ^ r16) << 4));
                acc[et] = __builtin_amdgcn_mfma_f32_16x16x32_bf16(af.v, bfr, acc[et], 0, 0, 0); }
        }
        ssq += __shfl_xor(ssq, 16); ssq += __shfl_xor(ssq, 32);
        if (kh == 1) {
#pragma unroll
            for (int et = 0; et < 2; ++et)
#pragma unroll
                for (int r = 0; r < 4; ++r) part[(16 * tg + 4 * kq + r) * 32 + 16 * et + r16] = acc[et][r];
            if (kq == 0) sq[tok] = ssq;
        }
        __syncthreads();
        if (kh == 0) {
            const float rstd = 1.f / sqrtf((ssq + sq[tok]) * (1.f / D) + EPS);
            if (kq == 0) { rs[tok] = rstd; RSTD[t] = rstd; }
            LDS_WAIT(); asm volatile("" ::: "memory");
#pragma unroll
            for (int et = 0; et < 2; ++et)
#pragma unroll
                for (int r = 0; r < 4; ++r) { const int tr = 16 * tg + 4 * kq + r, e = 16 * et + r16;
                    part[tr * 32 + e] = (acc[et][r] + part[tr * 32 + e]) * rs[tr] + br[e]; }
            LDS_WAIT(); asm volatile("" ::: "memory");
            if (lane < 16) { const int tk = 16 * tg + lane; const size_t tt = (size_t)blk * 64 + tk;
                float lg[32];
#pragma unroll
                for (int e = 0; e < 32; ++e) lg[e] = part[tk * 32 + e];
                float tv[4]; int te[4];
#pragma unroll
                for (int k = 0; k < 4; ++k) { float best = -3.0e38f; int bi = 0;
#pragma unroll
                    for (int e = 0; e < 32; ++e) { if (lg[e] > best) { best = lg[e]; bi = e; } }
                    tv[k] = best; te[k] = bi;
#pragma unroll
                    for (int e = 0; e < 32; ++e) lg[e] = (e == bi) ? -3.0e38f : lg[e]; }
                const float e1 = __expf(tv[1] - tv[0]), e2 = __expf(tv[2] - tv[0]), e3 = __expf(tv[3] - tv[0]), inv = 1.f / (1.f + e1 + e2 + e3);
                const float gk[4] = {inv, e1 * inv, e2 * inv, e3 * inv};
#pragma unroll
                for (int k = 0; k < 4; ++k) { TOPE[tt * 4 + k] = te[k]; GATE[tt * 4 + k] = gk[k]; le[tk * 4 + k] = te[k]; }
            }
        }
        __syncthreads();
        if (F.tid < 256) { const int me = le[F.tid]; int rk = 0;
#pragma unroll 8
            for (int q4 = 0; q4 < 64; ++q4) { const v4u e4 = *(const LAS v4u*)(le + 4 * q4); const int a0 = 4 * q4;
                rk += ((a0 < F.tid) & ((int)e4.x == me)) + ((a0 + 1 < F.tid) & ((int)e4.y == me)) + ((a0 + 2 < F.tid) & ((int)e4.z == me)) + ((a0 + 3 < F.tid) & ((int)e4.w == me)); }
            RANK[blk * 256 + F.tid] = rk; (void)lds_addi(lh + me, 1); }
        __syncthreads();
        if (F.tid < 32) HIST[blk * 32 + F.tid] = lh[F.tid];
        __syncthreads();
    }
}

__device__ __forceinline__ void p_route_a(Frame& F) {
    frame_ids(F);
    const float* LOG = (const float*)(F.ws + WS_LOG); int* TOPE = (int*)(F.ws + WS_TOPE); float* GATE = (float*)(F.ws + WS_GATE); int* RANK = (int*)(F.ws + WS_RANK);
    int* HIST = (int*)(F.ws + WS_CTL) + CW_HIST; const float* br = F.in[I_BR];
    LAS int* lh = (LAS int*)(F.lds + RING_OFF); LAS int* le = lh + 32;
    for (int blk = F.vcu; blk < T / 64; blk += F.G) {
        if (F.tid < 32) lh[F.tid] = 0;
        __syncthreads();
        if (F.tid < 64) { const int t = blk * 64 + F.tid;
            float lg[32];
#pragma unroll
            for (int e4 = 0; e4 < 8; ++e4) { const f32x4 v = *(const GAS f32x4*)(LOG + (size_t)t * 256 + 4 * e4), bb = *(const GAS f32x4*)(br + 4 * e4);
                lg[4 * e4] = v.x + bb.x; lg[4 * e4 + 1] = v.y + bb.y; lg[4 * e4 + 2] = v.z + bb.z; lg[4 * e4 + 3] = v.w + bb.w; }
            float tv[4]; int te[4];
#pragma unroll
            for (int k = 0; k < 4; ++k) { float best = -3.0e38f; int bi = 0;
#pragma unroll
                for (int e = 0; e < 32; ++e) { if (lg[e] > best) { best = lg[e]; bi = e; } }
                tv[k] = best; te[k] = bi;
#pragma unroll
                for (int e = 0; e < 32; ++e) lg[e] = (e == bi) ? -3.0e38f : lg[e]; }
            const float e1 = __expf(tv[1] - tv[0]), e2 = __expf(tv[2] - tv[0]), e3 = __expf(tv[3] - tv[0]), inv = 1.f / (1.f + e1 + e2 + e3);
            const float gk[4] = {inv, e1 * inv, e2 * inv, e3 * inv};
#pragma unroll
            for (int k = 0; k < 4; ++k) { TOPE[t * 4 + k] = te[k]; GATE[t * 4 + k] = gk[k]; le[F.tid * 4 + k] = te[k]; }
        }
        __syncthreads();
        if (F.tid < 256) { const int me = le[F.tid]; int rk = 0;
            for (int a = 0; a < F.tid; ++a) rk += (le[a] == me) ? 1 : 0;
            RANK[blk * 256 + F.tid] = rk; (void)lds_addi(lh + me, 1); }
        __syncthreads();
        if (F.tid < 32) HIST[blk * 32 + F.tid] = lh[F.tid];
        __syncthreads();
    }
}
__device__ __forceinline__ void p_route_b(Frame& F) {
    frame_ids(F);
    const int* TOPE = (const int*)(F.ws + WS_TOPE); const float* GATE = (const float*)(F.ws + WS_GATE); const int* RANK = (const int*)(F.ws + WS_RANK);
    int* DEST = (int*)(F.ws + WS_DEST); float* RGATE = (float*)(F.ws + WS_RGATE); float* RROW = (float*)(F.ws + WS_RROW); const float* RSTD = (const float*)(F.ws + WS_RSTD);
    const int* HIST = (const int*)(F.ws + WS_CTL) + CW_HIST; int* BLKE = (int*)(F.ws + WS_CTL) + CW_BLKE; int* NBLK = (int*)(F.ws + WS_CTL) + CW_NBLK;
    const unsigned char* XQ = (const unsigned char*)(F.ws + WS_XQ); unsigned char* XP = (unsigned char*)(F.ws + WS_XPERM);
    LAS int* cnt = (LAS int*)(F.lds + RING_OFF);
    LAS int* pst = cnt + 32; LAS int* pen = cnt + 64; LAS int* base = cnt + 96; LAS int* dl = cnt + 128; LAS int* part = cnt + 384; LAS int* hl = cnt + 896;
    for (int i = F.tid; i < (T / 64) * 32; i += NTHR) hl[i] = HIST[i];
    __syncthreads();
    { const int e = F.tid & 31, g = F.tid >> 5; int s = 0;
#pragma unroll
        for (int q = 0; q < 16; ++q) s += hl[(16 * g + q) * 32 + e];
        part[g * 32 + e] = s; }
    __syncthreads();
    if (F.tid < 32) { int s = 0;
#pragma unroll
        for (int g = 0; g < 16; ++g) s += part[g * 32 + F.tid];
        cnt[F.tid] = s; }
    __syncthreads();
    if (F.tid == 0) { int run = 0; for (int e = 0; e < 32; ++e) { const int pd = (cnt[e] + MOEB - 1) / MOEB * MOEB; pst[e] = run; run += pd; pen[e] = run; } }
    __syncthreads();
    if (F.vcu == 0) {
        if (F.tid == 0) NBLK[0] = pen[31] / MOEB;
        if (F.tid < NBLK_MAX) { int e = 0; for (int q = 0; q < 32; ++q) e += (pen[q] <= F.tid * MOEB) ? 1 : 0; BLKE[F.tid] = e < 31 ? e : 31; }
    }
    for (int e = F.vcu; e < NE; e += F.G) {
        const int r0 = pst[e] + cnt[e], r1 = pen[e];
        for (int r = r0 + F.wave; r < r1; r += NWAVES) { if (F.lane == 0) { RGATE[r] = 0.f; RROW[r] = 0.f; }
            GAS v4u* o = (GAS v4u*)(XP + (size_t)r * D) + F.lane;
#pragma unroll
            for (int j = 0; j < 2; ++j) o[64 * j] = (v4u){0u, 0u, 0u, 0u}; }
    }
    for (int blk = F.vcu; blk < T / 64; blk += F.G) {
        __syncthreads();
        { const int e = F.tid & 31, g = F.tid >> 5; int s = 0;
#pragma unroll
            for (int q = 0; q < 16; ++q) s += (16 * g + q < blk) ? hl[(16 * g + q) * 32 + e] : 0;
            part[g * 32 + e] = s; }
        __syncthreads();
        if (F.tid < 32) { int s = pst[F.tid];
#pragma unroll
            for (int g = 0; g < 16; ++g) s += part[g * 32 + F.tid];
            base[F.tid] = s; }
        __syncthreads();
        if (F.tid < 256) { const int a = blk * 256 + F.tid; const int d = base[TOPE[a]] + RANK[a]; DEST[a] = d; RGATE[d] = GATE[a]; RROW[d] = RSTD[a >> 2]; dl[F.tid] = d; }
        __syncthreads();
        { v4u rr[8][2];
#pragma unroll
            for (int q = 0; q < 8; ++q) { const int t = blk * 64 + F.wave + 8 * q; const GAS v4u* s = (const GAS v4u*)(XQ + (size_t)t * D) + F.lane; rr[q][0] = s[0]; rr[q][1] = s[64]; }
#pragma unroll
            for (int q = 0; q < 8; ++q)
#pragma unroll
                for (int k = 0; k < 4; ++k) { const int a = 4 * (F.wave + 8 * q) + k; GAS v4u* o = (GAS v4u*)(XP + (size_t)dl[a] * D) + F.lane; o[0] = rr[q][0]; o[64] = rr[q][1]; } }
    }
}
__device__ __forceinline__ void p_combine(Frame& F) {
    frame_ids(F);
    const bf16* X2 = (const bf16*)(F.ws + WS_X2); const unsigned char* YR = (const unsigned char*)(F.ws + WS_YR); const int* DEST = (const int*)(F.ws + WS_DEST);
    const float* fw = F.in[I_FNW];
    const int gw = F.vcu * NWAVES + F.wave, NGW = F.G * NWAVES;
    for (int m = gw; m < T; m += NGW) {
        const GAS v2u* xr = (const GAS v2u*)(X2 + (size_t)m * D) + F.lane;
        f32x4 v[8];
#pragma unroll
        for (int j = 0; j < 8; ++j) { const v2u xw = xr[64 * j]; v[j] = (f32x4){bflo(xw.x), bfhi(xw.x), bflo(xw.y), bfhi(xw.y)}; }
#pragma unroll
        for (int k = 0; k < 4; ++k) { const GAS unsigned* yr = (const GAS unsigned*)(YR + (size_t)DEST[m * 4 + k] * D) + F.lane;
#pragma unroll
            for (int j = 0; j < 8; ++j) { const unsigned y = yr[64 * j]; const f32x2 lo = __builtin_amdgcn_cvt_pk_f32_fp8((int)y, false), hi = __builtin_amdgcn_cvt_pk_f32_fp8((int)y, true);
                v[j].x += lo.x * (1.f / YSCALE); v[j].y += lo.y * (1.f / YSCALE); v[j].z += hi.x * (1.f / YSCALE); v[j].w += hi.y * (1.f / YSCALE); } }
        float s = 0.f;
#pragma unroll
        for (int j = 0; j < 8; ++j) s += (v[j].x * v[j].x + v[j].y * v[j].y) + (v[j].z * v[j].z + v[j].w * v[j].w);
        const float rstd = 1.f / sqrtf(wave_sum(s) * (1.f / D) + EPS);
        const GAS f32x4* wr = (const GAS f32x4*)fw + F.lane; GAS f32x4* o = (GAS f32x4*)(F.out + (size_t)m * D) + F.lane;
#pragma unroll
        for (int j = 0; j < 8; ++j) { const f32x4 ww = wr[64 * j]; f32x4 ov = (f32x4){v[j].x * rstd * ww.x, v[j].y * rstd * ww.y, v[j].z * rstd * ww.z, v[j].w * rstd * ww.w};
#ifdef MK_SANITIZE
#pragma unroll
            for (int q = 0; q < 4; ++q) if (!(fabsf(ov[q]) < 1e30f)) ov[q] = 100.f;
#endif
            __builtin_nontemporal_store(ov, o + 64 * j); }
    }
}


constexpr int NPHASE = 20;
struct Args { const float* in[25]; float* out; unsigned char* ws; int ph_lo, ph_hi; };
__global__ void __launch_bounds__(NTHR, 2) mk_fwd(Args args) {
    extern __shared__ __attribute__((aligned(16))) unsigned char lds[];
    Frame F;
    F.lds = (LAS unsigned char*)lds;
    F.wave = __builtin_amdgcn_readfirstlane((int)threadIdx.x >> 6); frame_ids(F);
    F.G = gridDim.x; { const int bx = blockIdx.x; F.vcu = (F.G % 8 == 0) ? (bx % 8) * (F.G / 8) + bx / 8 : bx; }
    F.ws = args.ws; F.out = args.out;
#pragma unroll
    for (int i = 0; i < 25; ++i) F.in[i] = args.in[i];
    for (int u = F.tid; u < (LDS_BYTES - LDSCTL_OFF) / 4; u += NTHR) ((LAS unsigned*)(F.lds + LDSCTL_OFF))[u] = 0u;
    __syncthreads();
    const int lo = args.ph_lo, hi = args.ph_hi;
    unsigned* ctl = (unsigned*)(F.ws + WS_CTL);
    XcdBarrier bar; bar.bar = ctl + CW_BAR; bar.x = 0; bar.st = nullptr;
    if (hi - lo > 1) bar = xcd_barrier_post(ctl + CW_BAR, (volatile LAS unsigned*)(F.lds + MISC_OFF) + 8, F.tid);
#define IN(k) (lo <= (k) && (k) < hi)
#define SEAM(k) do { if (IN(k) && IN((k) + 1)) { frame_ids(F); xcd_barrier(bar, F.tid); } } while (0)
    LAS unsigned char* ring = F.lds + RING_OFF;
    const int cid = (int)blockIdx.x;
    const int kj = cid >> 3, KOFF_ST = (F.G == 256) ? 2 * (((kj & 7) + (kj >> 3)) & 3) : 0, KOFF_MOE = (F.G == 256) ? 2 * (((kj >> 2) + (kj & 3)) & 3) : 0;

    if (IN(0)) { p0_prologue(F); }
#if (PROBE_MASK >> 0) & 1
    if (IN(0)) { frame_ids(F); VM_WAIT(); __syncthreads(); }
    if (IN(0)) { p0_prologue(F); }
#endif
 SEAM(0);
    if (IN(1)) {
        { pg8::Gemm g{(const bf16*)(F.ws + WS_H), (const bf16*)(F.ws + WS_WIN), T, 2048, D}; pg8::InProjOrder<0> S; S.init(T, 2048, F.G, cid);
          pg8::EpiAct E{(bf16*)(F.ws + WS_PROJ), NPROJ, 12, 16, 28, 44, 16, 20, 0.125f * 1.4426950408889634f, 0, nullptr, 0.f, 0.f, 1.f};
          pg8::gemm_phase<pg8::EpiAct, pg8::InProjOrder<0>, true, true>(ring, g, S, E, F.wave, KOFF_ST); }
        { pg8::Gemm g{(const bf16*)(F.ws + WS_H8), (const bf16*)(F.ws + WS_WIN8), T, 9216, D / 2}; pg8::InProjOrder<1> S; S.init(T, 9216, F.G, cid);
          pg8::EpiAct E{(bf16*)(F.ws + WS_PROJ), NPROJ, 12, 16, 28, 44, 16, 20, 0.125f * 1.4426950408889634f, 0, nullptr, 0.f, 0.f, 1.f / (HSCALE * WSCALE)};
          pg8::gemm_phase<pg8::EpiAct, pg8::InProjOrder<1>, true, true, true>(ring, g, S, E, F.wave, KOFF_ST); }
    }
#if (PROBE_MASK >> 1) & 1
    if (IN(1)) { frame_ids(F); VM_WAIT(); __syncthreads(); }
    if (IN(1)) {
        { pg8::Gemm g{(const bf16*)(F.ws + WS_H), (const bf16*)(F.ws + WS_WIN), T, 2048, D}; pg8::InProjOrder<0> S; S.init(T, 2048, F.G, cid);
          pg8::EpiAct E{(bf16*)(F.ws + WS_PROJ), NPROJ, 12, 16, 28, 44, 16, 20, 0.125f * 1.4426950408889634f, 1, nullptr, 0.f, 0.f, 1.f};
          pg8::gemm_phase<pg8::EpiAct, pg8::InProjOrder<0>, true, true>(ring, g, S, E, F.wave, KOFF_ST); }
        { pg8::Gemm g{(const bf16*)(F.ws + WS_H8), (const bf16*)(F.ws + WS_WIN8), T, 9216, D / 2}; pg8::InProjOrder<1> S; S.init(T, 9216, F.G, cid);
          pg8::EpiAct E{(bf16*)(F.ws + WS_PROJ), NPROJ, 0, 0, 0, 0, 16, 20, 0.125f * 1.4426950408889634f, 1, nullptr, 0.f, 0.f, 1.f / (HSCALE * WSCALE)};
          pg8::gemm_phase<pg8::EpiAct, pg8::InProjOrder<1>, true, true, true>(ring, g, S, E, F.wave, KOFF_ST); }
    }
#endif
 SEAM(1);
    if (IN(2)) { p_conv(F); }
#if (PROBE_MASK >> 2) & 1
    if (IN(2)) { frame_ids(F); VM_WAIT(); __syncthreads(); }
    if (IN(2)) { p_conv(F); }
#endif
 SEAM(2);
    if (IN(3)) { p_local_band(F); }
#if (PROBE_MASK >> 19) & 1
    if (IN(3)) { p_mlstm_local(F); }
#endif
#if (PROBE_MASK >> 20) & 1
    if (IN(3)) { p_band_attn(F); }
#endif
#if (PROBE_MASK >> 3) & 1
    if (IN(3)) { frame_ids(F); VM_WAIT(); __syncthreads(); }
    if (IN(3)) { p_mlstm_local(F); p_band_attn(F); }
#endif
 SEAM(3);
    if (IN(4)) { p_mlstm_scan(F); }
#if (PROBE_MASK >> 4) & 1
    if (IN(4)) { frame_ids(F); VM_WAIT(); __syncthreads(); }
    if (IN(4)) { p_mlstm_scan(F); }
#endif
 SEAM(4);
    if (IN(5)) { p_mlstm_out(F); }
#if (PROBE_MASK >> 5) & 1
    if (IN(5)) { frame_ids(F); VM_WAIT(); __syncthreads(); }
    if (IN(5)) { p_mlstm_out(F); }
#endif
 SEAM(5);
    if (IN(6)) { pg8::Gemm g{(const bf16*)(F.ws + WS_HM), (const bf16*)(F.ws + WS_WBM), T, D, 2048}; pg8::StaticOrder S; S.init(T, D, F.G, cid);
        pg8::EpiMerge E{(const bf16*)(F.ws + WS_PROJ), NPROJ, PG_M, PG_A, (bf16*)(F.ws + WS_MRG), D};
        pg8::gemm_phase<pg8::EpiMerge, pg8::StaticOrder, true, true>(ring, g, S, E, F.wave); }
#if (PROBE_MASK >> 6) & 1
    if (IN(6)) { frame_ids(F); VM_WAIT(); __syncthreads(); }
    if (IN(6)) { pg8::Gemm g{(const bf16*)(F.ws + WS_HM), (const bf16*)(F.ws + WS_WBM), T, D, 2048}; pg8::StaticOrder S; S.init(T, D, F.G, cid);
        pg8::EpiMerge E{(const bf16*)(F.ws + WS_PROJ), NPROJ, PG_M, PG_A, (bf16*)(F.ws + WS_MRG), D};
        pg8::gemm_phase<pg8::EpiMerge, pg8::StaticOrder, true, true>(ring, g, S, E, F.wave); }
#endif
 SEAM(6);
    if (IN(7)) { pg8::Gemm g{(const bf16*)(F.ws + WS_MRG), (const bf16*)(F.ws + WS_WOUT), T, D, D}; pg8::StaticOrder S; S.init(T, D, F.G, cid);
        pg8::EpiResB<false> E{(bf16*)(F.ws + WS_XN1), D, (const void*)F.in[I_X], (float*)(F.ws + WS_SSQ1)};
        pg8::gemm_phase<pg8::EpiResB<false>, pg8::StaticOrder, true, true>(ring, g, S, E, F.wave, KOFF_ST); }
#if (PROBE_MASK >> 7) & 1
    if (IN(7)) { frame_ids(F); VM_WAIT(); __syncthreads(); }
    if (IN(7)) { pg8::Gemm g{(const bf16*)(F.ws + WS_MRG), (const bf16*)(F.ws + WS_WOUT), T, D, D}; pg8::StaticOrder S; S.init(T, D, F.G, cid);
        pg8::EpiResB<false> E{(bf16*)(F.ws + WS_XN1), D, (const void*)F.in[I_X], (float*)(F.ws + WS_SSQ1)};
        pg8::gemm_phase<pg8::EpiResB<false>, pg8::StaticOrder, true, true>(ring, g, S, E, F.wave, KOFF_ST); }
#endif
 SEAM(7);
    if (IN(9)) {
        if (cid < 128 || F.G != 256) { pg8::Gemm g{(const bf16*)(F.ws + WS_XN1), (const bf16*)(F.ws + WS_WQ), T, XW, D}; pg8::StaticOrder S; S.init(T, XW, F.G, cid);
            pg8::EpiAct E{(bf16*)(F.ws + WS_QX), XW, 0, 0, 0, 0, 0, 2, 0.08838834764831845f * 1.4426950408889634f, 0, (const float*)(F.ws + WS_SSQ1), 1.f / D, EPS, 1.f};
            pg8::gemm_phase<pg8::EpiAct, pg8::StaticOrder, true, true>(ring, g, S, E, F.wave, KOFF_ST); }
        if (cid >= 128 || F.G != 256) {
            pg8::Gemm g{(const bf16*)(F.ws + WS_MEMN), (const bf16*)(F.ws + WS_WKV), BATCH * NMEM, 2 * XW, D}; pg8::StaticOrder S; S.init(BATCH * NMEM, 2 * XW, F.G == 256 ? 128 : F.G, F.G == 256 ? cid - 128 : cid);
            pg8::EpiAct E{(bf16*)(F.ws + WS_KVX), 2 * XW, 0, 0, 0, 0, 0, 0, 1.f, 0, nullptr, 0.f, 0.f, 1.f};
            pg8::gemm_phase<pg8::EpiAct, pg8::StaticOrder, true, true>(ring, g, S, E, F.wave, KOFF_ST); }
        if (F.G == 256) { if (cid >= 256 - LATE_WG) { frame_ids(F); weight_tiles(F, NTILES - NT_LATE, NTILES, cid - (256 - LATE_WG), LATE_WG); } }
        else { frame_ids(F); __syncthreads(); weight_tiles(F, NTILES - NT_LATE, NTILES, F.vcu, F.G); }
    }
#if (PROBE_MASK >> 9) & 1
    if (IN(9)) { frame_ids(F); VM_WAIT(); __syncthreads(); }
    if (IN(9)) {
        if (cid < 128 || F.G != 256) { pg8::Gemm g{(const bf16*)(F.ws + WS_XN1), (const bf16*)(F.ws + WS_WQ), T, XW, D}; pg8::StaticOrder S; S.init(T, XW, F.G, cid);
            pg8::EpiAct E{(bf16*)(F.ws + WS_QX), XW, 0, 0, 0, 0, 0, 2, 0.08838834764831845f * 1.4426950408889634f, 0, (const float*)(F.ws + WS_SSQ1), 1.f / D, EPS, 1.f};
            pg8::gemm_phase<pg8::EpiAct, pg8::StaticOrder, true, true>(ring, g, S, E, F.wave, KOFF_ST); }
        if (cid >= 128 || F.G != 256) {
            pg8::Gemm g{(const bf16*)(F.ws + WS_MEMN), (const bf16*)(F.ws + WS_WKV), BATCH * NMEM, 2 * XW, D}; pg8::StaticOrder S; S.init(BATCH * NMEM, 2 * XW, F.G == 256 ? 128 : F.G, F.G == 256 ? cid - 128 : cid);
            pg8::EpiAct E{(bf16*)(F.ws + WS_KVX), 2 * XW, 0, 0, 0, 0, 0, 0, 1.f, 0, nullptr, 0.f, 0.f, 1.f};
            pg8::gemm_phase<pg8::EpiAct, pg8::StaticOrder, true, true>(ring, g, S, E, F.wave, KOFF_ST); }
        if (F.G == 256) { if (cid >= 256 - LATE_WG) { frame_ids(F); weight_tiles(F, NTILES - NT_LATE, NTILES, cid - (256 - LATE_WG), LATE_WG); } }
        else { frame_ids(F); __syncthreads(); weight_tiles(F, NTILES - NT_LATE, NTILES, F.vcu, F.G); }
    }
#endif
 SEAM(9);
    if (IN(10)) { p_cross_attn(F); }
#if (PROBE_MASK >> 10) & 1
    if (IN(10)) { frame_ids(F); VM_WAIT(); __syncthreads(); }
    if (IN(10)) { p_cross_attn(F); }
#endif
 SEAM(10);
    if (IN(11)) { pg8::Gemm g{(const bf16*)(F.ws + WS_OX), (const bf16*)(F.ws + WS_WO), T, D, XW}; pg8::StaticOrder S; S.init(T, D, F.G, cid);
        pg8::EpiResB<true> E{(bf16*)(F.ws + WS_X2), D, (const void*)(F.ws + WS_XN1), nullptr};
        pg8::gemm_phase<pg8::EpiResB<true>, pg8::StaticOrder, true, true>(ring, g, S, E, F.wave, KOFF_ST); }
#if (PROBE_MASK >> 11) & 1
    if (IN(11)) { frame_ids(F); VM_WAIT(); __syncthreads(); }
    if (IN(11)) { pg8::Gemm g{(const bf16*)(F.ws + WS_OX), (const bf16*)(F.ws + WS_WO), T, D, XW}; pg8::StaticOrder S; S.init(T, D, F.G, cid);
        pg8::EpiResB<true> E{(bf16*)(F.ws + WS_X2), D, (const void*)(F.ws + WS_XN1), nullptr};
        pg8::gemm_phase<pg8::EpiResB<true>, pg8::StaticOrder, true, true>(ring, g, S, E, F.wave, KOFF_ST); }
#endif
 SEAM(11);
    if (IN(12)) { p_norm_route(F); }
#if (PROBE_MASK >> 12) & 1
    if (IN(12)) { frame_ids(F); VM_WAIT(); __syncthreads(); }
    if (IN(12)) { p_norm_route(F); }
#endif
    do { if (IN(12) && IN(15)) { frame_ids(F); xcd_barrier(bar, F.tid); } } while (0);
    if (IN(15)) { p_route_b(F); }
#if (PROBE_MASK >> 15) & 1
    if (IN(15)) { frame_ids(F); VM_WAIT(); __syncthreads(); }
    if (IN(15)) { p_route_b(F); }
#endif
 SEAM(15);
    if (IN(16)) { const int* BLKE = (const int*)ctl + CW_BLKE; const int nblk = ((const int*)ctl)[CW_NBLK];
        pg8::Gemm g{(const bf16*)(F.ws + WS_XPERM), (const bf16*)(F.ws + WS_WGU), NROWS_MAX, 2 * DFF, D / 2};
        pg8::MoeOrder S{2 * DFF / 256, F.G, cid, nblk, BLKE, (size_t)2 * DFF * D};
        pg8::EpiSwiGLU E{(unsigned char*)(F.ws + WS_ACT), DFF, F.in[I_BGU], BLKE, DFF, 1.f / (XSCALE * WSCALE), ASCALE, (const float*)(F.ws + WS_RROW)};
        pg8::gemm_phase<pg8::EpiSwiGLU, pg8::MoeOrder, true, true, true>(ring, g, S, E, F.wave, KOFF_MOE);
        { frame_ids(F); VM_WAIT(); __syncthreads();
          constexpr int TG0 = NTILES - NT_LATE - NT_GU, TG1 = NTILES - NT_LATE;
          const int nN = S.nN, rpr = (8 / (nN / 4)) * 8, R = (nblk + rpr - 1) / rpr, n_idle = (R * rpr - nblk) * nN; int covered = 0;
          if (F.G == 256 && n_idle > 0) { pg8::Unit u; const bool has = S.next(R - 1, u);
              covered = (6 * n_idle < NT_GU) ? 6 * n_idle : NT_GU;
              if (!has) weight_tiles(F, TG0, TG0 + covered, (u.pm - nblk) * nN + u.pn, n_idle); }
          if (covered < NT_GU) { __syncthreads(); weight_tiles(F, TG0 + covered, TG1, F.vcu, F.G); } } }
#if (PROBE_MASK >> 16) & 1
    if (IN(16)) { frame_ids(F); VM_WAIT(); __syncthreads(); }
    if (IN(16)) { const int* BLKE = (const int*)ctl + CW_BLKE; const int nblk = ((const int*)ctl)[CW_NBLK];
        pg8::Gemm g{(const bf16*)(F.ws + WS_XPERM), (const bf16*)(F.ws + WS_WGU), NROWS_MAX, 2 * DFF, D / 2};
        pg8::MoeOrder S{2 * DFF / 256, F.G, cid, nblk, BLKE, (size_t)2 * DFF * D};
        pg8::EpiSwiGLU E{(unsigned char*)(F.ws + WS_ACT), DFF, F.in[I_BGU], BLKE, DFF, 1.f / (XSCALE * WSCALE), ASCALE, (const float*)(F.ws + WS_RROW)};
        pg8::gemm_phase<pg8::EpiSwiGLU, pg8::MoeOrder, true, true, true>(ring, g, S, E, F.wave, KOFF_MOE); }
#endif
 SEAM(16);
    if (IN(17)) { const int* BLKE = (const int*)ctl + CW_BLKE; const int nblk = ((const int*)ctl)[CW_NBLK];
        pg8::Gemm g{(const bf16*)(F.ws + WS_ACT), (const bf16*)(F.ws + WS_WDN), NROWS_MAX, D, DFF / 2};
        pg8::MoeOrder S{D / 256, F.G, cid, nblk, BLKE, (size_t)D * DFF};
        pg8::EpiDown E{(unsigned char*)(F.ws + WS_YR), D, F.in[I_BDN], BLKE, (const float*)(F.ws + WS_RGATE), 1.f / (ASCALE * WSCALE), YSCALE};
        pg8::gemm_phase<pg8::EpiDown, pg8::MoeOrder, true, true, true>(ring, g, S, E, F.wave, KOFF_MOE); }
#if (PROBE_MASK >> 17) & 1
    if (IN(17)) { frame_ids(F); VM_WAIT(); __syncthreads(); }
    if (IN(17)) { const int* BLKE = (const int*)ctl + CW_BLKE; const int nblk = ((const int*)ctl)[CW_NBLK];
        pg8::Gemm g{(const bf16*)(F.ws + WS_ACT), (const bf16*)(F.ws + WS_WDN), NROWS_MAX, D, DFF / 2};
        pg8::MoeOrder S{D / 256, F.G, cid, nblk, BLKE, (size_t)D * DFF};
        pg8::EpiDown E{(unsigned char*)(F.ws + WS_YR), D, F.in[I_BDN], BLKE, (const float*)(F.ws + WS_RGATE), 1.f / (ASCALE * WSCALE), YSCALE};
        pg8::gemm_phase<pg8::EpiDown, pg8::MoeOrder, true, true, true>(ring, g, S, E, F.wave, KOFF_MOE); }
#endif
 SEAM(17);
    if (IN(18)) { p_combine(F); }
#if (PROBE_MASK >> 18) & 1
    if (IN(18)) { frame_ids(F); VM_WAIT(); __syncthreads(); }
    if (IN(18)) { p_combine(F); }
#endif

#undef IN
#undef SEAM
}

#ifndef MK_SPLIT
#define MK_SPLIT 0
#endif
extern "C" void kernel_launch(void* const* d_in, const int* in_sizes, int n_in, void* d_out, int out_size, void* d_ws, size_t ws_size, hipStream_t stream) {
    static int grid = 0;
    if (grid == 0) {
        if (n_in != 25 || in_sizes[0] != T * D || out_size != T * D || ws_size < WS_END) { fprintf(stderr, "kernel_launch: unexpected shapes (n_in %d in0 %d out %d ws %zu need %zu)\n", n_in, n_in > 0 ? in_sizes[0] : -1, out_size, ws_size, (size_t)WS_END); grid = -1; return; }
        int dev = 0, cus = 0, per_cu = 0;
        if (hipGetDevice(&dev) != hipSuccess || hipDeviceGetAttribute(&cus, hipDeviceAttributeMultiprocessorCount, dev) != hipSuccess) { grid = -1; return; }
        if (hipFuncSetAttribute((const void*)mk_fwd, hipFuncAttributeMaxDynamicSharedMemorySize, LDS_BYTES) != hipSuccess) { fprintf(stderr, "kernel_launch: hipFuncSetAttribute failed\n"); grid = -1; return; }
        if (hipOccupancyMaxActiveBlocksPerMultiprocessor(&per_cu, (const void*)mk_fwd, NTHR, LDS_BYTES) != hipSuccess || per_cu < 1) fprintf(stderr, "kernel_launch: occupancy query reports %d\n", per_cu);
        (void)hipGetLastError();
        grid = cus;
    }
    if (grid < 0) return;
    (void)hipMemsetAsync((char*)d_ws + WS_CTL, 0, CTL_ZERO_BYTES, stream);
    Args a{};
    for (int i = 0; i < 25; ++i) a.in[i] = (const float*)d_in[i];
    a.out = (float*)d_out; a.ws = (unsigned char*)d_ws;
#if MK_SPLIT
    for (int p = 0; p < 19; ++p) { a.ph_lo = p; a.ph_hi = p + 1; hipLaunchKernelGGL(mk_fwd, dim3(grid), dim3(NTHR), LDS_BYTES, stream, a); }
#else
    a.ph_lo = 0; a.ph_hi = 19; hipLaunchKernelGGL(mk_fwd, dim3(grid), dim3(NTHR), LDS_BYTES, stream, a);
#endif
}
```
